# Optimizing an MI355X kernel written in HIP

```python
import jax, jax.numpy as jnp
from jax import lax
import numpy as np

D_MODEL = 1024
BATCH = 8
SEQ = 8192
DEPTH = 4

N_MEM = 256
EPS = 1e-6
D_MIX = D_MODEL
MLA_HEADS = 8
MLA_NOPE = 64
MLA_ROPE = 32
MLA_V = 64
Q_LORA = 256
KV_LORA = 128
ROPE_THETA = 10000.0
Q_BLOCK = 128
MLA_WIDTH = MLA_HEADS * MLA_V
SG_HEADS = 8
SG_WIDTH = D_MIX - MLA_WIDTH
SG_HEAD_DIM = SG_WIDTH // SG_HEADS
CHUNK = 128
MEM_HEADS = 4
MEM_HEAD_DIM = D_MODEL // MEM_HEADS
D_FF = 2816
CONV_W = 3
IN_COLS = Q_LORA + KV_LORA + MLA_ROPE + 2 * SG_WIDTH

kernel_name = "hybrid_mla_gmlp_memory_convffn_encoder"


def rmsnorm(x, g):
    xf = x.astype(jnp.float32)
    y = xf * lax.rsqrt(jnp.mean(xf * xf, axis=-1, keepdims=True) + EPS)
    return (y * g.astype(jnp.float32)).astype(x.dtype)


def layernorm(x, g, b):
    xf = x.astype(jnp.float32)
    mu = jnp.mean(xf, axis=-1, keepdims=True)
    xc = xf - mu
    var = jnp.mean(xc * xc, axis=-1, keepdims=True)
    y = xc * lax.rsqrt(var + EPS) * g.astype(jnp.float32) + b.astype(jnp.float32)
    return y.astype(x.dtype)


def rope_tables(positions):
    half = MLA_ROPE // 2
    inv_freq = ROPE_THETA ** (-jnp.arange(half, dtype=jnp.float32) / half)
    ang = positions.astype(jnp.float32)[..., None] * inv_freq
    return jnp.cos(ang), jnp.sin(ang)


def apply_rope(x, cos, sin):
    x1, x2 = jnp.split(x, 2, axis=-1)
    c = cos.astype(x.dtype)
    s = sin.astype(x.dtype)
    return jnp.concatenate([x1 * c - x2 * s, x2 * c + x1 * s], axis=-1)


def mla_mixer(h_q, h_kv, k_pe, cos, sin, q_norm_g, w_uq, kv_norm_g, w_ukv):
    B, S, _ = h_q.shape
    q = (rmsnorm(h_q, q_norm_g) @ w_uq).reshape(B, S, MLA_HEADS, MLA_NOPE + MLA_ROPE)
    q_nope = q[..., :MLA_NOPE]
    q_pe = apply_rope(q[..., MLA_NOPE:], cos[:, :, None, :], sin[:, :, None, :])
    kv = (rmsnorm(h_kv, kv_norm_g) @ w_ukv).reshape(B, S, MLA_HEADS, MLA_NOPE + MLA_V)
    k_nope = kv[..., :MLA_NOPE]
    v = kv[..., MLA_NOPE:]
    k_pe = apply_rope(k_pe, cos, sin)
    scale = (MLA_NOPE + MLA_ROPE) ** -0.5
    nb = S // Q_BLOCK
    qn_blk = q_nope.reshape(B, nb, Q_BLOCK, MLA_HEADS, MLA_NOPE).transpose(1, 0, 2, 3, 4)
    qp_blk = q_pe.reshape(B, nb, Q_BLOCK, MLA_HEADS, MLA_ROPE).transpose(1, 0, 2, 3, 4)

    def attend(blk):
        qn, qp = blk
        s = (jnp.einsum('bqhd,bkhd->bhqk', qn, k_nope)
             + jnp.einsum('bqhr,bkr->bhqk', qp, k_pe))
        p = jax.nn.softmax(s.astype(jnp.float32) * scale, axis=-1).astype(v.dtype)
        return jnp.einsum('bhqk,bkhd->bqhd', p, v)

    o = lax.map(attend, (qn_blk, qp_blk))
    return o.transpose(1, 0, 2, 3, 4).reshape(B, S, MLA_WIDTH)


def spatial_gating_mixer(h_sg, ln_g, ln_b, w_s, b_s):
    B, S, _ = h_sg.shape
    z = jax.nn.gelu(h_sg)
    u, v = z[..., :SG_WIDTH], z[..., SG_WIDTH:]
    v = layernorm(v, ln_g, ln_b)
    nc = S // CHUNK
    v = v.reshape(B, nc, CHUNK, SG_HEADS, SG_HEAD_DIM)
    mixed = (jnp.einsum('hij,bcjhd->bcihd', w_s, v)
             + b_s.T[None, None, :, :, None])
    return u * mixed.reshape(B, S, SG_WIDTH)


def memory_attention(h, mem_h, w_mq, w_mkv, w_mo):
    B, S, _ = h.shape
    q = (h @ w_mq).reshape(B, S, MEM_HEADS, MEM_HEAD_DIM)
    kv = (mem_h @ w_mkv).reshape(B, -1, 2, MEM_HEADS, MEM_HEAD_DIM)
    k, v = kv[:, :, 0], kv[:, :, 1]
    s = jnp.einsum('bqhd,bmhd->bhqm', q, k).astype(jnp.float32) * (MEM_HEAD_DIM ** -0.5)
    p = jax.nn.softmax(s, axis=-1).astype(v.dtype)
    o = jnp.einsum('bhqm,bmhd->bqhd', p, v).reshape(B, S, D_MODEL)
    return o @ w_mo


def conv_ffn(h, w_up, conv_w, conv_b, w_down):
    S = h.shape[1]
    a = h @ w_up
    pad = CONV_W // 2
    ap = jnp.pad(a, ((0, 0), (pad, pad), (0, 0)))
    a = sum(ap[:, k:k + S] * conv_w[k] for k in range(CONV_W)) + conv_b
    g, up = jnp.split(a, 2, axis=-1)
    return (jax.nn.silu(g) * up) @ w_down


def setup_inputs(seed: int = 0) -> dict:
    key = jax.random.key(seed)
    ks = jax.random.split(key, 32)

    def nrm(k, shape, scale):
        return jax.random.normal(k, shape, jnp.float32) * scale

    def gain(k, shape):
        return 1.0 + 0.02 * jax.random.normal(k, shape, jnp.float32)

    L = DEPTH
    x = nrm(ks[0], (BATCH, SEQ, D_MODEL), 1.0)
    mem = nrm(ks[1], (BATCH, N_MEM, D_MODEL), 1.0)
    positions = (jnp.arange(SEQ, dtype=jnp.int32)[None, :]
                 + jax.random.randint(ks[2], (BATCH, 1), 0, 4096, dtype=jnp.int32))
    return {
        "x": x,
        "mem": mem,
        "positions": positions,
        "norm_mix_g": gain(ks[3], (L, D_MODEL)),
        "w_in": nrm(ks[4], (L, D_MODEL, IN_COLS), D_MODEL ** -0.5),
        "q_norm_g": gain(ks[5], (L, Q_LORA)),
        "w_uq": nrm(ks[6], (L, Q_LORA, MLA_HEADS * (MLA_NOPE + MLA_ROPE)), Q_LORA ** -0.5),
        "kv_norm_g": gain(ks[7], (L, KV_LORA)),
        "w_ukv": nrm(ks[8], (L, KV_LORA, MLA_HEADS * (MLA_NOPE + MLA_V)), KV_LORA ** -0.5),
        "sg_ln_g": gain(ks[9], (L, SG_WIDTH)),
        "sg_ln_b": nrm(ks[10], (L, SG_WIDTH), 0.02),
        "sg_w_s": nrm(ks[11], (L, SG_HEADS, CHUNK, CHUNK), 0.5 * CHUNK ** -0.5),
        "sg_b_s": gain(ks[12], (L, SG_HEADS, CHUNK)),
        "out_norm_mla_g": gain(ks[13], (L, MLA_WIDTH)),
        "out_norm_sg_g": gain(ks[14], (L, SG_WIDTH)),
        "w_out": nrm(ks[15], (L, D_MIX, D_MODEL), D_MIX ** -0.5),
        "norm_mem_g": gain(ks[16], (L, D_MODEL)),
        "mem_norm_g": gain(ks[17], (L, D_MODEL)),
        "w_mq": nrm(ks[18], (L, D_MODEL, D_MODEL), D_MODEL ** -0.5),
        "w_mkv": nrm(ks[19], (L, D_MODEL, 2 * D_MODEL), D_MODEL ** -0.5),
        "w_mo": nrm(ks[20], (L, D_MODEL, D_MODEL), D_MODEL ** -0.5),
        "norm_ffn_g": gain(ks[21], (L, D_MODEL)),
        "w_up": nrm(ks[22], (L, D_MODEL, 2 * D_FF), D_MODEL ** -0.5),
        "conv_w": nrm(ks[23], (L, CONV_W, 2 * D_FF), CONV_W ** -0.5),
        "conv_b": nrm(ks[24], (L, 2 * D_FF), 0.02),
        "w_down": nrm(ks[25], (L, D_FF, D_MODEL), D_FF ** -0.5),
        "final_norm_g": gain(ks[26], (D_MODEL,)),
    }


def reference(x, mem, positions, norm_mix_g, w_in, q_norm_g, w_uq, kv_norm_g, w_ukv,
              sg_ln_g, sg_ln_b, sg_w_s, sg_b_s, out_norm_mla_g, out_norm_sg_g, w_out,
              norm_mem_g, mem_norm_g, w_mq, w_mkv, w_mo, norm_ffn_g, w_up, conv_w,
              conv_b, w_down, final_norm_g):
    cos, sin = rope_tables(positions)
    c1 = Q_LORA
    c2 = c1 + KV_LORA
    c3 = c2 + MLA_ROPE
    for l in range(DEPTH):
        h = rmsnorm(x, norm_mix_g[l])
        proj = h @ w_in[l]
        h_q, h_kv, k_pe, h_sg = proj[..., :c1], proj[..., c1:c2], proj[..., c2:c3], proj[..., c3:]
        o_mla = mla_mixer(h_q, h_kv, k_pe, cos, sin, q_norm_g[l], w_uq[l], kv_norm_g[l], w_ukv[l])
        o_sg = spatial_gating_mixer(h_sg, sg_ln_g[l], sg_ln_b[l], sg_w_s[l], sg_b_s[l])
        o = jnp.concatenate([rmsnorm(o_mla, out_norm_mla_g[l]),
                             rmsnorm(o_sg, out_norm_sg_g[l])], axis=-1)
        x = x + o @ w_out[l]
        h = rmsnorm(x, norm_mem_g[l])
        m = rmsnorm(mem, mem_norm_g[l])
        x = x + memory_attention(h, m, w_mq[l], w_mkv[l], w_mo[l])
        h = rmsnorm(x, norm_ffn_g[l])
        x = x + conv_ffn(h, w_up[l], conv_w[l], conv_b[l], w_down[l])
    return rmsnorm(x, final_norm_g)
```

```cpp
#include <hip/hip_runtime.h>
#include <hip/hip_cooperative_groups.h>
#include <stdint.h>
#include <stdio.h>
namespace cg = cooperative_groups;

#ifndef PHMASK
#define PHMASK 0xFFFF
#endif
#ifndef REPMASK
#define REPMASK 0
#endif
#ifndef COOP
#define COOP 1
#endif

typedef unsigned short bf16_t;
typedef __attribute__((ext_vector_type(8))) short bf16x8;
typedef __attribute__((ext_vector_type(16))) float f32x16;
typedef __attribute__((ext_vector_type(4))) unsigned u32x4;
#define DI __device__ __forceinline__
#define MFMA(a, b, c) __builtin_amdgcn_mfma_f32_32x32x16_bf16((a), (b), (c), 0, 0, 0)

constexpr int NBATCH = 8, SEQ = 8192, TOK = NBATCH * SEQ, DM = 1024, DEPTH = 4;
constexpr int NMEM = 256, QL = 256, KVL = 128, ROPE = 32, NOPE = 64, VD = 64, NH = 8;
constexpr int SGW = 512, INC = 1440, INCP = 1536, DFF = 2816;
constexpr float EPS = 1e-6f;
constexpr float LOG2E = 1.4426950408889634f;

constexpr size_t al256(size_t x) { return (x + 255) & ~(size_t)255; }
constexpr size_t SZ_WIN = (size_t)DEPTH * INCP * DM * 2;
constexpr size_t SZ_WUQ = (size_t)DEPTH * 768 * QL * 2;
constexpr size_t SZ_WUKV = (size_t)DEPTH * 1024 * KVL * 2;
constexpr size_t SZ_WS = (size_t)DEPTH * 8 * 128 * 128 * 2;
constexpr size_t SZ_W1K = (size_t)DEPTH * DM * DM * 2;
constexpr size_t SZ_WMKV = (size_t)DEPTH * 2048 * DM * 2;
constexpr size_t SZ_WUP = (size_t)DEPTH * 2 * DFF * DM * 2;
constexpr size_t SZ_WDN = (size_t)DEPTH * DM * DFF * 2;
constexpr size_t OFF_WIN = 0;
constexpr size_t OFF_WUQ = OFF_WIN + SZ_WIN;
constexpr size_t OFF_WUKV = OFF_WUQ + SZ_WUQ;
constexpr size_t OFF_WSG = OFF_WUKV + SZ_WUKV;
constexpr size_t OFF_WOUT = OFF_WSG + SZ_WS;
constexpr size_t OFF_WMQ = OFF_WOUT + SZ_W1K;
constexpr size_t OFF_WMKV = OFF_WMQ + SZ_W1K;
constexpr size_t OFF_WMO = OFF_WMKV + SZ_WMKV;
constexpr size_t OFF_WUP = OFF_WMO + SZ_W1K;
constexpr size_t OFF_WDN = OFF_WUP + SZ_WUP;
constexpr size_t OFF_COS = OFF_WDN + SZ_WDN;
constexpr size_t OFF_SIN = OFF_COS + (size_t)TOK * 16 * 4;
constexpr size_t OFF_KMEM = OFF_SIN + (size_t)TOK * 16 * 4;
constexpr size_t SZ_KMEM = (size_t)DEPTH * NBATCH * 4 * 256 * 256 * 2;
constexpr size_t OFF_VMEM = OFF_KMEM + SZ_KMEM;
constexpr size_t OFF_ACT0 = OFF_VMEM + SZ_KMEM;
constexpr size_t OFF_Q = OFF_ACT0;
constexpr size_t OFF_K = OFF_Q + (size_t)TOK * 8 * 96 * 2;
constexpr size_t OFF_VT = OFF_K + (size_t)TOK * 8 * 96 * 2;
constexpr size_t OFF_U = OFF_VT + (size_t)TOK * 512 * 2;
constexpr size_t OFF_V = OFF_U + (size_t)TOK * 512 * 2;
constexpr size_t OFF_OMIX = OFF_V + (size_t)TOK * 512 * 2;
constexpr size_t OFF_HQ = OFF_OMIX + (size_t)TOK * 1024 * 2;
constexpr size_t OFF_HKV = OFF_HQ + (size_t)TOK * 256 * 2;
constexpr size_t OFF_XB = OFF_HKV + (size_t)TOK * 128 * 2;
constexpr size_t OFF_MEMB = OFF_XB + (size_t)TOK * DM * 2;
constexpr size_t OFF_RSC = OFF_MEMB + (size_t)NBATCH * NMEM * DM * 2;
constexpr size_t OFF_BAR = OFF_RSC + (size_t)TOK * 16 * 4;
constexpr size_t BAR_BYTES = 16384;
constexpr size_t OFF_END = OFF_BAR + BAR_BYTES;
constexpr size_t OFF_QM = OFF_Q;
constexpr size_t OFF_OMEM = OFF_OMIX;
constexpr size_t OFF_ACT = OFF_ACT0;
static_assert(OFF_ACT + (size_t)TOK * DFF * 2 <= OFF_XB, "act alias");
static_assert(OFF_END <= (size_t)1000 * 1024 * 1024, "ws budget");

struct Params {
    const float *x, *mem; const int* pos;
    const float *norm_mix_g, *w_in, *q_norm_g, *w_uq, *kv_norm_g, *w_ukv, *sg_ln_g, *sg_ln_b, *sg_w_s, *sg_b_s,
        *out_norm_mla_g, *out_norm_sg_g, *w_out, *norm_mem_g, *mem_norm_g, *w_mq, *w_mkv, *w_mo, *norm_ffn_g, *w_up,
        *conv_w, *conv_b, *w_down, *final_norm_g;
    float* out; char* ws;
};

typedef const __attribute__((address_space(4))) Params* KP;
DI KP kparams() { KP k = (KP)__builtin_amdgcn_kernarg_segment_ptr(); asm volatile("" : "+s"(k)); return k; }
typedef __bf16 bf16v2_t __attribute__((ext_vector_type(2)));
typedef float f32v2_t __attribute__((ext_vector_type(2)));
DI unsigned pack2(float a, float b) { f32v2_t v = {a, b}; return __builtin_bit_cast(unsigned, __builtin_convertvector(v, bf16v2_t)); }
DI bf16_t f2bf(float f) { return (bf16_t)(pack2(f, f) & 0xffffu); }
typedef _Float16 f16x8 __attribute__((ext_vector_type(8)));
typedef _Float16 f16v2_t __attribute__((ext_vector_type(2)));
DI unsigned pack2h(float a, float b) { f16v2_t v = {(_Float16)a, (_Float16)b}; return __builtin_bit_cast(unsigned, v); }
DI bf16_t f2h(float f) { return __builtin_bit_cast(unsigned short, (_Float16)f); }
DI float h2f(bf16_t u) { return (float)__builtin_bit_cast(_Float16, u); }
DI float hlo(unsigned u) { return h2f((bf16_t)(u & 0xffffu)); }
DI float hhi(unsigned u) { return h2f((bf16_t)(u >> 16)); }
#define MFMA_H(a, b, c) __builtin_amdgcn_mfma_f32_32x32x16_f16(__builtin_bit_cast(f16x8, (a)), __builtin_bit_cast(f16x8, (b)), (c), 0, 0, 0)
DI float bf2f(bf16_t b) { return __uint_as_float((unsigned)b << 16); }
DI float bflo(unsigned u) { return __uint_as_float(u << 16); }
DI float bfhi(unsigned u) { return __uint_as_float(u & 0xffff0000u); }
DI float ex2(float x) { return __builtin_amdgcn_exp2f(x); }
DI float gelu_tanh(float x) { float y = 0.7978845608028654f * (x + 0.044715f * x * x * x); return x * __builtin_amdgcn_rcpf(1.f + ex2(-2.f * LOG2E * y)); }
DI float silu(float x) { return x * __builtin_amdgcn_rcpf(1.f + ex2(-LOG2E * x)); }
DI int tid() { int t = threadIdx.x; asm volatile("" : "+v"(t)); return t; }
DI int crow(int r, int h) { return (r & 3) + 8 * (r >> 2) + 4 * h; }
DI int swap23(int r) { return (r & ~12) | ((r & 4) << 1) | ((r & 8) >> 1); }

template <class F> DI void for_tiles(int ntiles, F f) {
    const int G = gridDim.x, b = blockIdx.x;
    const bool sw = (G & 7) == 0;
    const int tpx = (ntiles + 7) >> 3;
    const int start = sw ? (b >> 3) : b, step = sw ? (G >> 3) : G, lim = sw ? tpx : ntiles, base = sw ? (b & 7) * tpx : 0;
    for (int i = start; i < lim; i += step) {
        const int t = base + i;
        if (t < ntiles) f(t);
    }
}

constexpr int LK = 72;
constexpr int GEMM_LDS = 4 * 128 * LK * 2;
constexpr int RS_OFF = GEMM_LDS;
constexpr int LDS_BYTES = GEMM_LDS + 1024;

template <int AMODE, bool F16 = false, bool MASK = false>
DI void gemm_tile(const bf16_t* __restrict__ Ab, int lda, int row0, int rlo, int rhi,
                  const bf16_t* __restrict__ Bt, int ldb, int K, char* smem, f32x16 (&acc)[2][2]) {
    const int t = tid(), lane = t & 63, w = __builtin_amdgcn_readfirstlane(t >> 6), wm = w >> 1, wn = w & 1, l32 = lane & 31, h = lane >> 5;
    bf16_t* As = (bf16_t*)smem;
    bf16_t* Bs = As + 2 * 128 * LK;
    float* rs = (float*)(smem + RS_OFF);
#pragma unroll
    for (int i = 0; i < 2; ++i)
#pragma unroll
        for (int j = 0; j < 2; ++j)
#pragma unroll
            for (int r = 0; r < 16; ++r) acc[i][j][r] = 0.f;

    uint4 p0a0, p0a1, p0a2, p0a3, p0b0, p0b1, p0b2, p0b3, p1a0, p1a1, p1a2, p1a3, p1b0, p1b1, p1b2, p1b3;
    float ss0 = 0.f, ss1 = 0.f, ss2 = 0.f, ss3 = 0.f;
    const int gr0 = row0 + (t >> 3);
    const bool rv0 = gr0 >= rlo && gr0 < rhi, rv1 = gr0 + 32 >= rlo && gr0 + 32 < rhi, rv2 = gr0 + 64 >= rlo && gr0 + 64 < rhi, rv3 = gr0 + 96 >= rlo && gr0 + 96 < rhi;
    const int nk = K >> 6;
    const int rhm = rhi - 1;
    const unsigned aoff0 = (unsigned)min(max(gr0, rlo), rhm) * (unsigned)lda + 8u * (t & 7);
    const unsigned aoff1 = (unsigned)min(max(gr0 + 32, rlo), rhm) * (unsigned)lda + 8u * (t & 7);
    const unsigned aoff2 = (unsigned)min(max(gr0 + 64, rlo), rhm) * (unsigned)lda + 8u * (t & 7);
    const unsigned aoff3 = (unsigned)min(max(gr0 + 96, rlo), rhm) * (unsigned)lda + 8u * (t & 7);
    const unsigned btoff = (unsigned)((t >> 3) * ldb + 8 * (t & 7));

    __syncthreads();

#define LD1(S, j, k0)                                                                                         \
    {                                                                                                         \
        S##a##j = *(const uint4*)(Ab + (k0) + aoff##j);          \
        S##b##j = *(const uint4*)(Bt + (size_t)(32 * j) * ldb + (k0) + btoff);                                \
    }
#define LOADS(S, k0) { LD1(S, 0, k0) LD1(S, 1, k0) LD1(S, 2, k0) LD1(S, 3, k0) }
#define ST1(S, j, buf)                                                                                        \
    {                                                                                                         \
        uint4 v = S##a##j;                                                                                    \
        if constexpr (MASK) { if (!rv##j) v = make_uint4(0, 0, 0, 0); }     \
        if (AMODE == 1) {                                                                                     \
            float a0 = bflo(v.x), a1 = bfhi(v.x), a2 = bflo(v.y), a3 = bfhi(v.y), a4 = bflo(v.z), a5 = bfhi(v.z), a6 = bflo(v.w), a7 = bfhi(v.w); \
            ss##j += a0 * a0 + a1 * a1 + a2 * a2 + a3 * a3 + a4 * a4 + a5 * a5 + a6 * a6 + a7 * a7;          \
        }                                                                                                     \
        *(uint4*)(As + (buf) * 128 * LK + ((t >> 3) + 32 * j) * LK + 8 * (t & 7)) = v;                        \
        *(uint4*)(Bs + (buf) * 128 * LK + ((t >> 3) + 32 * j) * LK + 8 * (t & 7)) = S##b##j;                  \
    }
#define STORES(S, buf) { ST1(S, 0, buf) ST1(S, 1, buf) ST1(S, 2, buf) ST1(S, 3, buf) }
#define FRAGS(ks, A0, A1, B0, B1) { A0 = *(const bf16x8*)(a_s + (ks) * 16); A1 = *(const bf16x8*)(a_s + 32 * LK + (ks) * 16); B0 = *(const bf16x8*)(b_s + (ks) * 16); B1 = *(const bf16x8*)(b_s + 32 * LK + (ks) * 16); }
#define MMAS(A0, A1, B0, B1) { __builtin_amdgcn_s_setprio(1); if constexpr (F16) { acc[0][0] = MFMA_H(A0, B0, acc[0][0]); acc[0][1] = MFMA_H(A0, B1, acc[0][1]); acc[1][0] = MFMA_H(A1, B0, acc[1][0]); acc[1][1] = MFMA_H(A1, B1, acc[1][1]); } else { acc[0][0] = MFMA(A0, B0, acc[0][0]); acc[0][1] = MFMA(A0, B1, acc[0][1]); acc[1][0] = MFMA(A1, B0, acc[1][0]); acc[1][1] = MFMA(A1, B1, acc[1][1]); } __builtin_amdgcn_s_setprio(0); }
#define COMPUTE(buf)                                                                                          \
    {                                                                                                         \
        const bf16_t* a_s = As + (buf) * 128 * LK + (wm * 64 + l32) * LK + h * 8;                             \
        const bf16_t* b_s = Bs + (buf) * 128 * LK + (wn * 64 + l32) * LK + h * 8;                             \
        bf16x8 xa0, xa1, xb0, xb1, ya0, ya1, yb0, yb1;                                                        \
        FRAGS(0, xa0, xa1, xb0, xb1)                                                                          \
        FRAGS(1, ya0, ya1, yb0, yb1)                                                                          \
        MMAS(xa0, xa1, xb0, xb1)                                                                              \
        FRAGS(2, xa0, xa1, xb0, xb1)                                                                          \
        MMAS(ya0, ya1, yb0, yb1)                                                                              \
        FRAGS(3, ya0, ya1, yb0, yb1)                                                                          \
        MMAS(xa0, xa1, xb0, xb1)                                                                              \
        MMAS(ya0, ya1, yb0, yb1)                                                                              \
    }

    const int klast = (nk - 1) * 64;
    LOADS(p0, 0);
    LOADS(p1, 64);
    STORES(p0, 0);
    LOADS(p0, min(128, klast));
    __syncthreads();
    for (int kt = 0; kt < nk; kt += 2) {
        COMPUTE(0);
        STORES(p1, 1);
        LOADS(p1, min((kt + 3) * 64, klast));
        __syncthreads();
        COMPUTE(1);
        if (kt + 2 < nk) STORES(p0, 0);
        LOADS(p0, min((kt + 4) * 64, klast));
        __syncthreads();
    }
#undef LOADS
#undef STORES
#undef COMPUTE
#undef FRAGS
#undef MMAS
#undef LD1
#undef ST1
    if (AMODE == 1) {
#define RS1(j) { float s = ss##j; s += __shfl_xor(s, 1); s += __shfl_xor(s, 2); s += __shfl_xor(s, 4); if ((t & 7) == 0) rs[(t >> 3) + 32 * j] = rsqrtf(s / (float)K + EPS); }
        RS1(0) RS1(1) RS1(2) RS1(3)
#undef RS1
        __syncthreads();
    }
}

DI float rs_load(KP p, int row0) {
    const int t = tid(), r = row0 + (t >> 1);
    float sum = 0.f;
    if (r >= 0 && r < TOK) {
        const float4* ps = (const float4*)((const float*)(p->ws + OFF_RSC) + (size_t)r * 16 + (t & 1) * 8);
        const float4 a = ps[0], b = ps[1];
        sum = (a.x + a.y) + (a.z + a.w) + (b.x + b.y) + (b.z + b.w);
    }
    return sum;
}
DI void rs_finish(float sum, int row0, char* smem) {
    const int t = tid(), r = row0 + (t >> 1);
    sum += __shfl_xor(sum, 1);
    if ((t & 1) == 0) ((float*)(smem + RS_OFF))[t >> 1] = (r >= 0 && r < TOK) ? rsqrtf(sum * (1.f / DM) + EPS) : 0.f;
    __syncthreads();
}

DI void tile_rc(int t, int NT, int& rt, int& ct) { const int g = t / (8 * NT), rem = t - g * 8 * NT; ct = rem >> 3; rt = g * 8 + (rem & 7); }

template <class E> DI void run_epi(const f32x16 (&acc)[2][2], const E& e) {
    const int w = __builtin_amdgcn_readfirstlane(tid() >> 6), wm = w >> 1, wn = w & 1;
#pragma unroll
    for (int i = 0; i < 2; ++i)
#pragma unroll
        for (int j = 0; j < 2; ++j) e(wm * 64 + i * 32, wn * 64 + j * 32, acc[i][j]);
}

DI int up_perm(int n) { return n < DFF ? (n >> 6) * 128 + (n & 63) : ((n - DFF) >> 6) * 128 + 64 + ((n - DFF) & 63); }

DI void conv_tile(const float* __restrict__ src, int K, int N, const float* g1, const float* g2, int ksplit,
                  bf16_t* __restrict__ dst, int rowmap, int tile, float* lds, int mode, bool f16 = false) {
    const int ntn = N >> 5, tk = tile / ntn, tn = tile - tk * ntn, k0 = tk * 32, n0 = tn * 32;
    const int tx = tid() & 31, ty = tid() >> 5;
    if (mode == 0) {
#pragma unroll
        for (int i = 0; i < 4; ++i) {
            int k = k0 + ty + 8 * i;
            float v = src[(size_t)k * N + n0 + tx];
            float g = g1 ? (k < ksplit ? g1[k] : g2[k - ksplit]) : 1.f;
            lds[(ty + 8 * i) * 33 + tx] = v * g;
        }
    } else {
#pragma unroll
        for (int i = 0; i < 4; ++i) {
            int n = n0 + ty + 8 * i;
            int nn = rowmap ? up_perm(n) : n;
            const float wv = lds[tx * 33 + ty + 8 * i];
            dst[(size_t)nn * K + k0 + tx] = f16 ? f2h(wv) : f2bf(wv);
        }
    }
}

__device__ void phase_setup(KP p, char* smem) {
    float* lds = (float*)smem;
    char* ws = p->ws;
    constexpr int PER_LAYER = 1440 + 192 + 128 + 1024 + 1024 + 2048 + 1024 + 5632 + 2816;
    auto job = [&](int t, float* ldsq, int mode) __attribute__((always_inline)) {
        int l = t / PER_LAYER, r = t - l * PER_LAYER;
        if (r < 1440) conv_tile(p->w_in + (size_t)l * DM * INC, DM, INC, p->norm_mix_g + l * DM, nullptr, DM, (bf16_t*)(ws + OFF_WIN) + (size_t)l * INCP * DM, 0, r, ldsq, mode, true);
        else if ((r -= 1440) < 192) conv_tile(p->w_uq + (size_t)l * QL * 768, QL, 768, p->q_norm_g + l * QL, nullptr, QL, (bf16_t*)(ws + OFF_WUQ) + (size_t)l * 768 * QL, 0, r, ldsq, mode);
        else if ((r -= 192) < 128) conv_tile(p->w_ukv + (size_t)l * KVL * 1024, KVL, 1024, p->kv_norm_g + l * KVL, nullptr, KVL, (bf16_t*)(ws + OFF_WUKV) + (size_t)l * 1024 * KVL, 0, r, ldsq, mode);
        else if ((r -= 128) < 1024) conv_tile(p->w_out + (size_t)l * DM * DM, DM, DM, p->out_norm_mla_g + l * 512, p->out_norm_sg_g + l * 512, 512, (bf16_t*)(ws + OFF_WOUT) + (size_t)l * DM * DM, 0, r, ldsq, mode);
        else if ((r -= 1024) < 1024) conv_tile(p->w_mq + (size_t)l * DM * DM, DM, DM, p->norm_mem_g + l * DM, nullptr, DM, (bf16_t*)(ws + OFF_WMQ) + (size_t)l * DM * DM, 0, r, ldsq, mode, true);
        else if ((r -= 1024) < 2048) conv_tile(p->w_mkv + (size_t)l * DM * 2048, DM, 2048, p->mem_norm_g + l * DM, nullptr, DM, (bf16_t*)(ws + OFF_WMKV) + (size_t)l * 2048 * DM, 0, r, ldsq, mode);
        else if ((r -= 2048) < 1024) conv_tile(p->w_mo + (size_t)l * DM * DM, DM, DM, nullptr, nullptr, DM, (bf16_t*)(ws + OFF_WMO) + (size_t)l * DM * DM, 0, r, ldsq, mode);
        else if ((r -= 1024) < 5632) conv_tile(p->w_up + (size_t)l * DM * 2 * DFF, DM, 2 * DFF, p->norm_ffn_g + l * DM, nullptr, DM, (bf16_t*)(ws + OFF_WUP) + (size_t)l * 2 * DFF * DM, 1, r, ldsq, mode, true);
        else { r -= 5632; conv_tile(p->w_down + (size_t)l * DFF * DM, DFF, DM, nullptr, nullptr, DFF, (bf16_t*)(ws + OFF_WDN) + (size_t)l * DM * DFF, 0, r, ldsq, mode); }
    };
    constexpr int NJOB = PER_LAYER * DEPTH, TPB = 4;
    for (int t0 = blockIdx.x; t0 < NJOB; t0 += TPB * gridDim.x) {
#pragma unroll
        for (int u = 0; u < TPB; ++u) { const int t = t0 + u * gridDim.x; if (t < NJOB) job(t, lds + u * 32 * 33, 0); }
        __syncthreads();
#pragma unroll
        for (int u = 0; u < TPB; ++u) { const int t = t0 + u * gridDim.x; if (t < NJOB) job(t, lds + u * 32 * 33, 1); }
        __syncthreads();
    }
    const size_t gt = (size_t)blockIdx.x * 256 + tid(), gn = (size_t)gridDim.x * 256;
    bf16_t* wsg = (bf16_t*)(ws + OFF_WSG);
    for (size_t i = gt; i < (size_t)DEPTH * 8 * 128 * 128; i += gn) wsg[i] = f2bf(p->sg_w_s[i]);
    for (size_t i = gt; i < (size_t)DEPTH * 96 * DM; i += gn) {
        size_t l = i / (96 * DM), r = i - l * (96 * DM);
        ((bf16_t*)(ws + OFF_WIN))[(l * INCP + INC) * DM + r] = 0;
    }
    {
        {
            const int lane = tid() & 63, wv = blockIdx.x * 4 + (tid() >> 6), nw = gridDim.x * 4;
            float* rsc = (float*)(ws + OFF_RSC);
            for (int row = wv; row < TOK; row += nw) {
                const float4* xs = (const float4*)(p->x + (size_t)row * DM); uint2* xd = (uint2*)(ws + OFF_XB) + (size_t)row * (DM / 4);
                float sacc = 0.f;
#pragma unroll
                for (int i = 0; i < 4; ++i) { float4 v = xs[lane + 64 * i]; sacc += v.x * v.x + v.y * v.y + v.z * v.z + v.w * v.w; uint2 o; o.x = pack2h(v.x, v.y); o.y = pack2h(v.z, v.w); xd[lane + 64 * i] = o; }
#pragma unroll
                for (int o = 1; o < 64; o <<= 1) sacc += __shfl_xor(sacc, o);
                if (lane < 16) rsc[(size_t)row * 16 + lane] = lane == 0 ? sacc : 0.f;
            }
        }
        const float4* ms = (const float4*)p->mem; uint2* md = (uint2*)(ws + OFF_MEMB);
        for (size_t i = gt; i < (size_t)NBATCH * NMEM * DM / 4; i += gn) { float4 v = ms[i]; uint2 o; o.x = pack2(v.x, v.y); o.y = pack2(v.z, v.w); md[i] = o; }
    }
    float* cs = (float*)(ws + OFF_COS); float* sn = (float*)(ws + OFF_SIN);
    for (size_t i = gt; i < (size_t)TOK * 16; i += gn) {
        int tok = (int)(i >> 4), f = (int)(i & 15);
        const float inv = ex2(-(float)f * 0.83048202372184058f);
        const float ang = (float)p->pos[tok] * inv;
        const float c_hi = 0.15915494309189535f, c_lo = 6.4206383e-9f;
        const float rh = ang * c_hi;
        const float re = fmaf(ang, c_hi, -rh) + ang * c_lo;
        float rf = (rh - floorf(rh)) + re;
        cs[i] = __builtin_amdgcn_cosf(rf);
        sn[i] = __builtin_amdgcn_sinf(rf);
    }
}

struct EpiMemKV {
    bf16_t* km; bf16_t* vm; const float* rs; int row0, col0;
    DI void operator()(int rb, int cb, const f32x16& a) const {
        const int lane = tid() & 63, c = lane & 31, h = lane >> 5;
        const int n0 = col0 + cb;
        if (n0 < 1024) {
            const int head = n0 >> 8, d = (n0 & 255) + c;
#pragma unroll
            for (int r = 0; r < 16; ++r) {
                int row = rb + crow(r, h), gr = row0 + row, b = gr >> 8, key = gr & 255;
                km[(((size_t)(b * 4 + head)) * 256 + key) * 256 + d] = f2bf(a[r] * rs[row]);
            }
        } else {
            const int head = (n0 - 1024) >> 8, d = ((n0 - 1024) & 255) + c;
#pragma unroll
            for (int g = 0; g < 4; ++g) {
                int row = rb + 8 * g + 4 * h, gr = row0 + row, b = gr >> 8, key = gr & 255;
                uint2 pk;
                pk.x = pack2(a[4 * g] * rs[row], a[4 * g + 1] * rs[row + 1]);
                pk.y = pack2(a[4 * g + 2] * rs[row + 2], a[4 * g + 3] * rs[row + 3]);
                *(uint2*)(vm + (((size_t)(b * 4 + head)) * 256 + d) * 256 + key) = pk;
            }
        }
    }
};

struct EpiIn {
    bf16_t *hq, *hkv, *u, *v, *kb; const float *cs, *sn, *rs; int row0, col0;
    DI void operator()(int rb, int cb, const f32x16& a) const {
        const int lane = tid() & 63, c = lane & 31, h = lane >> 5;
        const int nb = col0 + cb;
        if (nb >= INC) return;
        if (nb == 384) {
#pragma unroll
            for (int r = 0; r < 16; ++r) {
                const int row = rb + crow(r, h), tok = row0 + row;
                const float val = a[r] * rs[row];
                float pt = __shfl_xor(val, 16);
                float co = cs[tok * 16 + (c & 15)], si = sn[tok * 16 + (c & 15)];
                float o = (c < 16) ? val * co - pt * si : val * co + pt * si;
                bf16_t ob = f2bf(o);
                const int b = tok >> 13, s = tok & 8191;
                bf16_t* dst = kb + (((size_t)(b * 8)) * SEQ + s) * 96 + 64 + c;
                for (int hd = 0; hd < 8; ++hd) dst[(size_t)hd * SEQ * 96] = ob;
            }
            return;
        }
        bf16_t* dst; int pitch, off; bool act;
        if (nb < 256) { dst = hq; pitch = 256; off = nb; act = false; }
        else if (nb < 384) { dst = hkv; pitch = 128; off = nb - 256; act = false; }
        else if (nb < 928) { dst = u; pitch = 512; off = nb - 416; act = true; }
        else { dst = v; pitch = 512; off = nb - 928; act = true; }
        dst += (size_t)(row0 + rb + 4 * h) * pitch + off + c;
#pragma unroll
        for (int r = 0; r < 16; ++r) {
            const int rr = (r & 3) + 8 * (r >> 2);
            float val = a[r] * rs[rb + rr + 4 * h];
            if (act) val = gelu_tanh(val);
            dst[(size_t)rr * pitch] = f2bf(val);
        }
    }
};

struct EpiQ {
    bf16_t* q; const float *cs, *sn, *rs; int row0, col0;
    DI void operator()(int rb, int cb, const f32x16& a) const {
        const int lane = tid() & 63, c = lane & 31, h = lane >> 5;
        const int n0 = col0 + cb, head = n0 / 96, w0 = n0 - head * 96;
        const float qs = 0.10206207261596575f * LOG2E;
#pragma unroll
        for (int r = 0; r < 16; ++r) {
            const int row = rb + crow(r, h), tok = row0 + row;
            float val = a[r] * rs[row] * qs;
            if (w0 == 64) {
                float pt = __shfl_xor(val, 16);
                float co = cs[tok * 16 + (c & 15)], si = sn[tok * 16 + (c & 15)];
                val = (c < 16) ? val * co - pt * si : val * co + pt * si;
            }
            const int b = tok >> 13, s = tok & 8191;
            q[(((size_t)(b * 8 + head)) * SEQ + s) * 96 + w0 + c] = f2bf(val);
        }
    }
};

struct EpiKV {
    bf16_t *kb, *vstage; const float* rs; int row0, col0;
    DI void operator()(int rb, int cb, const f32x16& a) const {
        const int lane = tid() & 63, c = lane & 31, h = lane >> 5;
        const int n0 = col0 + cb, head = n0 >> 7, w0 = n0 & 127;
        if (w0 < 64) {
#pragma unroll
            for (int r = 0; r < 16; ++r) {
                const int row = rb + crow(r, h), tok = row0 + row, b = tok >> 13, s = tok & 8191;
                kb[(((size_t)(b * 8 + head)) * SEQ + s) * 96 + w0 + c] = f2bf(a[r] * rs[row]);
            }
        } else {
            const int d = w0 - 64 + c;
#pragma unroll
            for (int g = 0; g < 4; ++g) {
                const int row = rb + 8 * g + 4 * h;
                uint2 pk;
                pk.x = pack2(a[4 * g] * rs[row], a[4 * g + 1] * rs[row + 1]);
                pk.y = pack2(a[4 * g + 2] * rs[row + 2], a[4 * g + 3] * rs[row + 3]);
                *(uint2*)(vstage + d * 136 + row) = pk;
            }
        }
    }
};

struct EpiRes {
    bf16_t* xb; int row0, col0; bool dry;
    DI void operator()(int rb, int cb, const f32x16& a, f32x16& sq) const {
        const int lane = tid() & 63, c = lane & 31, h = lane >> 5;
        if (dry && a[0] != 1.2345e30f) return;
        bf16_t* ptr = xb + (size_t)(row0 + rb + 4 * h) * DM + col0 + cb + c;
#pragma unroll
        for (int r = 0; r < 16; ++r) {
            const int rr = (r & 3) + 8 * (r >> 2);
            const bf16_t nb = f2h(h2f(ptr[(size_t)rr * DM]) + a[r]);
            ptr[(size_t)rr * DM] = nb;
            const float nv = h2f(nb);
            sq[r] += nv * nv;
        }
    }
};

struct EpiQm {
    bf16_t* qm; const float* rs; int row0, col0;
    DI void operator()(int rb, int cb, const f32x16& a) const {
        const int lane = tid() & 63, c = lane & 31, h = lane >> 5;
#pragma unroll
        for (int r = 0; r < 16; ++r) {
            const int row = rb + crow(r, h);
            qm[(size_t)(row0 + row) * DM + col0 + cb + c] = f2bf(a[r] * rs[row] * (0.0625f * LOG2E));
        }
    }
};

template <int DQK, int DV, int NBUF, bool QREG, int QW, int LDQ, int LDK, int LDV, int LDO>
DI void flash_item(const bf16_t* __restrict__ Qp, const bf16_t* __restrict__ Kp, const bf16_t* __restrict__ Vtp, int nkt,
                   bf16_t* __restrict__ Op, char* smem, float& ssq) {
    constexpr int KP = DQK + 8;
    constexpr int VP = 72;
    constexpr int CPR = DQK / 8;
    constexpr int KCH = 64 * CPR / 256;
    constexpr int VCH = DV * 8 / 256;
    constexpr int NKS = DQK / 16, NMT = DV / 32 / QW;
    constexpr bool KROWS = (256 % CPR) == 0;
    static_assert(KROWS || LDK == DQK, "K tile addressing");
    static_assert(KCH <= 8 && VCH <= 8, "staging regs");
    static_assert(NBUF == 2 ? (KCH <= 4 && VCH <= 2) : (KCH == 8 && VCH == 8), "staging");
    bf16_t* Ks = (bf16_t*)smem;
    bf16_t* Vs = Ks + NBUF * 64 * KP;
    const int t = tid(), lane = t & 63, w = __builtin_amdgcn_readfirstlane(t >> 6), l32 = lane & 31, h = lane >> 5;
    const int q = (w / QW) * 32 + l32, dv0 = (w % QW) * (DV / QW);
    const unsigned ktoff = KROWS ? (unsigned)((t / CPR) * LDK + (t % CPR) * 8) : (unsigned)(t * 8);
    const unsigned vtoff = (unsigned)((t >> 3) * LDV + (t & 7) * 8);

    bf16x8 qf[QREG ? NKS : 1];
    if constexpr (QREG) {
#pragma unroll
        for (int ks = 0; ks < NKS; ++ks) qf[ks] = *(const bf16x8*)(Qp + (size_t)q * LDQ + ks * 16 + 8 * h);
    }
    f32x16 o[NMT];
#pragma unroll
    for (int mt = 0; mt < NMT; ++mt)
#pragma unroll
        for (int r = 0; r < 16; ++r) o[mt][r] = 0.f;
    float m = -INFINITY, lsum = 0.f;

    uint4 rk0, rk1, rk2, rk3, rk4, rk5, rk6, rk7, rv0, rv1;
    (void)rk0; (void)rk1; (void)rk2; (void)rk3; (void)rk4; (void)rk5; (void)rk6; (void)rk7; (void)rv0; (void)rv1;
#define LKJ(kt, i, R) { const bf16_t* kb_ = KROWS ? Kp + (size_t)((kt) * 64 + (i) * (256 / CPR)) * LDK : Kp + (size_t)(kt) * 64 * DQK + (i) * 2048; R = *(const uint4*)(kb_ + ktoff); }
#define SKJ(buf, i, R) { int c = t + 256 * (i), row = c / CPR, cc = c - row * CPR; *(uint4*)(Ks + (buf) * 64 * KP + swap23(row) * KP + cc * 8) = R; }
#define LVJ(kt, i, R) { const bf16_t* vb_ = Vtp + (size_t)(i) * 32 * LDV + (kt) * 64; R = *(const uint4*)(vb_ + vtoff); }
#define SVJ(buf, i, R) { int c = t + 256 * (i), d = c >> 3, cc = c & 7; *(uint4*)(Vs + (buf) * DV * VP + d * VP + cc * 8) = R; }
#define ATT_LOAD(kt) { LKJ(kt, 0, rk0) if constexpr (KCH > 1) LKJ(kt, 1, rk1) if constexpr (KCH > 2) LKJ(kt, 2, rk2) if constexpr (KCH > 3) LKJ(kt, 3, rk3) LVJ(kt, 0, rv0) if constexpr (VCH > 1) LVJ(kt, 1, rv1) }
#define ATT_STORE(buf) { SKJ(buf, 0, rk0) if constexpr (KCH > 1) SKJ(buf, 1, rk1) if constexpr (KCH > 2) SKJ(buf, 2, rk2) if constexpr (KCH > 3) SKJ(buf, 3, rk3) SVJ(buf, 0, rv0) if constexpr (VCH > 1) SVJ(buf, 1, rv1) }

    __syncthreads();
    if constexpr (NBUF == 2) ATT_LOAD(0);
    for (int kt = 0; kt < nkt; ++kt) {
        const int buf = (NBUF == 2) ? (kt & 1) : 0;
        if constexpr (NBUF == 1) {
            __syncthreads();
            LKJ(kt, 0, rk0) LKJ(kt, 1, rk1) LKJ(kt, 2, rk2) LKJ(kt, 3, rk3)
            LKJ(kt, 4, rk4) LKJ(kt, 5, rk5) LKJ(kt, 6, rk6) LKJ(kt, 7, rk7)
            SKJ(0, 0, rk0) SKJ(0, 1, rk1) SKJ(0, 2, rk2) SKJ(0, 3, rk3)
            asm volatile("" ::: "memory");
            LVJ(kt, 0, rk0) LVJ(kt, 1, rk1) LVJ(kt, 2, rk2) LVJ(kt, 3, rk3)
            SKJ(0, 4, rk4) SKJ(0, 5, rk5) SKJ(0, 6, rk6) SKJ(0, 7, rk7)
            asm volatile("" ::: "memory");
            LVJ(kt, 4, rk4) LVJ(kt, 5, rk5) LVJ(kt, 6, rk6) LVJ(kt, 7, rk7)
            SVJ(0, 0, rk0) SVJ(0, 1, rk1) SVJ(0, 2, rk2) SVJ(0, 3, rk3)
            asm volatile("" ::: "memory");
            SVJ(0, 4, rk4) SVJ(0, 5, rk5) SVJ(0, 6, rk6) SVJ(0, 7, rk7)
        } else { ATT_STORE(buf); }
        __syncthreads();
        if constexpr (NBUF == 2) { if (kt + 1 < nkt) ATT_LOAD(kt + 1); }

        const bf16_t* kb = Ks + buf * 64 * KP + l32 * KP + 8 * h;
        f32x16 s0, s1;
#pragma unroll
        for (int r = 0; r < 16; ++r) { s0[r] = 0.f; s1[r] = 0.f; }
#pragma unroll
        for (int ks = 0; ks < NKS; ++ks) {
            bf16x8 qq;
            if constexpr (QREG) qq = qf[ks]; else qq = *(const bf16x8*)(Qp + (size_t)q * LDQ + ks * 16 + 8 * h);
            bf16x8 k0 = *(const bf16x8*)(kb + ks * 16);
            bf16x8 k1 = *(const bf16x8*)(kb + 32 * KP + ks * 16);
            s0 = MFMA(k0, qq, s0);
            s1 = MFMA(k1, qq, s1);
        }
        float mx = s0[0];
#pragma unroll
        for (int r = 1; r < 16; ++r) mx = fmaxf(mx, s0[r]);
#pragma unroll
        for (int r = 0; r < 16; ++r) mx = fmaxf(mx, s1[r]);
        mx = fmaxf(mx, __shfl_xor(mx, 32));
        const float mn = fmaxf(m, mx);
        const float alpha = ex2(m - mn);
        m = mn;
        float psum = 0.f;
#pragma unroll
        for (int r = 0; r < 16; ++r) { s0[r] = ex2(s0[r] - mn); psum += s0[r]; }
#pragma unroll
        for (int r = 0; r < 16; ++r) { s1[r] = ex2(s1[r] - mn); psum += s1[r]; }
        lsum = lsum * alpha + psum;
        if (__builtin_amdgcn_ballot_w64(alpha != 1.f) != 0ull) {
#pragma unroll
            for (int mt = 0; mt < NMT; ++mt)
#pragma unroll
                for (int r = 0; r < 16; ++r) o[mt][r] *= alpha;
        }
        const bf16_t* vb = Vs + buf * DV * VP + (dv0 + l32) * VP + 8 * h;
#pragma unroll
        for (int t2 = 0; t2 < 2; ++t2)
#pragma unroll
            for (int s2 = 0; s2 < 2; ++s2) {
                u32x4 pu;
#pragma unroll
                for (int j = 0; j < 4; ++j)
                    pu[j] = t2 ? pack2(s1[8 * s2 + 2 * j], s1[8 * s2 + 2 * j + 1]) : pack2(s0[8 * s2 + 2 * j], s0[8 * s2 + 2 * j + 1]);
                const bf16x8 pfv = __builtin_bit_cast(bf16x8, pu);
#pragma unroll
                for (int mt = 0; mt < NMT; ++mt) {
                    bf16x8 vv = *(const bf16x8*)(vb + mt * 32 * VP + t2 * 32 + s2 * 16);
                    o[mt] = MFMA(vv, pfv, o[mt]);
                }
            }
    }
#undef ATT_LOAD
#undef ATT_STORE
#undef LKJ
#undef SKJ
#undef LVJ
#undef SVJ
    const float inv = 1.f / (lsum + __shfl_xor(lsum, 32));
#pragma unroll
    for (int mt = 0; mt < NMT; ++mt)
#pragma unroll
        for (int g = 0; g < 4; ++g) {
            float v0 = o[mt][4 * g] * inv, v1 = o[mt][4 * g + 1] * inv, v2 = o[mt][4 * g + 2] * inv, v3 = o[mt][4 * g + 3] * inv;
            uint2 pk; pk.x = pack2(v0, v1); pk.y = pack2(v2, v3);
            float r0 = bflo(pk.x), r1 = bfhi(pk.x), r2 = bflo(pk.y), r3 = bfhi(pk.y);
            ssq += r0 * r0 + r1 * r1 + r2 * r2 + r3 * r3;
            *(uint2*)(Op + (size_t)q * LDO + dv0 + mt * 32 + 8 * g + 4 * h) = pk;
        }
}

DI void flash_mla2(const bf16_t* __restrict__ Qp, const bf16_t* __restrict__ Kp, const bf16_t* __restrict__ Vtp,
                   bf16_t* __restrict__ Op, char* smem, float& ssq) {
    constexpr int DQK = 96, DV = 64, LDQ = 96, LDV = SEQ, LDO = DM, NKT = SEQ / 64;
    constexpr int KP = DQK + 8, VP = 72, CPR = DQK / 8, NKS = DQK / 16, NMT = DV / 32;
    bf16_t* Ks = (bf16_t*)smem;
    bf16_t* Vs = Ks + 2 * 64 * KP;
    const int t = tid(), lane = t & 63, w = __builtin_amdgcn_readfirstlane(t >> 6), l32 = lane & 31, h = lane >> 5;
    const int q = w * 32 + l32;
    const unsigned ktoff = (unsigned)(t * 8);
    const unsigned vtoff = (unsigned)((t >> 3) * LDV + (t & 7) * 8);
    bf16x8 qf[NKS];
#pragma unroll
    for (int ks = 0; ks < NKS; ++ks) qf[ks] = *(const bf16x8*)(Qp + (size_t)q * LDQ + ks * 16 + 8 * h);
    f32x16 o[NMT];
#pragma unroll
    for (int mt = 0; mt < NMT; ++mt)
#pragma unroll
        for (int r = 0; r < 16; ++r) o[mt][r] = 0.f;
    float m = 0.f, lsum = 0.f;
    uint4 ak0, ak1, ak2, av0, av1, bk0, bk1, bk2, bv0, bv1;
#define M2_LOAD(S, kt) { const bf16_t* kb_ = Kp + (size_t)(kt) * 64 * DQK; S##k0 = *(const uint4*)(kb_ + ktoff); S##k1 = *(const uint4*)(kb_ + 2048 + ktoff); S##k2 = *(const uint4*)(kb_ + 4096 + ktoff); \
        const bf16_t* vb_ = Vtp + (kt) * 64; S##v0 = *(const uint4*)(vb_ + vtoff); S##v1 = *(const uint4*)(vb_ + (size_t)32 * LDV + vtoff); }
#define M2_SK(i, R, buf) { int c = t + 256 * (i), row = c / CPR, cc = c - row * CPR; *(uint4*)(Ks + (buf) * 64 * KP + swap23(row) * KP + cc * 8) = R; }
#define M2_SV(i, R, buf) { int c = t + 256 * (i), d = c >> 3, cc = c & 7; *(uint4*)(Vs + (buf) * DV * VP + d * VP + cc * 8) = R; }
#define M2_STORE(S, buf) { M2_SK(0, S##k0, buf) M2_SK(1, S##k1, buf) M2_SK(2, S##k2, buf) M2_SV(0, S##v0, buf) M2_SV(1, S##v1, buf) }
#define M2_COMPUTE(buf) { \
        if (__builtin_amdgcn_ballot_w64(alpha != 1.f) != 0ull) { \
            _Pragma("unroll") for (int mt = 0; mt < NMT; ++mt) _Pragma("unroll") for (int r = 0; r < 16; ++r) o[mt][r] *= alpha; } \
        lsum *= alpha; \
        const bf16_t* kb = Ks + (buf) * 64 * KP + l32 * KP + 8 * h; \
        f32x16 s0, s1; \
        const float nm = -m; \
        _Pragma("unroll") for (int r = 0; r < 16; ++r) { s0[r] = nm; s1[r] = nm; } \
        _Pragma("unroll") for (int ks = 0; ks < NKS; ++ks) { bf16x8 k0 = *(const bf16x8*)(kb + ks * 16); bf16x8 k1 = *(const bf16x8*)(kb + 32 * KP + ks * 16); s0 = MFMA(k0, qf[ks], s0); s1 = MFMA(k1, qf[ks], s1); } \
        float mx = s0[0]; \
        _Pragma("unroll") for (int r = 1; r < 16; ++r) mx = fmaxf(mx, s0[r]); \
        _Pragma("unroll") for (int r = 0; r < 16; ++r) mx = fmaxf(mx, s1[r]); \
        mx = fmaxf(mx, __shfl_xor(mx, 32)); \
        float psum = 0.f; \
        _Pragma("unroll") for (int r = 0; r < 16; ++r) { s0[r] = ex2(s0[r]); psum += s0[r]; } \
        _Pragma("unroll") for (int r = 0; r < 16; ++r) { s1[r] = ex2(s1[r]); psum += s1[r]; } \
        lsum += psum; \
        const float dgrow = fmaxf(mx, 0.f); alpha = ex2(-dgrow); m += dgrow; \
        const bf16_t* vb = Vs + (buf) * DV * VP + l32 * VP + 8 * h; \
        _Pragma("unroll") for (int s2 = 0; s2 < 2; ++s2) { \
            u32x4 pu0, pu1; \
            _Pragma("unroll") for (int j = 0; j < 4; ++j) { pu0[j] = pack2(s0[8 * s2 + 2 * j], s0[8 * s2 + 2 * j + 1]); pu1[j] = pack2(s1[8 * s2 + 2 * j], s1[8 * s2 + 2 * j + 1]); } \
            const bf16x8 pf0 = __builtin_bit_cast(bf16x8, pu0), pf1 = __builtin_bit_cast(bf16x8, pu1); \
            _Pragma("unroll") for (int mt = 0; mt < NMT; ++mt) { \
                bf16x8 v0 = *(const bf16x8*)(vb + mt * 32 * VP + s2 * 16); bf16x8 v1 = *(const bf16x8*)(vb + mt * 32 * VP + 32 + s2 * 16); \
                o[mt] = MFMA(v0, pf0, o[mt]); o[mt] = MFMA(v1, pf1, o[mt]); } } }

    float alpha = 1.f;
    __syncthreads();
    M2_LOAD(a, 0);
    M2_LOAD(b, 1);
    {
        M2_STORE(a, 0);
        __syncthreads();
        const bf16_t* kb = Ks + l32 * KP + 8 * h;
        f32x16 s0, s1;
#pragma unroll
        for (int r = 0; r < 16; ++r) { s0[r] = 0.f; s1[r] = 0.f; }
#pragma unroll
        for (int ks = 0; ks < NKS; ++ks) { bf16x8 k0 = *(const bf16x8*)(kb + ks * 16); bf16x8 k1 = *(const bf16x8*)(kb + 32 * KP + ks * 16); s0 = MFMA(k0, qf[ks], s0); s1 = MFMA(k1, qf[ks], s1); }
        float mx = s0[0];
#pragma unroll
        for (int r = 1; r < 16; ++r) mx = fmaxf(mx, s0[r]);
#pragma unroll
        for (int r = 0; r < 16; ++r) mx = fmaxf(mx, s1[r]);
        m = fmaxf(mx, __shfl_xor(mx, 32));
        __syncthreads();
    }
    for (int kt = 0; kt < NKT; kt += 2) {
        M2_STORE(a, 0);
        __syncthreads();
        M2_LOAD(a, min(kt + 2, NKT - 1));
        M2_COMPUTE(0);
        M2_STORE(b, 1);
        __syncthreads();
        M2_LOAD(b, min(kt + 3, NKT - 1));
        M2_COMPUTE(1);
    }
#undef M2_LOAD
#undef M2_SK
#undef M2_SV
#undef M2_STORE
#undef M2_COMPUTE
    const float inv = 1.f / (lsum + __shfl_xor(lsum, 32));
#pragma unroll
    for (int mt = 0; mt < NMT; ++mt)
#pragma unroll
        for (int g = 0; g < 4; ++g) {
            float v0 = o[mt][4 * g] * inv, v1 = o[mt][4 * g + 1] * inv, v2 = o[mt][4 * g + 2] * inv, v3 = o[mt][4 * g + 3] * inv;
            uint2 pk; pk.x = pack2(v0, v1); pk.y = pack2(v2, v3);
            float r0 = bflo(pk.x), r1 = bfhi(pk.x), r2 = bflo(pk.y), r3 = bfhi(pk.y);
            ssq += r0 * r0 + r1 * r1 + r2 * r2 + r3 * r3;
            *(uint2*)(Op + (size_t)q * LDO + mt * 32 + 8 * g + 4 * h) = pk;
        }
}

DI void mla_item(KP p, int item, char* smem) {
    const int b = item >> 6, qb = item & 63;
    const bf16_t* Q = (const bf16_t*)(p->ws + OFF_Q);
    const bf16_t* K = (const bf16_t*)(p->ws + OFF_K);
    const bf16_t* Vt = (const bf16_t*)(p->ws + OFF_VT);
    bf16_t* om = (bf16_t*)(p->ws + OFF_OMIX) + ((size_t)b * SEQ + qb * 128) * DM;
    float ssq = 0.f;
    for (int hd = 0; hd < 8; ++hd) {
        const size_t bh = (size_t)(b * 8 + hd);
        flash_mla2(Q + (bh * SEQ + qb * 128) * 96, K + bh * SEQ * 96, Vt + bh * 64 * SEQ, om + hd * 64, smem, ssq);
    }
    ssq += __shfl_xor(ssq, 32);
    const float sc = rsqrtf(ssq * (1.f / 512.f) + EPS);
    const int lane = tid() & 63, w = tid() >> 6, q = w * 32 + (lane & 31), h = lane >> 5;
    for (int i = 0; i < 64; ++i) {
        uint2* ptr = (uint2*)(om + (size_t)q * DM + (i >> 3) * 64 + ((i >> 2) & 1) * 32 + (i & 3) * 8 + 4 * h);
        uint2 v = *ptr;
        v.x = pack2(bflo(v.x) * sc, bfhi(v.x) * sc);
        v.y = pack2(bflo(v.y) * sc, bfhi(v.y) * sc);
        *ptr = v;
    }
}

DI void memattn_item(KP p, int l, int item, char* smem) {
    const int head = item & 3, qt = (item >> 2) & 127, b = item >> 9;
    const bf16_t* qm = (const bf16_t*)(p->ws + OFF_QM) + ((size_t)b * SEQ + qt * 64) * DM + head * 256;
    const bf16_t* km = (const bf16_t*)(p->ws + OFF_KMEM) + ((size_t)((l * NBATCH + b) * 4 + head)) * 256 * 256;
    const bf16_t* vm = (const bf16_t*)(p->ws + OFF_VMEM) + ((size_t)((l * NBATCH + b) * 4 + head)) * 256 * 256;
    bf16_t* om = (bf16_t*)(p->ws + OFF_OMEM) + ((size_t)b * SEQ + qt * 64) * DM + head * 256;
    float dummy = 0.f;
    flash_item<256, 256, 1, true, 2, DM, 256, 256, DM>(qm, km, vm, 4, om, smem, dummy);
}

DI void gmlp_item(KP p, int l, int ci, char* smem) {
    constexpr int AP = 136;
    bf16_t* As = (bf16_t*)smem;
    bf16_t* Bs = As + 128 * AP;
    float* st = (float*)(Bs + 64 * AP);
    const int t = tid(), lane = t & 63, w = __builtin_amdgcn_readfirstlane(t >> 6), l32 = lane & 31, h = lane >> 5;
    const int tok0 = ci * 128;
    const bf16_t* vbuf = (const bf16_t*)(p->ws + OFF_V) + (size_t)tok0 * 512;
    const bf16_t* ubuf = (const bf16_t*)(p->ws + OFF_U) + (size_t)(tok0 + w * 32) * 512;
    bf16_t* om = (bf16_t*)(p->ws + OFF_OMIX) + (size_t)(tok0 + w * 32) * DM + 512;
    const bf16_t* wsg = (const bf16_t*)(p->ws + OFF_WSG) + (size_t)l * 8 * 128 * 128;
    const float* lng = p->sg_ln_g + l * 512; const float* lnb = p->sg_ln_b + l * 512;
    const float* bs = p->sg_b_s + l * 8 * 128 + w * 32;
    __syncthreads();
    {
        const int row = t >> 1, half = t & 1;
        const uint4* src = (const uint4*)(vbuf + (size_t)row * 512 + half * 256);
        float s = 0.f, s2 = 0.f;
#pragma unroll 4
        for (int i = 0; i < 32; ++i) {
            uint4 qv = src[i];
            float a0 = bflo(qv.x), a1 = bfhi(qv.x), a2 = bflo(qv.y), a3 = bfhi(qv.y), a4 = bflo(qv.z), a5 = bfhi(qv.z), a6 = bflo(qv.w), a7 = bfhi(qv.w);
            s += a0 + a1 + a2 + a3 + a4 + a5 + a6 + a7;
            s2 += a0 * a0 + a1 * a1 + a2 * a2 + a3 * a3 + a4 * a4 + a5 * a5 + a6 * a6 + a7 * a7;
        }
        s += __shfl_xor(s, 1); s2 += __shfl_xor(s2, 1);
        const float mean = s * (1.f / 512.f);
        const float var = fmaxf(s2 * (1.f / 512.f) - mean * mean, 0.f);
        if (half == 0) { st[2 * row] = mean; st[2 * row + 1] = rsqrtf(var + EPS); }
    }
    __syncthreads();
    float ssq[16];
#pragma unroll
    for (int r = 0; r < 16; ++r) ssq[r] = 0.f;
    const unsigned wtoff = (unsigned)((t >> 4) * 128 + (t & 15) * 8);
    const unsigned vtoff = (unsigned)((t >> 3) * 512 + (t & 7) * 8);
    const unsigned eoff_u = (unsigned)(4 * h * 512 + l32), eoff_o = (unsigned)(4 * h * DM + l32);
    for (int hd = 0; hd < 8; ++hd) {
        const bf16_t* wh = wsg + (size_t)hd * 128 * 128;
#pragma unroll
        for (int i = 0; i < 8; ++i)
            *(uint4*)(As + ((t >> 4) + 16 * i) * AP + (t & 15) * 8) = *(const uint4*)(wh + i * 16 * 128 + wtoff);
#pragma unroll
        for (int i = 0; i < 4; ++i) {
            const int j = (t >> 3) + 32 * i, c8 = t & 7;
            uint4 qv = *(const uint4*)(vbuf + (size_t)i * 32 * 512 + hd * 64 + vtoff);
            const float mean = st[2 * j], rstd = st[2 * j + 1];
            const int ch = hd * 64 + c8 * 8;
            const float4 g0 = *(const float4*)(lng + ch), g1 = *(const float4*)(lng + ch + 4);
            const float4 b0 = *(const float4*)(lnb + ch), b1 = *(const float4*)(lnb + ch + 4);
            bf16_t* bd = Bs + (c8 * 8) * AP + j;
            bd[0 * AP] = f2bf((bflo(qv.x) - mean) * rstd * g0.x + b0.x);
            bd[1 * AP] = f2bf((bfhi(qv.x) - mean) * rstd * g0.y + b0.y);
            bd[2 * AP] = f2bf((bflo(qv.y) - mean) * rstd * g0.z + b0.z);
            bd[3 * AP] = f2bf((bfhi(qv.y) - mean) * rstd * g0.w + b0.w);
            bd[4 * AP] = f2bf((bflo(qv.z) - mean) * rstd * g1.x + b1.x);
            bd[5 * AP] = f2bf((bfhi(qv.z) - mean) * rstd * g1.y + b1.y);
            bd[6 * AP] = f2bf((bflo(qv.w) - mean) * rstd * g1.z + b1.z);
            bd[7 * AP] = f2bf((bfhi(qv.w) - mean) * rstd * g1.w + b1.w);
        }
        __syncthreads();
        f32x16 acc[2];
#pragma unroll
        for (int r = 0; r < 16; ++r) { acc[0][r] = 0.f; acc[1][r] = 0.f; }
        const bf16_t* a_s = As + (w * 32 + l32) * AP + 8 * h;
        const bf16_t* b_s = Bs + l32 * AP + 8 * h;
#pragma unroll
        for (int ks = 0; ks < 8; ++ks) {
            bf16x8 a = *(const bf16x8*)(a_s + ks * 16);
            bf16x8 b0 = *(const bf16x8*)(b_s + ks * 16);
            bf16x8 b1 = *(const bf16x8*)(b_s + 32 * AP + ks * 16);
            acc[0] = MFMA(a, b0, acc[0]);
            acc[1] = MFMA(a, b1, acc[1]);
        }
#pragma unroll
        for (int j2 = 0; j2 < 2; ++j2)
#pragma unroll
            for (int r = 0; r < 16; ++r) {
                const int rr = (r & 3) + 8 * (r >> 2);
                const float val = acc[j2][r] + (bs + hd * 128 + rr)[4 * h];
                const bf16_t ob = f2bf(bf2f((ubuf + (size_t)rr * 512 + hd * 64 + j2 * 32)[eoff_u]) * val);
                (om + (size_t)rr * DM + hd * 64 + j2 * 32)[eoff_o] = ob;
                const float of = bf2f(ob);
                ssq[r] += of * of;
            }
        __syncthreads();
    }
#pragma unroll
    for (int r = 0; r < 16; ++r) {
        float s = ssq[r];
        s += __shfl_xor(s, 1); s += __shfl_xor(s, 2); s += __shfl_xor(s, 4); s += __shfl_xor(s, 8); s += __shfl_xor(s, 16);
        ssq[r] = rsqrtf(s * (1.f / 512.f) + EPS);
    }
    for (int i = 0; i < 16; ++i) {
#pragma unroll
        for (int r = 0; r < 16; ++r) {
            const int rr = (r & 3) + 8 * (r >> 2);
            bf16_t* ptr = om + (size_t)rr * DM + i * 32 + eoff_o;
            *ptr = f2bf(bf2f(*ptr) * ssq[r]);
        }
    }
}

DI void ph_memkv(KP p, char* smem) {
    for_tiles(DEPTH * 16 * 16, [&](int t) __attribute__((always_inline)) {
        const int l = t >> 8, rt = (t >> 4) & 15, ct = t & 15;
        f32x16 acc[2][2];
        gemm_tile<1>((const bf16_t*)(p->ws + OFF_MEMB), DM, rt * 128, 0, NBATCH * NMEM, (const bf16_t*)(p->ws + OFF_WMKV) + ((size_t)l * 2048 + ct * 128) * DM, DM, DM, smem, acc);
        EpiMemKV e{(bf16_t*)(p->ws + OFF_KMEM) + (size_t)l * NBATCH * 4 * 256 * 256, (bf16_t*)(p->ws + OFF_VMEM) + (size_t)l * NBATCH * 4 * 256 * 256,
                   (const float*)(smem + RS_OFF), rt * 128, ct * 128};
        run_epi(acc, e);
    });
}
DI float* stage_tile(const f32x16 (&acc)[2][2], const float* rs, char* smem) {
    const int tt = tid(), lane = tt & 63, w = __builtin_amdgcn_readfirstlane(tt >> 6), wm = w >> 1, wn = w & 1, l32 = lane & 31, h = lane >> 5;
    float* stg = (float*)smem;
#pragma unroll
    for (int i = 0; i < 2; ++i)
#pragma unroll
        for (int j = 0; j < 2; ++j)
#pragma unroll
            for (int r = 0; r < 16; ++r) {
                const int row = wm * 64 + i * 32 + crow(r, h);
                stg[row * 132 + wn * 64 + j * 32 + l32] = rs ? acc[i][j][r] * rs[row] : acc[i][j][r];
            }
    __syncthreads();
    return stg;
}
DI uint4 pack8(const float4& a, const float4& b) { uint4 o; o.x = pack2(a.x, a.y); o.y = pack2(a.z, a.w); o.z = pack2(b.x, b.y); o.w = pack2(b.z, b.w); return o; }
DI float4 gelu4(const float4& a) { float4 o; o.x = gelu_tanh(a.x); o.y = gelu_tanh(a.y); o.z = gelu_tanh(a.z); o.w = gelu_tanh(a.w); return o; }
DI void rope8(float4& lo, float4& hi, const float4& plo, const float4& phi, const float* cs, const float* sn, int c) {
    const float4 c0 = *(const float4*)(cs + (c & 15)), c1 = *(const float4*)(cs + (c & 15) + 4);
    const float4 s0 = *(const float4*)(sn + (c & 15)), s1 = *(const float4*)(sn + (c & 15) + 4);
    const float sg = c < 16 ? -1.f : 1.f;
    lo.x = lo.x * c0.x + sg * plo.x * s0.x; lo.y = lo.y * c0.y + sg * plo.y * s0.y; lo.z = lo.z * c0.z + sg * plo.z * s0.z; lo.w = lo.w * c0.w + sg * plo.w * s0.w;
    hi.x = hi.x * c1.x + sg * phi.x * s1.x; hi.y = hi.y * c1.y + sg * phi.y * s1.y; hi.z = hi.z * c1.z + sg * phi.z * s1.z; hi.w = hi.w * c1.w + sg * phi.w * s1.w;
}

DI void ph_in(KP p, int l, const float* xin, char* smem) {
    for_tiles(512 * 12, [&](int t) __attribute__((always_inline)) {
        int rt, ct; tile_rc(t, 12, rt, ct);
        f32x16 acc[2][2];
        const float rsp = rs_load(p, rt * 128);
        gemm_tile<0, true>((const bf16_t*)(p->ws + OFF_XB), DM, rt * 128, 0, TOK, (const bf16_t*)(p->ws + OFF_WIN) + ((size_t)l * INCP + ct * 128) * DM, DM, DM, smem, acc);
        rs_finish(rsp, rt * 128, smem);
        const float* stg = stage_tile(acc, (const float*)(smem + RS_OFF), smem);
        const int tt = tid(), c8 = tt & 15, nb = ct * 128 + c8 * 8;
        if (nb < INC) {
#pragma unroll
            for (int i = 0; i < 8; ++i) {
                const int row = (tt >> 4) + 16 * i, tok = rt * 128 + row;
                float4 lo = *(const float4*)(stg + row * 132 + c8 * 8), hi = *(const float4*)(stg + row * 132 + c8 * 8 + 4);
                if (nb < 256) *(uint4*)((bf16_t*)(p->ws + OFF_HQ) + (size_t)tok * 256 + nb) = pack8(lo, hi);
                else if (nb < 384) *(uint4*)((bf16_t*)(p->ws + OFF_HKV) + (size_t)tok * 128 + (nb - 256)) = pack8(lo, hi);
                else if (nb < 416) {
                    const int c = nb - 384, pc = c8 * 8 + (c < 16 ? 16 : -16);
                    const float4 plo = *(const float4*)(stg + row * 132 + pc), phi = *(const float4*)(stg + row * 132 + pc + 4);
                    rope8(lo, hi, plo, phi, (const float*)(p->ws + OFF_COS) + (size_t)tok * 16, (const float*)(p->ws + OFF_SIN) + (size_t)tok * 16, c);
                    const uint4 ov = pack8(lo, hi);
                    const int b = tok >> 13, sx = tok & 8191;
                    bf16_t* dst = (bf16_t*)(p->ws + OFF_K) + (((size_t)(b * 8)) * SEQ + sx) * 96 + 64 + c;
#pragma unroll
                    for (int hd = 0; hd < 8; ++hd) *(uint4*)(dst + (size_t)hd * SEQ * 96) = ov;
                } else if (nb < 928) *(uint4*)((bf16_t*)(p->ws + OFF_U) + (size_t)tok * 512 + (nb - 416)) = pack8(gelu4(lo), gelu4(hi));
                else *(uint4*)((bf16_t*)(p->ws + OFF_V) + (size_t)tok * 512 + (nb - 928)) = pack8(gelu4(lo), gelu4(hi));
            }
        }
    });
}
DI void ph_qkv(KP p, int l, char* smem) {
    for_tiles(512 * 14, [&](int t) __attribute__((always_inline)) {
        int rt, ct; tile_rc(t, 14, rt, ct);
        f32x16 acc[2][2];
        if (ct < 6) {
            gemm_tile<1>((const bf16_t*)(p->ws + OFF_HQ), QL, rt * 128, 0, TOK, (const bf16_t*)(p->ws + OFF_WUQ) + ((size_t)l * 768 + ct * 128) * QL, QL, QL, smem, acc);
            const float* stg = stage_tile(acc, (const float*)(smem + RS_OFF), smem);
            const int tt = tid(), c8 = tt & 15, n8 = ct * 128 + c8 * 8, head = n8 / 96, w0 = n8 - head * 96;
            const float qs = 0.10206207261596575f * LOG2E;
#pragma unroll
            for (int i = 0; i < 8; ++i) {
                const int row = (tt >> 4) + 16 * i, tok = rt * 128 + row;
                float4 lo = *(const float4*)(stg + row * 132 + c8 * 8), hi = *(const float4*)(stg + row * 132 + c8 * 8 + 4);
                if (w0 >= 64) {
                    const int c = w0 - 64, pc = c8 * 8 + (c < 16 ? 16 : -16);
                    const float4 plo = *(const float4*)(stg + row * 132 + pc), phi = *(const float4*)(stg + row * 132 + pc + 4);
                    rope8(lo, hi, plo, phi, (const float*)(p->ws + OFF_COS) + (size_t)tok * 16, (const float*)(p->ws + OFF_SIN) + (size_t)tok * 16, c);
                }
                lo.x *= qs; lo.y *= qs; lo.z *= qs; lo.w *= qs; hi.x *= qs; hi.y *= qs; hi.z *= qs; hi.w *= qs;
                const int b = tok >> 13, sx = tok & 8191;
                *(uint4*)((bf16_t*)(p->ws + OFF_Q) + (((size_t)(b * 8 + head)) * SEQ + sx) * 96 + w0) = pack8(lo, hi);
            }
        } else {
            const int c2 = ct - 6;
            gemm_tile<1>((const bf16_t*)(p->ws + OFF_HKV), KVL, rt * 128, 0, TOK, (const bf16_t*)(p->ws + OFF_WUKV) + ((size_t)l * 1024 + c2 * 128) * KVL, KVL, KVL, smem, acc);
            const float* stg = stage_tile(acc, (const float*)(smem + RS_OFF), smem);
            const int tt = tid(), tok0 = rt * 128, b = tok0 >> 13, s0 = tok0 & 8191;
            {
                const int c8 = tt & 7;
#pragma unroll
                for (int i = 0; i < 4; ++i) {
                    const int row = (tt >> 3) + 32 * i;
                    const float4 lo = *(const float4*)(stg + row * 132 + c8 * 8), hi = *(const float4*)(stg + row * 132 + c8 * 8 + 4);
                    *(uint4*)((bf16_t*)(p->ws + OFF_K) + (((size_t)(b * 8 + c2)) * SEQ + s0 + row) * 96 + c8 * 8) = pack8(lo, hi);
                }
            }
            {
                const int tc = tt & 15;
#pragma unroll
                for (int i = 0; i < 4; ++i) {
                    const int d = (tt >> 4) + 16 * i;
                    const float* sp = stg + (tc * 8) * 132 + 64 + d;
                    uint4 ov;
                    ov.x = pack2(sp[0], sp[132]); ov.y = pack2(sp[2 * 132], sp[3 * 132]); ov.z = pack2(sp[4 * 132], sp[5 * 132]); ov.w = pack2(sp[6 * 132], sp[7 * 132]);
                    *(uint4*)((bf16_t*)(p->ws + OFF_VT) + (((size_t)(b * 8 + c2)) * 64 + d) * SEQ + s0 + tc * 8) = ov;
                }
            }
        }
    });
}
DI void ph_mix(KP p, int l, char* smem) {
    for_tiles(512, [&](int t) __attribute__((always_inline)) { mla_item(p, t, smem); });
    for_tiles(512, [&](int t) __attribute__((always_inline)) { gmlp_item(p, l, t, smem); });
}
DI void ph_res(KP p, const bf16_t* A, int K, const bf16_t* Wt, const float* xin, char* smem, bool dry) {
    for_tiles(512 * 8, [&](int t) __attribute__((always_inline)) {
        int rt, ct; tile_rc(t, 8, rt, ct);
        f32x16 acc[2][2];
        gemm_tile<0>(A, K, rt * 128, 0, TOK, Wt + (size_t)ct * 128 * K, K, K, smem, acc);
        if (dry) return;
        const int tt = tid(), lane = tt & 63, w = __builtin_amdgcn_readfirstlane(tt >> 6), wm = w >> 1, wn = w & 1, l32 = lane & 31, h = lane >> 5;
        float* stg = (float*)smem;
#pragma unroll
        for (int i = 0; i < 2; ++i)
#pragma unroll
            for (int j = 0; j < 2; ++j)
#pragma unroll
                for (int r = 0; r < 16; ++r) stg[(wm * 64 + i * 32 + crow(r, h)) * 132 + wn * 64 + j * 32 + l32] = acc[i][j][r];
        __syncthreads();
        bf16_t* xb = (bf16_t*)(p->ws + OFF_XB) + (size_t)(rt * 128) * DM + ct * 128;
        float* part = (float*)(p->ws + OFF_RSC) + (size_t)(rt * 128) * 16 + ct * 2;
        const int c8 = tt & 15;
#pragma unroll
        for (int i = 0; i < 8; ++i) {
            const int row = (tt >> 4) + 16 * i;
            const float4 lo = *(const float4*)(stg + row * 132 + c8 * 8), hi = *(const float4*)(stg + row * 132 + c8 * 8 + 4);
            uint4* gp = (uint4*)(xb + (size_t)row * DM + c8 * 8);
            const uint4 xv = *gp;
            uint4 nv;
            nv.x = pack2h(hlo(xv.x) + lo.x, hhi(xv.x) + lo.y); nv.y = pack2h(hlo(xv.y) + lo.z, hhi(xv.y) + lo.w);
            nv.z = pack2h(hlo(xv.z) + hi.x, hhi(xv.z) + hi.y); nv.w = pack2h(hlo(xv.w) + hi.z, hhi(xv.w) + hi.w);
            *gp = nv;
            float s0 = hlo(nv.x), s1 = hhi(nv.x), s2 = hlo(nv.y), s3 = hhi(nv.y), s4 = hlo(nv.z), s5 = hhi(nv.z), s6 = hlo(nv.w), s7 = hhi(nv.w);
            float sq = s0 * s0 + s1 * s1 + s2 * s2 + s3 * s3 + s4 * s4 + s5 * s5 + s6 * s6 + s7 * s7;
            sq += __shfl_xor(sq, 1); sq += __shfl_xor(sq, 2); sq += __shfl_xor(sq, 4); sq += __shfl_xor(sq, 8);
            if (c8 == 0) { float2 pv; pv.x = sq; pv.y = 0.f; *(float2*)(part + (size_t)row * 16) = pv; }
        }
    });
}
DI void ph_qm(KP p, int l, char* smem) {
    for_tiles(512 * 8, [&](int t) __attribute__((always_inline)) {
        int rt, ct; tile_rc(t, 8, rt, ct);
        f32x16 acc[2][2];
        const float rsp = rs_load(p, rt * 128);
        gemm_tile<0, true>((const bf16_t*)(p->ws + OFF_XB), DM, rt * 128, 0, TOK, (const bf16_t*)(p->ws + OFF_WMQ) + ((size_t)l * DM + ct * 128) * DM, DM, DM, smem, acc);
        rs_finish(rsp, rt * 128, smem);
        const float* stg = stage_tile(acc, (const float*)(smem + RS_OFF), smem);
        const int tt = tid(), c8 = tt & 15;
        const float qs = 0.0625f * LOG2E;
#pragma unroll
        for (int i = 0; i < 8; ++i) {
            const int row = (tt >> 4) + 16 * i;
            float4 lo = *(const float4*)(stg + row * 132 + c8 * 8), hi = *(const float4*)(stg + row * 132 + c8 * 8 + 4);
            lo.x *= qs; lo.y *= qs; lo.z *= qs; lo.w *= qs; hi.x *= qs; hi.y *= qs; hi.z *= qs; hi.w *= qs;
            *(uint4*)((bf16_t*)(p->ws + OFF_QM) + (size_t)(rt * 128 + row) * DM + ct * 128 + c8 * 8) = pack8(lo, hi);
        }
    });
}
DI void ph_memattn(KP p, int l, char* smem) {
    for_tiles(NBATCH * 128 * 4, [&](int t) __attribute__((always_inline)) { memattn_item(p, l, t, smem); });
}
typedef float f32p __attribute__((ext_vector_type(2)));
DI void ph_up(KP p, int l, char* smem) {
    for_tiles(NBATCH * 66 * 44, [&](int t) __attribute__((always_inline)) {
        int rt, ct; tile_rc(t, 44, rt, ct);
        const int b = rt / 66, rl = rt - b * 66, s0 = rl * 126;
        const float* cw = p->conv_w + (size_t)l * 3 * 2 * DFF; const float* cb = p->conv_b + (size_t)l * 2 * DFF;
        const int cp2 = (tid() & 31) * 2, c = ct * 64 + cp2, c2 = DFF + c;
        const f32p g0 = *(const f32p*)(cw + c), g1 = *(const f32p*)(cw + 2 * DFF + c), g2 = *(const f32p*)(cw + 4 * DFF + c), gb = *(const f32p*)(cb + c);
        const f32p u0 = *(const f32p*)(cw + c2), u1 = *(const f32p*)(cw + 2 * DFF + c2), u2 = *(const f32p*)(cw + 4 * DFF + c2), ub = *(const f32p*)(cb + c2);
        f32x16 acc[2][2];
        const float rsp = rs_load(p, b * SEQ + s0 - 1);
        gemm_tile<0, true, true>((const bf16_t*)(p->ws + OFF_XB), DM, b * SEQ + s0 - 1, b * SEQ, (b + 1) * SEQ, (const bf16_t*)(p->ws + OFF_WUP) + ((size_t)l * 2 * DFF + ct * 128) * DM, DM, DM, smem, acc);
        rs_finish(rsp, b * SEQ + s0 - 1, smem);
        const float* rs = (const float*)(smem + RS_OFF);
        float* stg = (float*)smem;
        const int tt = tid(), lane = tt & 63, w = __builtin_amdgcn_readfirstlane(tt >> 6), wm = w >> 1, wn = w & 1, l32 = lane & 31, h = lane >> 5;
#pragma unroll
        for (int i = 0; i < 2; ++i)
#pragma unroll
            for (int j = 0; j < 2; ++j)
#pragma unroll
                for (int r = 0; r < 16; ++r) {
                    const int row = wm * 64 + i * 32 + crow(r, h), col = wn * 64 + j * 32 + l32;
                    stg[row * 130 + col] = acc[i][j][r] * rs[row];
                }
        __syncthreads();
        bf16_t* act = (bf16_t*)(p->ws + OFF_ACT);
        const int rmax = min(126, SEQ - s0);
        const int rbeg = w * 32 + h * 16, rend = min(rbeg + 16, rmax);
        if (rbeg < rend) {
            const float* sg = stg + rbeg * 130 + cp2;
            unsigned* arow = (unsigned*)(act + ((size_t)b * SEQ + s0 + rbeg) * DFF + c);
            f32p ga = *(const f32p*)sg, gm = *(const f32p*)(sg + 130), ua = *(const f32p*)(sg + 64), um = *(const f32p*)(sg + 130 + 64);
#pragma unroll 4
            for (int r = rbeg; r < rend; ++r) {
                sg += 130;
                const f32p gn = *(const f32p*)(sg + 130), un = *(const f32p*)(sg + 130 + 64);
                const f32p g = g0 * ga + g1 * gm + g2 * gn + gb;
                const f32p up = u0 * ua + u1 * um + u2 * un + ub;
                const f32p e = g * (-LOG2E);
                f32p den; den.x = 1.f + ex2(e.x); den.y = 1.f + ex2(e.y);
                f32p sig; sig.x = __builtin_amdgcn_rcpf(den.x); sig.y = __builtin_amdgcn_rcpf(den.y);
                const f32p o = g * sig * up;
                *arow = pack2(o.x, o.y);
                arow += DFF / 2;
                ga = gm; gm = gn; ua = um; um = un;
            }
        }
    });
}
DI void ph_final(KP p) {
    const int lane = tid() & 63, wv = blockIdx.x * 4 + (tid() >> 6), nw = gridDim.x * 4;
    const bf16_t* xbp = (const bf16_t*)(p->ws + OFF_XB);
    const float* rsc = (const float*)(p->ws + OFF_RSC);
    for (int row = wv; row < TOK; row += nw) {
        const uint4* xr = (const uint4*)(xbp + (size_t)row * DM);
        float4* orow = (float4*)(p->out + (size_t)row * DM);
        float ps = lane < 16 ? rsc[(size_t)row * 16 + lane] : 0.f;
        ps += __shfl_xor(ps, 1); ps += __shfl_xor(ps, 2); ps += __shfl_xor(ps, 4); ps += __shfl_xor(ps, 8);
        const float sc = rsqrtf(__shfl(ps, 0) * (1.f / DM) + EPS);
#pragma unroll
        for (int i = 0; i < 2; ++i) {
            const uint4 v = xr[lane + 64 * i];
            const float4 g0 = ((const float4*)p->final_norm_g)[2 * (lane + 64 * i)], g1 = ((const float4*)p->final_norm_g)[2 * (lane + 64 * i) + 1];
            float4 o0, o1;
            o0.x = hlo(v.x) * sc * g0.x; o0.y = hhi(v.x) * sc * g0.y; o0.z = hlo(v.y) * sc * g0.z; o0.w = hhi(v.y) * sc * g0.w;
            o1.x = hlo(v.z) * sc * g1.x; o1.y = hhi(v.z) * sc * g1.y; o1.z = hlo(v.w) * sc * g1.z; o1.w = hhi(v.w) * sc * g1.w;
            orow[2 * (lane + 64 * i)] = o0; orow[2 * (lane + 64 * i) + 1] = o1;
        }
    }
}

#define XB_TMO      128
#define XB_XCNT(j)  (256  + 64 * (j))
#define XB_XSUB(j)  (1280 + 64 * (j))
#define XB_XGEN(j)  (2304 + 64 * (j))
#define XB_TOP      3328
#define XB_TOPGEN   3392
#define XCD_BAR_WORDS 3456
#define XB_SPIN_CAP (1u << 22)
#define LAS __attribute__((address_space(3)))
static_assert(XCD_BAR_WORDS * 4 <= BAR_BYTES, "barrier words");
DI unsigned xb_ld(unsigned* p) { return __hip_atomic_load(p, __ATOMIC_RELAXED, __HIP_MEMORY_SCOPE_AGENT); }
DI unsigned xb_add(unsigned* p, unsigned v) { return __hip_atomic_fetch_add(p, v, __ATOMIC_RELAXED, __HIP_MEMORY_SCOPE_AGENT); }
DI unsigned xb_xcc_id() { return (unsigned)__builtin_amdgcn_s_getreg((3 << 11) | 20) & 0xFu; }
#define XB_SPIN(cond, bar) do { unsigned _sp = 0; while (cond) { __builtin_amdgcn_s_sleep(1); \
    if ((++_sp & 255u) == 0u) { if (xb_ld(&(bar)[XB_TMO])) break; if (_sp > XB_SPIN_CAP) { atomicAdd(&(bar)[XB_TMO], 1u); break; } } } } while (0)
struct XcdBarrier { unsigned* bar; unsigned x; volatile LAS unsigned* st; };
DI XcdBarrier xcd_barrier_post(unsigned* bar, volatile LAS unsigned* st) {
    XcdBarrier b; b.bar = bar; b.x = xb_xcc_id(); b.st = st;
    if (threadIdx.x == 0) (void)xb_add(&bar[XB_XCNT(b.x)], 1u);
    return b;
}
DI void xcd_barrier_complete(unsigned* bar, unsigned x, unsigned& nloc, unsigned& nx) {
    const unsigned G = gridDim.x * gridDim.y * gridDim.z;
    unsigned sum, cnt, mine, sp = 0u;
    for (;;) {
        sum = 0u; cnt = 0u; mine = 0u;
#pragma unroll
        for (unsigned j = 0; j < 16; ++j) { const unsigned c = xb_ld(&bar[XB_XCNT(j)]); sum += c; cnt += (c > 0u) ? 1u : 0u; mine = (j == x) ? c : mine; }
        if (sum == G) break;
        __builtin_amdgcn_s_sleep(1);
        if ((++sp & 255u) == 0u) { if (xb_ld(&bar[XB_TMO])) break; if (sp > XB_SPIN_CAP) { atomicAdd(&bar[XB_TMO], 1u); break; } }
    }
    nloc = mine > 0u ? mine : 1u; nx = cnt > 0u ? cnt : 1u;
}
DI void xcd_barrier(const XcdBarrier& b) {
    asm volatile("s_waitcnt vmcnt(0)" ::: "memory");
    __syncthreads();
    if (threadIdx.x == 0) {
        unsigned* bar = b.bar;
        __builtin_amdgcn_s_waitcnt(0);
        unsigned nloc = b.st[0], nx = b.st[1];
        if (nloc == 0u) { xcd_barrier_complete(bar, b.x, nloc, nx); b.st[0] = nloc; b.st[1] = nx; }
        const unsigned old = xb_add(&bar[XB_XSUB(b.x)], 1u);
        const unsigned gen = old / nloc;
        if (old + 1u == (gen + 1u) * nloc) {
            __builtin_amdgcn_fence(__ATOMIC_RELEASE, "agent");
            asm volatile("s_waitcnt vmcnt(0)" ::: "memory");
            const unsigned og = xb_add(&bar[XB_TOP], 1u);
            const unsigned tg = og / nx;
            if (og + 1u == (tg + 1u) * nx) xb_add(&bar[XB_TOPGEN], 1u);
            else XB_SPIN(xb_ld(&bar[XB_TOPGEN]) == tg, bar);
            __builtin_amdgcn_fence(__ATOMIC_ACQUIRE, "agent");
            xb_add(&bar[XB_XGEN(b.x)], 1u);
            asm volatile("s_waitcnt vmcnt(0)" ::: "memory");
        } else {
            XB_SPIN(xb_ld(&bar[XB_XGEN(b.x)]) == gen, bar);
            __builtin_amdgcn_fence(__ATOMIC_ACQUIRE, "agent");
            asm volatile("s_waitcnt vmcnt(0)" ::: "memory");
        }
    }
    __syncthreads();
}

constexpr int NPHASE = 2 + 9 * DEPTH + 1;
__global__ void __launch_bounds__(256, 2) mk(Params p_unused, int lo, int hi) {
    extern __shared__ __attribute__((aligned(16))) char smem[];
    cg::grid_group grid = cg::this_grid();
    volatile LAS unsigned* xst = (volatile LAS unsigned*)(smem + RS_OFF + 512);
    if (threadIdx.x == 0) { xst[0] = 0u; xst[1] = 0u; xst[2] = 0u; xst[3] = 0u; }
    __syncthreads();
    const XcdBarrier xbar = xcd_barrier_post((unsigned*)(kparams()->ws + OFF_BAR), xst);
    for (int ph = lo; ph < hi; ++ph) {
        KP p = kparams();
        if (ph == 0) phase_setup(p, smem);
        else if (ph == 1) ph_memkv(p, smem);
        else if (ph == NPHASE - 1) ph_final(p);
        else {
            const int l = (ph - 2) / 9, s = (ph - 2) % 9;
            const float* xin = l == 0 ? p->x : p->out;
            const int reps = ((REPMASK >> s) & 1) ? 2 : 1;
            for (int rep = 0; rep < reps; ++rep) {
                const bool dry = rep + 1 < reps;
                switch (s) {
                    case 0: ph_in(p, l, xin, smem); break;
                    case 1: ph_qkv(p, l, smem); break;
                    case 2: ph_mix(p, l, smem); break;
                    case 3: ph_res(p, (const bf16_t*)(p->ws + OFF_OMIX), DM, (const bf16_t*)(p->ws + OFF_WOUT) + (size_t)l * DM * DM, xin, smem, dry); break;
                    case 4: ph_qm(p, l, smem); break;
                    case 5: ph_memattn(p, l, smem); break;
                    case 6: ph_res(p, (const bf16_t*)(p->ws + OFF_OMEM), DM, (const bf16_t*)(p->ws + OFF_WMO) + (size_t)l * DM * DM, p->out, smem, dry); break;
                    case 7: ph_up(p, l, smem); break;
                    case 8: ph_res(p, (const bf16_t*)(p->ws + OFF_ACT), DFF, (const bf16_t*)(p->ws + OFF_WDN) + (size_t)l * DM * DFF, p->out, smem, dry); break;
                }
                if (dry) xcd_barrier(xbar);
            }
        }
        if (ph + 1 < hi) { if (ph == 0) grid.sync(); else xcd_barrier(xbar); }
    }
}

extern "C" void kernel_launch(void* const* d_in, const int* in_sizes, int n_in, void* d_out, int out_size, void* d_ws, size_t ws_size, hipStream_t stream) {
    static int grid_blocks = 0;
    if (!grid_blocks) {
        int dev = 0, cus = 0, per_cu = 0;
        hipGetDevice(&dev);
        hipDeviceGetAttribute(&cus, hipDeviceAttributeMultiprocessorCount, dev);
        hipFuncSetAttribute((const void*)mk, hipFuncAttributeMaxDynamicSharedMemorySize, LDS_BYTES);
        hipOccupancyMaxActiveBlocksPerMultiprocessor(&per_cu, (const void*)mk, 256, LDS_BYTES);
        if (per_cu < 1) per_cu = 1;
        if (per_cu > 2) per_cu = 2;
        grid_blocks = cus * per_cu;
        if (ws_size < OFF_END) fprintf(stderr, "kernel_launch: workspace too small: %zu < %zu\n", ws_size, (size_t)OFF_END);
    }
    Params p{};
    const float** fp = (const float**)&p;
    p.x = (const float*)d_in[0]; p.mem = (const float*)d_in[1]; p.pos = (const int*)d_in[2];
    p.norm_mix_g = (const float*)d_in[3]; p.w_in = (const float*)d_in[4]; p.q_norm_g = (const float*)d_in[5]; p.w_uq = (const float*)d_in[6];
    p.kv_norm_g = (const float*)d_in[7]; p.w_ukv = (const float*)d_in[8]; p.sg_ln_g = (const float*)d_in[9]; p.sg_ln_b = (const float*)d_in[10];
    p.sg_w_s = (const float*)d_in[11]; p.sg_b_s = (const float*)d_in[12]; p.out_norm_mla_g = (const float*)d_in[13]; p.out_norm_sg_g = (const float*)d_in[14];
    p.w_out = (const float*)d_in[15]; p.norm_mem_g = (const float*)d_in[16]; p.mem_norm_g = (const float*)d_in[17]; p.w_mq = (const float*)d_in[18];
    p.w_mkv = (const float*)d_in[19]; p.w_mo = (const float*)d_in[20]; p.norm_ffn_g = (const float*)d_in[21]; p.w_up = (const float*)d_in[22];
    p.conv_w = (const float*)d_in[23]; p.conv_b = (const float*)d_in[24]; p.w_down = (const float*)d_in[25]; p.final_norm_g = (const float*)d_in[26];
    p.out = (float*)d_out; p.ws = (char*)d_ws;
    (void)fp;
    (void)hipMemsetAsync((char*)d_ws + OFF_BAR, 0, BAR_BYTES, stream);
#if COOP
    int lo = 0, hi = NPHASE;
    void* args[] = {&p, &lo, &hi};
    hipError_t e = hipLaunchCooperativeKernel((const void*)mk, dim3(grid_blocks), dim3(256), args, LDS_BYTES, stream);
    if (e != hipSuccess) fprintf(stderr, "cooperative launch failed: %s (grid %d)\n", hipGetErrorString(e), grid_blocks);
#else
    for (int ph = 0; ph < NPHASE; ++ph) hipLaunchKernelGGL(mk, dim3(grid_blocks), dim3(256), LDS_BYTES, stream, p, ph, ph + 1);
#endif
}
```

```cpp
#include <hip/hip_runtime.h>
#include <hip/hip_cooperative_groups.h>
#include <stdint.h>
#include <stdio.h>
namespace cg = cooperative_groups;

#ifndef PHMASK
#define PHMASK 0xFFFF
#endif
#ifndef REPMASK
#define REPMASK 0
#endif
#ifndef COOP
#define COOP 1
#endif

typedef unsigned short bf16_t;
typedef __attribute__((ext_vector_type(8))) short bf16x8;
typedef __attribute__((ext_vector_type(16))) float f32x16;
typedef __attribute__((ext_vector_type(4))) unsigned u32x4;
#define DI __device__ __forceinline__
#define MFMA(a, b, c) __builtin_amdgcn_mfma_f32_32x32x16_bf16((a), (b), (c), 0, 0, 0)

constexpr int NBATCH = 8, SEQ = 8192, TOK = NBATCH * SEQ, DM = 1024, DEPTH = 4;
constexpr int NMEM = 256, QL = 256, KVL = 128, ROPE = 32, NOPE = 64, VD = 64, NH = 8;
constexpr int SGW = 512, INC = 1440, INCP = 1536, DFF = 2816;
constexpr float EPS = 1e-6f;
constexpr float LOG2E = 1.4426950408889634f;

constexpr size_t al256(size_t x) { return (x + 255) & ~(size_t)255; }
constexpr size_t SZ_WIN = (size_t)DEPTH * INCP * DM * 2;
constexpr size_t SZ_WUQ = (size_t)DEPTH * 768 * QL * 2;
constexpr size_t SZ_WUKV = (size_t)DEPTH * 1024 * KVL * 2;
constexpr size_t SZ_WS = (size_t)DEPTH * 8 * 128 * 128 * 2;
constexpr size_t SZ_W1K = (size_t)DEPTH * DM * DM * 2;
constexpr size_t SZ_WMKV = (size_t)DEPTH * 2048 * DM * 2;
constexpr size_t SZ_WUP = (size_t)DEPTH * 2 * DFF * DM * 2;
constexpr size_t SZ_WDN = (size_t)DEPTH * DM * DFF * 2;
constexpr size_t OFF_WIN = 0;
constexpr size_t OFF_WUQ = OFF_WIN + SZ_WIN;
constexpr size_t OFF_WUKV = OFF_WUQ + SZ_WUQ;
constexpr size_t OFF_WSG = OFF_WUKV + SZ_WUKV;
constexpr size_t OFF_WOUT = OFF_WSG + SZ_WS;
constexpr size_t OFF_WMQ = OFF_WOUT + SZ_W1K;
constexpr size_t OFF_WMKV = OFF_WMQ + SZ_W1K;
constexpr size_t OFF_WMO = OFF_WMKV + SZ_WMKV;
constexpr size_t OFF_WUP = OFF_WMO + SZ_W1K;
constexpr size_t OFF_WDN = OFF_WUP + SZ_WUP;
constexpr size_t OFF_COS = OFF_WDN + SZ_WDN;
constexpr size_t OFF_SIN = OFF_COS + (size_t)TOK * 16 * 4;
constexpr size_t OFF_KMEM = OFF_SIN + (size_t)TOK * 16 * 4;
constexpr size_t SZ_KMEM = (size_t)DEPTH * NBATCH * 4 * 256 * 256 * 2;
constexpr size_t OFF_VMEM = OFF_KMEM + SZ_KMEM;
constexpr size_t OFF_ACT0 = OFF_VMEM + SZ_KMEM;
constexpr size_t OFF_Q = OFF_ACT0;
constexpr size_t OFF_K = OFF_Q + (size_t)TOK * 8 * 96 * 2;
constexpr size_t OFF_VT = OFF_K + (size_t)TOK * 8 * 96 * 2;
constexpr size_t OFF_U = OFF_VT + (size_t)TOK * 512 * 2;
constexpr size_t OFF_V = OFF_U + (size_t)TOK * 512 * 2;
constexpr size_t OFF_OMIX = OFF_V + (size_t)TOK * 512 * 2;
constexpr size_t OFF_HQ = OFF_OMIX + (size_t)TOK * 1024 * 2;
constexpr size_t OFF_HKV = OFF_HQ + (size_t)TOK * 256 * 2;
constexpr size_t OFF_XB = OFF_HKV + (size_t)TOK * 128 * 2;
constexpr size_t OFF_MEMB = OFF_XB + (size_t)TOK * DM * 2;
constexpr size_t OFF_RSC = OFF_MEMB + (size_t)NBATCH * NMEM * DM * 2;
constexpr size_t OFF_BAR = OFF_RSC + (size_t)TOK * 16 * 4;
constexpr size_t BAR_BYTES = 16384;
constexpr size_t OFF_END = OFF_BAR + BAR_BYTES;
constexpr size_t OFF_QM = OFF_Q;
constexpr size_t OFF_OMEM = OFF_OMIX;
constexpr size_t OFF_ACT = OFF_ACT0;
static_assert(OFF_ACT + (size_t)TOK * DFF * 2 <= OFF_XB, "act alias");
static_assert(OFF_END <= (size_t)1000 * 1024 * 1024, "ws budget");

struct Params {
    const float *x, *mem; const int* pos;
    const float *norm_mix_g, *w_in, *q_norm_g, *w_uq, *kv_norm_g, *w_ukv, *sg_ln_g, *sg_ln_b, *sg_w_s, *sg_b_s,
        *out_norm_mla_g, *out_norm_sg_g, *w_out, *norm_mem_g, *mem_norm_g, *w_mq, *w_mkv, *w_mo, *norm_ffn_g, *w_up,
        *conv_w, *conv_b, *w_down, *final_norm_g;
    float* out; char* ws;
};

typedef const __attribute__((address_space(4))) Params* KP;
DI KP kparams() { KP k = (KP)__builtin_amdgcn_kernarg_segment_ptr(); asm volatile("" : "+s"(k)); return k; }
typedef __bf16 bf16v2_t __attribute__((ext_vector_type(2)));
typedef float f32v2_t __attribute__((ext_vector_type(2)));
DI unsigned pack2(float a, float b) { f32v2_t v = {a, b}; return __builtin_bit_cast(unsigned, __builtin_convertvector(v, bf16v2_t)); }
DI bf16_t f2bf(float f) { return (bf16_t)(pack2(f, f) & 0xffffu); }
typedef _Float16 f16x8 __attribute__((ext_vector_type(8)));
typedef _Float16 f16v2_t __attribute__((ext_vector_type(2)));
DI unsigned pack2h(float a, float b) { f16v2_t v = {(_Float16)a, (_Float16)b}; return __builtin_bit_cast(unsigned, v); }
DI bf16_t f2h(float f) { return __builtin_bit_cast(unsigned short, (_Float16)f); }
DI float h2f(bf16_t u) { return (float)__builtin_bit_cast(_Float16, u); }
DI float hlo(unsigned u) { return h2f((bf16_t)(u & 0xffffu)); }
DI float hhi(unsigned u) { return h2f((bf16_t)(u >> 16)); }
#define MFMA_H(a, b, c) __builtin_amdgcn_mfma_f32_32x32x16_f16(__builtin_bit_cast(f16x8, (a)), __builtin_bit_cast(f16x8, (b)), (c), 0, 0, 0)
DI float bf2f(bf16_t b) { return __uint_as_float((unsigned)b << 16); }
DI float bflo(unsigned u) { return __uint_as_float(u << 16); }
DI float bfhi(unsigned u) { return __uint_as_float(u & 0xffff0000u); }
DI float ex2(float x) { return __builtin_amdgcn_exp2f(x); }
DI float gelu_tanh(float x) { float y = 0.7978845608028654f * (x + 0.044715f * x * x * x); return x * __builtin_amdgcn_rcpf(1.f + ex2(-2.f * LOG2E * y)); }
DI float silu(float x) { return x * __builtin_amdgcn_rcpf(1.f + ex2(-LOG2E * x)); }
DI int tid() { int t = threadIdx.x; asm volatile("" : "+v"(t)); return t; }
DI int crow(int r, int h) { return (r & 3) + 8 * (r >> 2) + 4 * h; }
DI int swap23(int r) { return (r & ~12) | ((r & 4) << 1) | ((r & 8) >> 1); }

template <class F> DI void for_tiles(int ntiles, F f) {
    const int G = gridDim.x, b = blockIdx.x;
    const bool sw = (G & 7) == 0;
    const int tpx = (ntiles + 7) >> 3;
    const int start = sw ? (b >> 3) : b, step = sw ? (G >> 3) : G, lim = sw ? tpx : ntiles, base = sw ? (b & 7) * tpx : 0;
    for (int i = start; i < lim; i += step) {
        const int t = base + i;
        if (t < ntiles) f(t);
    }
}

constexpr int LK = 72;
constexpr int GEMM_LDS = 4 * 128 * LK * 2;
constexpr int RS_OFF = GEMM_LDS;
constexpr int LDS_BYTES = GEMM_LDS + 1024;

template <int AMODE, bool F16 = false, bool MASK = false>
DI void gemm_tile(const bf16_t* __restrict__ Ab, int lda, int row0, int rlo, int rhi,
                  const bf16_t* __restrict__ Bt, int ldb, int K, char* smem, f32x16 (&acc)[2][2]) {
    const int t = tid(), lane = t & 63, w = __builtin_amdgcn_readfirstlane(t >> 6), wm = w >> 1, wn = w & 1, l32 = lane & 31, h = lane >> 5;
    bf16_t* As = (bf16_t*)smem;
    bf16_t* Bs = As + 2 * 128 * LK;
    float* rs = (float*)(smem + RS_OFF);
#pragma unroll
    for (int i = 0; i < 2; ++i)
#pragma unroll
        for (int j = 0; j < 2; ++j)
#pragma unroll
            for (int r = 0; r < 16; ++r) acc[i][j][r] = 0.f;

    uint4 p0a0, p0a1, p0a2, p0a3, p0b0, p0b1, p0b2, p0b3, p1a0, p1a1, p1a2, p1a3, p1b0, p1b1, p1b2, p1b3;
    float ss0 = 0.f, ss1 = 0.f, ss2 = 0.f, ss3 = 0.f;
    const int gr0 = row0 + (t >> 3);
    const bool rv0 = gr0 >= rlo && gr0 < rhi, rv1 = gr0 + 32 >= rlo && gr0 + 32 < rhi, rv2 = gr0 + 64 >= rlo && gr0 + 64 < rhi, rv3 = gr0 + 96 >= rlo && gr0 + 96 < rhi;
    const int nk = K >> 6;
    const int rhm = rhi - 1;
    const unsigned aoff0 = (unsigned)min(max(gr0, rlo), rhm) * (unsigned)lda + 8u * (t & 7);
    const unsigned aoff1 = (unsigned)min(max(gr0 + 32, rlo), rhm) * (unsigned)lda + 8u * (t & 7);
    const unsigned aoff2 = (unsigned)min(max(gr0 + 64, rlo), rhm) * (unsigned)lda + 8u * (t & 7);
    const unsigned aoff3 = (unsigned)min(max(gr0 + 96, rlo), rhm) * (unsigned)lda + 8u * (t & 7);
    const unsigned btoff = (unsigned)((t >> 3) * ldb + 8 * (t & 7));

    __syncthreads();

#define LD1(S, j, k0)                                                                                         \
    {                                                                                                         \
        S##a##j = *(const uint4*)(Ab + (k0) + aoff##j);          \
        S##b##j = *(const uint4*)(Bt + (size_t)(32 * j) * ldb + (k0) + btoff);                                \
    }
#define LOADS(S, k0) { LD1(S, 0, k0) LD1(S, 1, k0) LD1(S, 2, k0) LD1(S, 3, k0) }
#define ST1(S, j, buf)                                                                                        \
    {                                                                                                         \
        uint4 v = S##a##j;                                                                                    \
        if constexpr (MASK) { if (!rv##j) v = make_uint4(0, 0, 0, 0); }     \
        if (AMODE == 1) {                                                                                     \
            float a0 = bflo(v.x), a1 = bfhi(v.x), a2 = bflo(v.y), a3 = bfhi(v.y), a4 = bflo(v.z), a5 = bfhi(v.z), a6 = bflo(v.w), a7 = bfhi(v.w); \
            ss##j += a0 * a0 + a1 * a1 + a2 * a2 + a3 * a3 + a4 * a4 + a5 * a5 + a6 * a6 + a7 * a7;          \
        }                                                                                                     \
        *(uint4*)(As + (buf) * 128 * LK + ((t >> 3) + 32 * j) * LK + 8 * (t & 7)) = v;                        \
        *(uint4*)(Bs + (buf) * 128 * LK + ((t >> 3) + 32 * j) * LK + 8 * (t & 7)) = S##b##j;                  \
    }
#define STORES(S, buf) { ST1(S, 0, buf) ST1(S, 1, buf) ST1(S, 2, buf) ST1(S, 3, buf) }
#define FRAGS(ks, A0, A1, B0, B1) { A0 = *(const bf16x8*)(a_s + (ks) * 16); A1 = *(const bf16x8*)(a_s + 32 * LK + (ks) * 16); B0 = *(const bf16x8*)(b_s + (ks) * 16); B1 = *(const bf16x8*)(b_s + 32 * LK + (ks) * 16); }
#define MMAS(A0, A1, B0, B1) { __builtin_amdgcn_s_setprio(1); if constexpr (F16) { acc[0][0] = MFMA_H(A0, B0, acc[0][0]); acc[0][1] = MFMA_H(A0, B1, acc[0][1]); acc[1][0] = MFMA_H(A1, B0, acc[1][0]); acc[1][1] = MFMA_H(A1, B1, acc[1][1]); } else { acc[0][0] = MFMA(A0, B0, acc[0][0]); acc[0][1] = MFMA(A0, B1, acc[0][1]); acc[1][0] = MFMA(A1, B0, acc[1][0]); acc[1][1] = MFMA(A1, B1, acc[1][1]); } __builtin_amdgcn_s_setprio(0); }
#define COMPUTE(buf)                                                                                          \
    {                                                                                                         \
        const bf16_t* a_s = As + (buf) * 128 * LK + (wm * 64 + l32) * LK + h * 8;                             \
        const bf16_t* b_s = Bs + (buf) * 128 * LK + (wn * 64 + l32) * LK + h * 8;                             \
        bf16x8 xa0, xa1, xb0, xb1, ya0, ya1, yb0, yb1;                                                        \
        FRAGS(0, xa0, xa1, xb0, xb1)                                                                          \
        FRAGS(1, ya0, ya1, yb0, yb1)                                                                          \
        MMAS(xa0, xa1, xb0, xb1)                                                                              \
        FRAGS(2, xa0, xa1, xb0, xb1)                                                                          \
        MMAS(ya0, ya1, yb0, yb1)                                                                              \
        FRAGS(3, ya0, ya1, yb0, yb1)                                                                          \
        MMAS(xa0, xa1, xb0, xb1)                                                                              \
        MMAS(ya0, ya1, yb0, yb1)                                                                              \
    }

    const int klast = (nk - 1) * 64;
    LOADS(p0, 0);
    LOADS(p1, 64);
    STORES(p0, 0);
    LOADS(p0, min(128, klast));
    __syncthreads();
    for (int kt = 0; kt < nk; kt += 2) {
        COMPUTE(0);
        STORES(p1, 1);
        LOADS(p1, min((kt + 3) * 64, klast));
        __syncthreads();
        COMPUTE(1);
        if (kt + 2 < nk) STORES(p0, 0);
        LOADS(p0, min((kt + 4) * 64, klast));
        __syncthreads();
    }
#undef LOADS
#undef STORES
#undef COMPUTE
#undef FRAGS
#undef MMAS
#undef LD1
#undef ST1
    if (AMODE == 1) {
#define RS1(j) { float s = ss##j; s += __shfl_xor(s, 1); s += __shfl_xor(s, 2); s += __shfl_xor(s, 4); if ((t & 7) == 0) rs[(t >> 3) + 32 * j] = rsqrtf(s / (float)K + EPS); }
        RS1(0) RS1(1) RS1(2) RS1(3)
#undef RS1
        __syncthreads();
    }
}

DI float rs_load(KP p, int row0) {
    const int t = tid(), r = row0 + (t >> 1);
    float sum = 0.f;
    if (r >= 0 && r < TOK) {
        const float4* ps = (const float4*)((const float*)(p->ws + OFF_RSC) + (size_t)r * 16 + (t & 1) * 8);
        const float4 a = ps[0], b = ps[1];
        sum = (a.x + a.y) + (a.z + a.w) + (b.x + b.y) + (b.z + b.w);
    }
    return sum;
}
DI void rs_finish(float sum, int row0, char* smem) {
    const int t = tid(), r = row0 + (t >> 1);
    sum += __shfl_xor(sum, 1);
    if ((t & 1) == 0) ((float*)(smem + RS_OFF))[t >> 1] = (r >= 0 && r < TOK) ? rsqrtf(sum * (1.f / DM) + EPS) : 0.f;
    __syncthreads();
}

DI void tile_rc(int t, int NT, int& rt, int& ct) { const int g = t / (8 * NT), rem = t - g * 8 * NT; ct = rem >> 3; rt = g * 8 + (rem & 7); }

template <class E> DI void run_epi(const f32x16 (&acc)[2][2], const E& e) {
    const int w = __builtin_amdgcn_readfirstlane(tid() >> 6), wm = w >> 1, wn = w & 1;
#pragma unroll
    for (int i = 0; i < 2; ++i)
#pragma unroll
        for (int j = 0; j < 2; ++j) e(wm * 64 + i * 32, wn * 64 + j * 32, acc[i][j]);
}

DI int up_perm(int n) { return n < DFF ? (n >> 6) * 128 + (n & 63) : ((n - DFF) >> 6) * 128 + 64 + ((n - DFF) & 63); }

DI void conv_tile(const float* __restrict__ src, int K, int N, const float* g1, const float* g2, int ksplit,
                  bf16_t* __restrict__ dst, int rowmap, int tile, float* lds, int mode, bool f16 = false) {
    const int ntn = N >> 5, tk = tile / ntn, tn = tile - tk * ntn, k0 = tk * 32, n0 = tn * 32;
    const int tx = tid() & 31, ty = tid() >> 5;
    if (mode == 0) {
#pragma unroll
        for (int i = 0; i < 4; ++i) {
            int k = k0 + ty + 8 * i;
            float v = src[(size_t)k * N + n0 + tx];
            float g = g1 ? (k < ksplit ? g1[k] : g2[k - ksplit]) : 1.f;
            lds[(ty + 8 * i) * 33 + tx] = v * g;
        }
    } else {
#pragma unroll
        for (int i = 0; i < 4; ++i) {
            int n = n0 + ty + 8 * i;
            int nn = rowmap ? up_perm(n) : n;
            const float wv = lds[tx * 33 + ty + 8 * i];
            dst[(size_t)nn * K + k0 + tx] = f16 ? f2h(wv) : f2bf(wv);
        }
    }
}

__device__ void phase_setup(KP p, char* smem) {
    float* lds = (float*)smem;
    char* ws = p->ws;
    constexpr int PER_LAYER = 1440 + 192 + 128 + 1024 + 1024 + 2048 + 1024 + 5632 + 2816;
    auto job = [&](int t, float* ldsq, int mode) __attribute__((always_inline)) {
        int l = t / PER_LAYER, r = t - l * PER_LAYER;
        if (r < 1440) conv_tile(p->w_in + (size_t)l * DM * INC, DM, INC, p->norm_mix_g + l * DM, nullptr, DM, (bf16_t*)(ws + OFF_WIN) + (size_t)l * INCP * DM, 0, r, ldsq, mode, true);
        else if ((r -= 1440) < 192) conv_tile(p->w_uq + (size_t)l * QL * 768, QL, 768, p->q_norm_g + l * QL, nullptr, QL, (bf16_t*)(ws + OFF_WUQ) + (size_t)l * 768 * QL, 0, r, ldsq, mode);
        else if ((r -= 192) < 128) conv_tile(p->w_ukv + (size_t)l * KVL * 1024, KVL, 1024, p->kv_norm_g + l * KVL, nullptr, KVL, (bf16_t*)(ws + OFF_WUKV) + (size_t)l * 1024 * KVL, 0, r, ldsq, mode);
        else if ((r -= 128) < 1024) conv_tile(p->w_out + (size_t)l * DM * DM, DM, DM, p->out_norm_mla_g + l * 512, p->out_norm_sg_g + l * 512, 512, (bf16_t*)(ws + OFF_WOUT) + (size_t)l * DM * DM, 0, r, ldsq, mode);
        else if ((r -= 1024) < 1024) conv_tile(p->w_mq + (size_t)l * DM * DM, DM, DM, p->norm_mem_g + l * DM, nullptr, DM, (bf16_t*)(ws + OFF_WMQ) + (size_t)l * DM * DM, 0, r, ldsq, mode, true);
        else if ((r -= 1024) < 2048) conv_tile(p->w_mkv + (size_t)l * DM * 2048, DM, 2048, p->mem_norm_g + l * DM, nullptr, DM, (bf16_t*)(ws + OFF_WMKV) + (size_t)l * 2048 * DM, 0, r, ldsq, mode);
        else if ((r -= 2048) < 1024) conv_tile(p->w_mo + (size_t)l * DM * DM, DM, DM, nullptr, nullptr, DM, (bf16_t*)(ws + OFF_WMO) + (size_t)l * DM * DM, 0, r, ldsq, mode);
        else if ((r -= 1024) < 5632) conv_tile(p->w_up + (size_t)l * DM * 2 * DFF, DM, 2 * DFF, p->norm_ffn_g + l * DM, nullptr, DM, (bf16_t*)(ws + OFF_WUP) + (size_t)l * 2 * DFF * DM, 1, r, ldsq, mode, true);
        else { r -= 5632; conv_tile(p->w_down + (size_t)l * DFF * DM, DFF, DM, nullptr, nullptr, DFF, (bf16_t*)(ws + OFF_WDN) + (size_t)l * DM * DFF, 0, r, ldsq, mode); }
    };
    constexpr int NJOB = PER_LAYER * DEPTH, TPB = 4;
    for (int t0 = blockIdx.x; t0 < NJOB; t0 += TPB * gridDim.x) {
#pragma unroll
        for (int u = 0; u < TPB; ++u) { const int t = t0 + u * gridDim.x; if (t < NJOB) job(t, lds + u * 32 * 33, 0); }
        __syncthreads();
#pragma unroll
        for (int u = 0; u < TPB; ++u) { const int t = t0 + u * gridDim.x; if (t < NJOB) job(t, lds + u * 32 * 33, 1); }
        __syncthreads();
    }
    const size_t gt = (size_t)blockIdx.x * 256 + tid(), gn = (size_t)gridDim.x * 256;
    bf16_t* wsg = (bf16_t*)(ws + OFF_WSG);
    for (size_t i = gt; i < (size_t)DEPTH * 8 * 128 * 128; i += gn) wsg[i] = f2bf(p->sg_w_s[i]);
    for (size_t i = gt; i < (size_t)DEPTH * 96 * DM; i += gn) {
        size_t l = i / (96 * DM), r = i - l * (96 * DM);
        ((bf16_t*)(ws + OFF_WIN))[(l * INCP + INC) * DM + r] = 0;
    }
    {
        {
            const int lane = tid() & 63, wv = blockIdx.x * 4 + (tid() >> 6), nw = gridDim.x * 4;
            float* rsc = (float*)(ws + OFF_RSC);
            for (int row = wv; row < TOK; row += nw) {
                const float4* xs = (const float4*)(p->x + (size_t)row * DM); uint2* xd = (uint2*)(ws + OFF_XB) + (size_t)row * (DM / 4);
                float sacc = 0.f;
#pragma unroll
                for (int i = 0; i < 4; ++i) { float4 v = xs[lane + 64 * i]; sacc += v.x * v.x + v.y * v.y + v.z * v.z + v.w * v.w; uint2 o; o.x = pack2h(v.x, v.y); o.y = pack2h(v.z, v.w); xd[lane + 64 * i] = o; }
#pragma unroll
                for (int o = 1; o < 64; o <<= 1) sacc += __shfl_xor(sacc, o);
                if (lane < 16) rsc[(size_t)row * 16 + lane] = lane == 0 ? sacc : 0.f;
            }
        }
        const float4* ms = (const float4*)p->mem; uint2* md = (uint2*)(ws + OFF_MEMB);
        for (size_t i = gt; i < (size_t)NBATCH * NMEM * DM / 4; i += gn) { float4 v = ms[i]; uint2 o; o.x = pack2(v.x, v.y); o.y = pack2(v.z, v.w); md[i] = o; }
    }
    float* cs = (float*)(ws + OFF_COS); float* sn = (float*)(ws + OFF_SIN);
    for (size_t i = gt; i < (size_t)TOK * 16; i += gn) {
        int tok = (int)(i >> 4), f = (int)(i & 15);
        const float inv = ex2(-(float)f * 0.83048202372184058f);
        const float ang = (float)p->pos[tok] * inv;
        const float c_hi = 0.15915494309189535f, c_lo = 6.4206383e-9f;
        const float rh = ang * c_hi;
        const float re = fmaf(ang, c_hi, -rh) + ang * c_lo;
        float rf = (rh - floorf(rh)) + re;
        cs[i] = __builtin_amdgcn_cosf(rf);
        sn[i] = __builtin_amdgcn_sinf(rf);
    }
}

struct EpiMemKV {
    bf16_t* km; bf16_t* vm; const float* rs; int row0, col0;
    DI void operator()(int rb, int cb, const f32x16& a) const {
        const int lane = tid() & 63, c = lane & 31, h = lane >> 5;
        const int n0 = col0 + cb;
        if (n0 < 1024) {
            const int head = n0 >> 8, d = (n0 & 255) + c;
#pragma unroll
            for (int r = 0; r < 16; ++r) {
                int row = rb + crow(r, h), gr = row0 + row, b = gr >> 8, key = gr & 255;
                km[(((size_t)(b * 4 + head)) * 256 + key) * 256 + d] = f2bf(a[r] * rs[row]);
            }
        } else {
            const int head = (n0 - 1024) >> 8, d = ((n0 - 1024) & 255) + c;
#pragma unroll
            for (int g = 0; g < 4; ++g) {
                int row = rb + 8 * g + 4 * h, gr = row0 + row, b = gr >> 8, key = gr & 255;
                uint2 pk;
                pk.x = pack2(a[4 * g] * rs[row], a[4 * g + 1] * rs[row + 1]);
                pk.y = pack2(a[4 * g + 2] * rs[row + 2], a[4 * g + 3] * rs[row + 3]);
                *(uint2*)(vm + (((size_t)(b * 4 + head)) * 256 + d) * 256 + key) = pk;
            }
        }
    }
};

struct EpiIn {
    bf16_t *hq, *hkv, *u, *v, *kb; const float *cs, *sn, *rs; int row0, col0;
    DI void operator()(int rb, int cb, const f32x16& a) const {
        const int lane = tid() & 63, c = lane & 31, h = lane >> 5;
        const int nb = col0 + cb;
        if (nb >= INC) return;
        if (nb == 384) {
#pragma unroll
            for (int r = 0; r < 16; ++r) {
                const int row = rb + crow(r, h), tok = row0 + row;
                const float val = a[r] * rs[row];
                float pt = __shfl_xor(val, 16);
                float co = cs[tok * 16 + (c & 15)], si = sn[tok * 16 + (c & 15)];
                float o = (c < 16) ? val * co - pt * si : val * co + pt * si;
                bf16_t ob = f2bf(o);
                const int b = tok >> 13, s = tok & 8191;
                bf16_t* dst = kb + (((size_t)(b * 8)) * SEQ + s) * 96 + 64 + c;
                for (int hd = 0; hd < 8; ++hd) dst[(size_t)hd * SEQ * 96] = ob;
            }
            return;
        }
        bf16_t* dst; int pitch, off; bool act;
        if (nb < 256) { dst = hq; pitch = 256; off = nb; act = false; }
        else if (nb < 384) { dst = hkv; pitch = 128; off = nb - 256; act = false; }
        else if (nb < 928) { dst = u; pitch = 512; off = nb - 416; act = true; }
        else { dst = v; pitch = 512; off = nb - 928; act = true; }
        dst += (size_t)(row0 + rb + 4 * h) * pitch + off + c;
#pragma unroll
        for (int r = 0; r < 16; ++r) {
            const int rr = (r & 3) + 8 * (r >> 2);
            float val = a[r] * rs[rb + rr + 4 * h];
            if (act) val = gelu_tanh(val);
            dst[(size_t)rr * pitch] = f2bf(val);
        }
    }
};

struct EpiQ {
    bf16_t* q; const float *cs, *sn, *rs; int row0, col0;
    DI void operator()(int rb, int cb, const f32x16& a) const {
        const int lane = tid() & 63, c = lane & 31, h = lane >> 5;
        const int n0 = col0 + cb, head = n0 / 96, w0 = n0 - head * 96;
        const float qs = 0.10206207261596575f * LOG2E;
#pragma unroll
        for (int r = 0; r < 16; ++r) {
            const int row = rb + crow(r, h), tok = row0 + row;
            float val = a[r] * rs[row] * qs;
            if (w0 == 64) {
                float pt = __shfl_xor(val, 16);
                float co = cs[tok * 16 + (c & 15)], si = sn[tok * 16 + (c & 15)];
                val = (c < 16) ? val * co - pt * si : val * co + pt * si;
            }
            const int b = tok >> 13, s = tok & 8191;
            q[(((size_t)(b * 8 + head)) * SEQ + s) * 96 + w0 + c] = f2bf(val);
        }
    }
};

struct EpiKV {
    bf16_t *kb, *vstage; const float* rs; int row0, col0;
    DI void operator()(int rb, int cb, const f32x16& a) const {
        const int lane = tid() & 63, c = lane & 31, h = lane >> 5;
        const int n0 = col0 + cb, head = n0 >> 7, w0 = n0 & 127;
        if (w0 < 64) {
#pragma unroll
            for (int r = 0; r < 16; ++r) {
                const int row = rb + crow(r, h), tok = row0 + row, b = tok >> 13, s = tok & 8191;
                kb[(((size_t)(b * 8 + head)) * SEQ + s) * 96 + w0 + c] = f2bf(a[r] * rs[row]);
            }
        } else {
            const int d = w0 - 64 + c;
#pragma unroll
            for (int g = 0; g < 4; ++g) {
                const int row = rb + 8 * g + 4 * h;
                uint2 pk;
                pk.x = pack2(a[4 * g] * rs[row], a[4 * g + 1] * rs[row + 1]);
                pk.y = pack2(a[4 * g + 2] * rs[row + 2], a[4 * g + 3] * rs[row + 3]);
                *(uint2*)(vstage + d * 136 + row) = pk;
            }
        }
    }
};

struct EpiRes {
    bf16_t* xb; int row0, col0; bool dry;
    DI void operator()(int rb, int cb, const f32x16& a, f32x16& sq) const {
        const int lane = tid() & 63, c = lane & 31, h = lane >> 5;
        if (dry && a[0] != 1.2345e30f) return;
        bf16_t* ptr = xb + (size_t)(row0 + rb + 4 * h) * DM + col0 + cb + c;
#pragma unroll
        for (int r = 0; r < 16; ++r) {
            const int rr = (r & 3) + 8 * (r >> 2);
            const bf16_t nb = f2h(h2f(ptr[(size_t)rr * DM]) + a[r]);
            ptr[(size_t)rr * DM] = nb;
            const float nv = h2f(nb);
            sq[r] += nv * nv;
        }
    }
};

struct EpiQm {
    bf16_t* qm; const float* rs; int row0, col0;
    DI void operator()(int rb, int cb, const f32x16& a) const {
        const int lane = tid() & 63, c = lane & 31, h = lane >> 5;
#pragma unroll
        for (int r = 0; r < 16; ++r) {
            const int row = rb + crow(r, h);
            qm[(size_t)(row0 + row) * DM + col0 + cb + c] = f2bf(a[r] * rs[row] * (0.0625f * LOG2E));
        }
    }
};

template <int DQK, int DV, int NBUF, bool QREG, int QW, int LDQ, int LDK, int LDV, int LDO>
DI void flash_item(const bf16_t* __restrict__ Qp, const bf16_t* __restrict__ Kp, const bf16_t* __restrict__ Vtp, int nkt,
                   bf16_t* __restrict__ Op, char* smem, float& ssq) {
    constexpr int KP = DQK + 8;
    constexpr int VP = 72;
    constexpr int CPR = DQK / 8;
    constexpr int KCH = 64 * CPR / 256;
    constexpr int VCH = DV * 8 / 256;
    constexpr int NKS = DQK / 16, NMT = DV / 32 / QW;
    constexpr bool KROWS = (256 % CPR) == 0;
    static_assert(KROWS || LDK == DQK, "K tile addressing");
    static_assert(KCH <= 8 && VCH <= 8, "staging regs");
    static_assert(NBUF == 2 ? (KCH <= 4 && VCH <= 2) : (KCH == 8 && VCH == 8), "staging");
    bf16_t* Ks = (bf16_t*)smem;
    bf16_t* Vs = Ks + NBUF * 64 * KP;
    const int t = tid(), lane = t & 63, w = __builtin_amdgcn_readfirstlane(t >> 6), l32 = lane & 31, h = lane >> 5;
    const int q = (w / QW) * 32 + l32, dv0 = (w % QW) * (DV / QW);
    const unsigned ktoff = KROWS ? (unsigned)((t / CPR) * LDK + (t % CPR) * 8) : (unsigned)(t * 8);
    const unsigned vtoff = (unsigned)((t >> 3) * LDV + (t & 7) * 8);

    bf16x8 qf[QREG ? NKS : 1];
    if constexpr (QREG) {
#pragma unroll
        for (int ks = 0; ks < NKS; ++ks) qf[ks] = *(const bf16x8*)(Qp + (size_t)q * LDQ + ks * 16 + 8 * h);
    }
    f32x16 o[NMT];
#pragma unroll
    for (int mt = 0; mt < NMT; ++mt)
#pragma unroll
        for (int r = 0; r < 16; ++r) o[mt][r] = 0.f;
    float m = -INFINITY, lsum = 0.f;

    uint4 rk0, rk1, rk2, rk3, rk4, rk5, rk6, rk7, rv0, rv1;
    (void)rk0; (void)rk1; (void)rk2; (void)rk3; (void)rk4; (void)rk5; (void)rk6; (void)rk7; (void)rv0; (void)rv1;
#define LKJ(kt, i, R) { const bf16_t* kb_ = KROWS ? Kp + (size_t)((kt) * 64 + (i) * (256 / CPR)) * LDK : Kp + (size_t)(kt) * 64 * DQK + (i) * 2048; R = *(const uint4*)(kb_ + ktoff); }
#define SKJ(buf, i, R) { int c = t + 256 * (i), row = c / CPR, cc = c - row * CPR; *(uint4*)(Ks + (buf) * 64 * KP + swap23(row) * KP + cc * 8) = R; }
#define LVJ(kt, i, R) { const bf16_t* vb_ = Vtp + (size_t)(i) * 32 * LDV + (kt) * 64; R = *(const uint4*)(vb_ + vtoff); }
#define SVJ(buf, i, R) { int c = t + 256 * (i), d = c >> 3, cc = c & 7; *(uint4*)(Vs + (buf) * DV * VP + d * VP + cc * 8) = R; }
#define ATT_LOAD(kt) { LKJ(kt, 0, rk0) if constexpr (KCH > 1) LKJ(kt, 1, rk1) if constexpr (KCH > 2) LKJ(kt, 2, rk2) if constexpr (KCH > 3) LKJ(kt, 3, rk3) LVJ(kt, 0, rv0) if constexpr (VCH > 1) LVJ(kt, 1, rv1) }
#define ATT_STORE(buf) { SKJ(buf, 0, rk0) if constexpr (KCH > 1) SKJ(buf, 1, rk1) if constexpr (KCH > 2) SKJ(buf, 2, rk2) if constexpr (KCH > 3) SKJ(buf, 3, rk3) SVJ(buf, 0, rv0) if constexpr (VCH > 1) SVJ(buf, 1, rv1) }

    __syncthreads();
    if constexpr (NBUF == 2) ATT_LOAD(0);
    for (int kt = 0; kt < nkt; ++kt) {
        const int buf = (NBUF == 2) ? (kt & 1) : 0;
        if constexpr (NBUF == 1) {
            __syncthreads();
            LKJ(kt, 0, rk0) LKJ(kt, 1, rk1) LKJ(kt, 2, rk2) LKJ(kt, 3, rk3)
            LKJ(kt, 4, rk4) LKJ(kt, 5, rk5) LKJ(kt, 6, rk6) LKJ(kt, 7, rk7)
            SKJ(0, 0, rk0) SKJ(0, 1, rk1) SKJ(0, 2, rk2) SKJ(0, 3, rk3)
            asm volatile("" ::: "memory");
            LVJ(kt, 0, rk0) LVJ(kt, 1, rk1) LVJ(kt, 2, rk2) LVJ(kt, 3, rk3)
            SKJ(0, 4, rk4) SKJ(0, 5, rk5) SKJ(0, 6, rk6) SKJ(0, 7, rk7)
            asm volatile("" ::: "memory");
            LVJ(kt, 4, rk4) LVJ(kt, 5, rk5) LVJ(kt, 6, rk6) LVJ(kt, 7, rk7)
            SVJ(0, 0, rk0) SVJ(0, 1, rk1) SVJ(0, 2, rk2) SVJ(0, 3, rk3)
            asm volatile("" ::: "memory");
            SVJ(0, 4, rk4) SVJ(0, 5, rk5) SVJ(0, 6, rk6) SVJ(0, 7, rk7)
        } else { ATT_STORE(buf); }
        __syncthreads();
        if constexpr (NBUF == 2) { if (kt + 1 < nkt) ATT_LOAD(kt + 1); }

        const bf16_t* kb = Ks + buf * 64 * KP + l32 * KP + 8 * h;
        f32x16 s0, s1;
#pragma unroll
        for (int r = 0; r < 16; ++r) { s0[r] = 0.f; s1[r] = 0.f; }
#pragma unroll
        for (int ks = 0; ks < NKS; ++ks) {
            bf16x8 qq;
            if constexpr (QREG) qq = qf[ks]; else qq = *(const bf16x8*)(Qp + (size_t)q * LDQ + ks * 16 + 8 * h);
            bf16x8 k0 = *(const bf16x8*)(kb + ks * 16);
            bf16x8 k1 = *(const bf16x8*)(kb + 32 * KP + ks * 16);
            s0 = MFMA(k0, qq, s0);
            s1 = MFMA(k1, qq, s1);
        }
        float mx = s0[0];
#pragma unroll
        for (int r = 1; r < 16; ++r) mx = fmaxf(mx, s0[r]);
#pragma unroll
        for (int r = 0; r < 16; ++r) mx = fmaxf(mx, s1[r]);
        mx = fmaxf(mx, __shfl_xor(mx, 32));
        const float mn = fmaxf(m, mx);
        const float alpha = ex2(m - mn);
        m = mn;
        float psum = 0.f;
#pragma unroll
        for (int r = 0; r < 16; ++r) { s0[r] = ex2(s0[r] - mn); psum += s0[r]; }
#pragma unroll
        for (int r = 0; r < 16; ++r) { s1[r] = ex2(s1[r] - mn); psum += s1[r]; }
        lsum = lsum * alpha + psum;
        if (__builtin_amdgcn_ballot_w64(alpha != 1.f) != 0ull) {
#pragma unroll
            for (int mt = 0; mt < NMT; ++mt)
#pragma unroll
                for (int r = 0; r < 16; ++r) o[mt][r] *= alpha;
        }
        const bf16_t* vb = Vs + buf * DV * VP + (dv0 + l32) * VP + 8 * h;
#pragma unroll
        for (int t2 = 0; t2 < 2; ++t2)
#pragma unroll
            for (int s2 = 0; s2 < 2; ++s2) {
                u32x4 pu;
#pragma unroll
                for (int j = 0; j < 4; ++j)
                    pu[j] = t2 ? pack2(s1[8 * s2 + 2 * j], s1[8 * s2 + 2 * j + 1]) : pack2(s0[8 * s2 + 2 * j], s0[8 * s2 + 2 * j + 1]);
                const bf16x8 pfv = __builtin_bit_cast(bf16x8, pu);
#pragma unroll
                for (int mt = 0; mt < NMT; ++mt) {
                    bf16x8 vv = *(const bf16x8*)(vb + mt * 32 * VP + t2 * 32 + s2 * 16);
                    o[mt] = MFMA(vv, pfv, o[mt]);
                }
            }
    }
#undef ATT_LOAD
#undef ATT_STORE
#undef LKJ
#undef SKJ
#undef LVJ
#undef SVJ
    const float inv = 1.f / (lsum + __shfl_xor(lsum, 32));
#pragma unroll
    for (int mt = 0; mt < NMT; ++mt)
#pragma unroll
        for (int g = 0; g < 4; ++g) {
            float v0 = o[mt][4 * g] * inv, v1 = o[mt][4 * g + 1] * inv, v2 = o[mt][4 * g + 2] * inv, v3 = o[mt][4 * g + 3] * inv;
            uint2 pk; pk.x = pack2(v0, v1); pk.y = pack2(v2, v3);
            float r0 = bflo(pk.x), r1 = bfhi(pk.x), r2 = bflo(pk.y), r3 = bfhi(pk.y);
            ssq += r0 * r0 + r1 * r1 + r2 * r2 + r3 * r3;
            *(uint2*)(Op + (size_t)q * LDO + dv0 + mt * 32 + 8 * g + 4 * h) = pk;
        }
}

DI void flash_mla2(const bf16_t* __restrict__ Qp, const bf16_t* __restrict__ Kp, const bf16_t* __restrict__ Vtp,
                   bf16_t* __restrict__ Op, char* smem, float& ssq) {
    constexpr int DQK = 96, DV = 64, LDQ = 96, LDV = SEQ, LDO = DM, NKT = SEQ / 64;
    constexpr int KP = DQK + 8, VP = 72, CPR = DQK / 8, NKS = DQK / 16, NMT = DV / 32;
    bf16_t* Ks = (bf16_t*)smem;
    bf16_t* Vs = Ks + 2 * 64 * KP;
    const int t = tid(), lane = t & 63, w = __builtin_amdgcn_readfirstlane(t >> 6), l32 = lane & 31, h = lane >> 5;
    const int q = w * 32 + l32;
    const unsigned ktoff = (unsigned)(t * 8);
    const unsigned vtoff = (unsigned)((t >> 3) * LDV + (t & 7) * 8);
    bf16x8 qf[NKS];
#pragma unroll
    for (int ks = 0; ks < NKS; ++ks) qf[ks] = *(const bf16x8*)(Qp + (size_t)q * LDQ + ks * 16 + 8 * h);
    f32x16 o[NMT];
#pragma unroll
    for (int mt = 0; mt < NMT; ++mt)
#pragma unroll
        for (int r = 0; r < 16; ++r) o[mt][r] = 0.f;
    float m = 0.f, lsum = 0.f;
    uint4 ak0, ak1, ak2, av0, av1, bk0, bk1, bk2, bv0, bv1;
#define M2_LOAD(S, kt) { const bf16_t* kb_ = Kp + (size_t)(kt) * 64 * DQK; S##k0 = *(const uint4*)(kb_ + ktoff); S##k1 = *(const uint4*)(kb_ + 2048 + ktoff); S##k2 = *(const uint4*)(kb_ + 4096 + ktoff); \
        const bf16_t* vb_ = Vtp + (kt) * 64; S##v0 = *(const uint4*)(vb_ + vtoff); S##v1 = *(const uint4*)(vb_ + (size_t)32 * LDV + vtoff); }
#define M2_SK(i, R, buf) { int c = t + 256 * (i), row = c / CPR, cc = c - row * CPR; *(uint4*)(Ks + (buf) * 64 * KP + swap23(row) * KP + cc * 8) = R; }
#define M2_SV(i, R, buf) { int c = t + 256 * (i), d = c >> 3, cc = c & 7; *(uint4*)(Vs + (buf) * DV * VP + d * VP + cc * 8) = R; }
#define M2_STORE(S, buf) { M2_SK(0, S##k0, buf) M2_SK(1, S##k1, buf) M2_SK(2, S##k2, buf) M2_SV(0, S##v0, buf) M2_SV(1, S##v1, buf) }
#define M2_COMPUTE(buf) { \
        if (__builtin_amdgcn_ballot_w64(alpha != 1.f) != 0ull) { \
            _Pragma("unroll") for (int mt = 0; mt < NMT; ++mt) _Pragma("unroll") for (int r = 0; r < 16; ++r) o[mt][r] *= alpha; } \
        lsum *= alpha; \
        const bf16_t* kb = Ks + (buf) * 64 * KP + l32 * KP + 8 * h; \
        f32x16 s0, s1; \
        const float nm = -m; \
        _Pragma("unroll") for (int r = 0; r < 16; ++r) { s0[r] = nm; s1[r] = nm; } \
        _Pragma("unroll") for (int ks = 0; ks < NKS; ++ks) { bf16x8 k0 = *(const bf16x8*)(kb + ks * 16); bf16x8 k1 = *(const bf16x8*)(kb + 32 * KP + ks * 16); s0 = MFMA(k0, qf[ks], s0); s1 = MFMA(k1, qf[ks], s1); } \
        float mx = s0[0]; \
        _Pragma("unroll") for (int r = 1; r < 16; ++r) mx = fmaxf(mx, s0[r]); \
        _Pragma("unroll") for (int r = 0; r < 16; ++r) mx = fmaxf(mx, s1[r]); \
        mx = fmaxf(mx, __shfl_xor(mx, 32)); \
        float psum = 0.f; \
        _Pragma("unroll") for (int r = 0; r < 16; ++r) { s0[r] = ex2(s0[r]); psum += s0[r]; } \
        _Pragma("unroll") for (int r = 0; r < 16; ++r) { s1[r] = ex2(s1[r]); psum += s1[r]; } \
        lsum += psum; \
        const float dgrow = fmaxf(mx, 0.f); alpha = ex2(-dgrow); m += dgrow; \
        const bf16_t* vb = Vs + (buf) * DV * VP + l32 * VP + 8 * h; \
        _Pragma("unroll") for (int s2 = 0; s2 < 2; ++s2) { \
            u32x4 pu0, pu1; \
            _Pragma("unroll") for (int j = 0; j < 4; ++j) { pu0[j] = pack2(s0[8 * s2 + 2 * j], s0[8 * s2 + 2 * j + 1]); pu1[j] = pack2(s1[8 * s2 + 2 * j], s1[8 * s2 + 2 * j + 1]); } \
            const bf16x8 pf0 = __builtin_bit_cast(bf16x8, pu0), pf1 = __builtin_bit_cast(bf16x8, pu1); \
            _Pragma("unroll") for (int mt = 0; mt < NMT; ++mt) { \
                bf16x8 v0 = *(const bf16x8*)(vb + mt * 32 * VP + s2 * 16); bf16x8 v1 = *(const bf16x8*)(vb + mt * 32 * VP + 32 + s2 * 16); \
                o[mt] = MFMA(v0, pf0, o[mt]); o[mt] = MFMA(v1, pf1, o[mt]); } } }

    float alpha = 1.f;
    __syncthreads();
    M2_LOAD(a, 0);
    M2_LOAD(b, 1);
    {
        M2_STORE(a, 0);
        __syncthreads();
        const bf16_t* kb = Ks + l32 * KP + 8 * h;
        f32x16 s0, s1;
#pragma unroll
        for (int r = 0; r < 16; ++r) { s0[r] = 0.f; s1[r] = 0.f; }
#pragma unroll
        for (int ks = 0; ks < NKS; ++ks) { bf16x8 k0 = *(const bf16x8*)(kb + ks * 16); bf16x8 k1 = *(const bf16x8*)(kb + 32 * KP + ks * 16); s0 = MFMA(k0, qf[ks], s0); s1 = MFMA(k1, qf[ks], s1); }
        float mx = s0[0];
#pragma unroll
        for (int r = 1; r < 16; ++r) mx = fmaxf(mx, s0[r]);
#pragma unroll
        for (int r = 0; r < 16; ++r) mx = fmaxf(mx, s1[r]);
        m = fmaxf(mx, __shfl_xor(mx, 32));
        __syncthreads();
    }
    for (int kt = 0; kt < NKT; kt += 2) {
        M2_STORE(a, 0);
        __syncthreads();
        M2_LOAD(a, min(kt + 2, NKT - 1));
        M2_COMPUTE(0);
        M2_STORE(b, 1);
        __syncthreads();
        M2_LOAD(b, min(kt + 3, NKT - 1));
        M2_COMPUTE(1);
    }
#undef M2_LOAD
#undef M2_SK
#undef M2_SV
#undef M2_STORE
#undef M2_COMPUTE
    const float inv = 1.f / (lsum + __shfl_xor(lsum, 32));
#pragma unroll
    for (int mt = 0; mt < NMT; ++mt)
#pragma unroll
        for (int g = 0; g < 4; ++g) {
            float v0 = o[mt][4 * g] * inv, v1 = o[mt][4 * g + 1] * inv, v2 = o[mt][4 * g + 2] * inv, v3 = o[mt][4 * g + 3] * inv;
            uint2 pk; pk.x = pack2(v0, v1); pk.y = pack2(v2, v3);
            float r0 = bflo(pk.x), r1 = bfhi(pk.x), r2 = bflo(pk.y), r3 = bfhi(pk.y);
            ssq += r0 * r0 + r1 * r1 + r2 * r2 + r3 * r3;
            *(uint2*)(Op + (size_t)q * LDO + mt * 32 + 8 * g + 4 * h) = pk;
        }
}

DI void mla_item(KP p, int item, char* smem) {
    const int b = item >> 6, qb = item & 63;
    const bf16_t* Q = (const bf16_t*)(p->ws + OFF_Q);
    const bf16_t* K = (const bf16_t*)(p->ws + OFF_K);
    const bf16_t* Vt = (const bf16_t*)(p->ws + OFF_VT);
    bf16_t* om = (bf16_t*)(p->ws + OFF_OMIX) + ((size_t)b * SEQ + qb * 128) * DM;
    float ssq = 0.f;
    for (int hd = 0; hd < 8; ++hd) {
        const size_t bh = (size_t)(b * 8 + hd);
        flash_mla2(Q + (bh * SEQ + qb * 128) * 96, K + bh * SEQ * 96, Vt + bh * 64 * SEQ, om + hd * 64, smem, ssq);
    }
    ssq += __shfl_xor(ssq, 32);
    const float sc = rsqrtf(ssq * (1.f / 512.f) + EPS);
    const int lane = tid() & 63, w = tid() >> 6, q = w * 32 + (lane & 31), h = lane >> 5;
    for (int i = 0; i < 64; ++i) {
        uint2* ptr = (uint2*)(om + (size_t)q * DM + (i >> 3) * 64 + ((i >> 2) & 1) * 32 + (i & 3) * 8 + 4 * h);
        uint2 v = *ptr;
        v.x = pack2(bflo(v.x) * sc, bfhi(v.x) * sc);
        v.y = pack2(bflo(v.y) * sc, bfhi(v.y) * sc);
        *ptr = v;
    }
}

DI void memattn_item(KP p, int l, int item, char* smem) {
    const int head = item & 3, qt = (item >> 2) & 127, b = item >> 9;
    const bf16_t* qm = (const bf16_t*)(p->ws + OFF_QM) + ((size_t)b * SEQ + qt * 64) * DM + head * 256;
    const bf16_t* km = (const bf16_t*)(p->ws + OFF_KMEM) + ((size_t)((l * NBATCH + b) * 4 + head)) * 256 * 256;
    const bf16_t* vm = (const bf16_t*)(p->ws + OFF_VMEM) + ((size_t)((l * NBATCH + b) * 4 + head)) * 256 * 256;
    bf16_t* om = (bf16_t*)(p->ws + OFF_OMEM) + ((size_t)b * SEQ + qt * 64) * DM + head * 256;
    float dummy = 0.f;
    flash_item<256, 256, 1, true, 2, DM, 256, 256, DM>(qm, km, vm, 4, om, smem, dummy);
}

DI void gmlp_item(KP p, int l, int ci, char* smem) {
    constexpr int AP = 136;
    bf16_t* As = (bf16_t*)smem;
    bf16_t* Bs = As + 128 * AP;
    float* st = (float*)(Bs + 64 * AP);
    const int t = tid(), lane = t & 63, w = __builtin_amdgcn_readfirstlane(t >> 6), l32 = lane & 31, h = lane >> 5;
    const int tok0 = ci * 128;
    const bf16_t* vbuf = (const bf16_t*)(p->ws + OFF_V) + (size_t)tok0 * 512;
    const bf16_t* ubuf = (const bf16_t*)(p->ws + OFF_U) + (size_t)(tok0 + w * 32) * 512;
    bf16_t* om = (bf16_t*)(p->ws + OFF_OMIX) + (size_t)(tok0 + w * 32) * DM + 512;
    const bf16_t* wsg = (const bf16_t*)(p->ws + OFF_WSG) + (size_t)l * 8 * 128 * 128;
    const float* lng = p->sg_ln_g + l * 512; const float* lnb = p->sg_ln_b + l * 512;
    const float* bs = p->sg_b_s + l * 8 * 128 + w * 32;
    __syncthreads();
    {
        const int row = t >> 1, half = t & 1;
        const uint4* src = (const uint4*)(vbuf + (size_t)row * 512 + half * 256);
        float s = 0.f, s2 = 0.f;
#pragma unroll 4
        for (int i = 0; i < 32; ++i) {
            uint4 qv = src[i];
            float a0 = bflo(qv.x), a1 = bfhi(qv.x), a2 = bflo(qv.y), a3 = bfhi(qv.y), a4 = bflo(qv.z), a5 = bfhi(qv.z), a6 = bflo(qv.w), a7 = bfhi(qv.w);
            s += a0 + a1 + a2 + a3 + a4 + a5 + a6 + a7;
            s2 += a0 * a0 + a1 * a1 + a2 * a2 + a3 * a3 + a4 * a4 + a5 * a5 + a6 * a6 + a7 * a7;
        }
        s += __shfl_xor(s, 1); s2 += __shfl_xor(s2, 1);
        const float mean = s * (1.f / 512.f);
        const float var = fmaxf(s2 * (1.f / 512.f) - mean * mean, 0.f);
        if (half == 0) { st[2 * row] = mean; st[2 * row + 1] = rsqrtf(var + EPS); }
    }
    __syncthreads();
    float ssq[16];
#pragma unroll
    for (int r = 0; r < 16; ++r) ssq[r] = 0.f;
    const unsigned wtoff = (unsigned)((t >> 4) * 128 + (t & 15) * 8);
    const unsigned vtoff = (unsigned)((t >> 3) * 512 + (t & 7) * 8);
    const unsigned eoff_u = (unsigned)(4 * h * 512 + l32), eoff_o = (unsigned)(4 * h * DM + l32);
    for (int hd = 0; hd < 8; ++hd) {
        const bf16_t* wh = wsg + (size_t)hd * 128 * 128;
#pragma unroll
        for (int i = 0; i < 8; ++i)
            *(uint4*)(As + ((t >> 4) + 16 * i) * AP + (t & 15) * 8) = *(const uint4*)(wh + i * 16 * 128 + wtoff);
#pragma unroll
        for (int i = 0; i < 4; ++i) {
            const int j = (t >> 3) + 32 * i, c8 = t & 7;
            uint4 qv = *(const uint4*)(vbuf + (size_t)i * 32 * 512 + hd * 64 + vtoff);
            const float mean = st[2 * j], rstd = st[2 * j + 1];
            const int ch = hd * 64 + c8 * 8;
            const float4 g0 = *(const float4*)(lng + ch), g1 = *(const float4*)(lng + ch + 4);
            const float4 b0 = *(const float4*)(lnb + ch), b1 = *(const float4*)(lnb + ch + 4);
            bf16_t* bd = Bs + (c8 * 8) * AP + j;
            bd[0 * AP] = f2bf((bflo(qv.x) - mean) * rstd * g0.x + b0.x);
            bd[1 * AP] = f2bf((bfhi(qv.x) - mean) * rstd * g0.y + b0.y);
            bd[2 * AP] = f2bf((bflo(qv.y) - mean) * rstd * g0.z + b0.z);
            bd[3 * AP] = f2bf((bfhi(qv.y) - mean) * rstd * g0.w + b0.w);
            bd[4 * AP] = f2bf((bflo(qv.z) - mean) * rstd * g1.x + b1.x);
            bd[5 * AP] = f2bf((bfhi(qv.z) - mean) * rstd * g1.y + b1.y);
            bd[6 * AP] = f2bf((bflo(qv.w) - mean) * rstd * g1.z + b1.z);
            bd[7 * AP] = f2bf((bfhi(qv.w) - mean) * rstd * g1.w + b1.w);
        }
        __syncthreads();
        f32x16 acc[2];
#pragma unroll
        for (int r = 0; r < 16; ++r) { acc[0][r] = 0.f; acc[1][r] = 0.f; }
        const bf16_t* a_s = As + (w * 32 + l32) * AP + 8 * h;
        const bf16_t* b_s = Bs + l32 * AP + 8 * h;
#pragma unroll
        for (int ks = 0; ks < 8; ++ks) {
            bf16x8 a = *(const bf16x8*)(a_s + ks * 16);
            bf16x8 b0 = *(const bf16x8*)(b_s + ks * 16);
            bf16x8 b1 = *(const bf16x8*)(b_s + 32 * AP + ks * 16);
            acc[0] = MFMA(a, b0, acc[0]);
            acc[1] = MFMA(a, b1, acc[1]);
        }
#pragma unroll
        for (int j2 = 0; j2 < 2; ++j2)
#pragma unroll
            for (int r = 0; r < 16; ++r) {
                const int rr = (r & 3) + 8 * (r >> 2);
                const float val = acc[j2][r] + (bs + hd * 128 + rr)[4 * h];
                const bf16_t ob = f2bf(bf2f((ubuf + (size_t)rr * 512 + hd * 64 + j2 * 32)[eoff_u]) * val);
                (om + (size_t)rr * DM + hd * 64 + j2 * 32)[eoff_o] = ob;
                const float of = bf2f(ob);
                ssq[r] += of * of;
            }
        __syncthreads();
    }
#pragma unroll
    for (int r = 0; r < 16; ++r) {
        float s = ssq[r];
        s += __shfl_xor(s, 1); s += __shfl_xor(s, 2); s += __shfl_xor(s, 4); s += __shfl_xor(s, 8); s += __shfl_xor(s, 16);
        ssq[r] = rsqrtf(s * (1.f / 512.f) + EPS);
    }
    for (int i = 0; i < 16; ++i) {
#pragma unroll
        for (int r = 0; r < 16; ++r) {
            const int rr = (r & 3) + 8 * (r >> 2);
            bf16_t* ptr = om + (size_t)rr * DM + i * 32 + eoff_o;
            *ptr = f2bf(bf2f(*ptr) * ssq[r]);
        }
    }
}

DI void ph_memkv(KP p, char* smem) {
    for_tiles(DEPTH * 16 * 16, [&](int t) __attribute__((always_inline)) {
        const int l = t >> 8, rt = (t >> 4) & 15, ct = t & 15;
        f32x16 acc[2][2];
        gemm_tile<1>((const bf16_t*)(p->ws + OFF_MEMB), DM, rt * 128, 0, NBATCH * NMEM, (const bf16_t*)(p->ws + OFF_WMKV) + ((size_t)l * 2048 + ct * 128) * DM, DM, DM, smem, acc);
        EpiMemKV e{(bf16_t*)(p->ws + OFF_KMEM) + (size_t)l * NBATCH * 4 * 256 * 256, (bf16_t*)(p->ws + OFF_VMEM) + (size_t)l * NBATCH * 4 * 256 * 256,
                   (const float*)(smem + RS_OFF), rt * 128, ct * 128};
        run_epi(acc, e);
    });
}
DI float* stage_tile(const f32x16 (&acc)[2][2], const float* rs, char* smem) {
    const int tt = tid(), lane = tt & 63, w = __builtin_amdgcn_readfirstlane(tt >> 6), wm = w >> 1, wn = w & 1, l32 = lane & 31, h = lane >> 5;
    float* stg = (float*)smem;
#pragma unroll
    for (int i = 0; i < 2; ++i)
#pragma unroll
        for (int j = 0; j < 2; ++j)
#pragma unroll
            for (int r = 0; r < 16; ++r) {
                const int row = wm * 64 + i * 32 + crow(r, h);
                stg[row * 132 + wn * 64 + j * 32 + l32] = rs ? acc[i][j][r] * rs[row] : acc[i][j][r];
            }
    __syncthreads();
    return stg;
}
DI uint4 pack8(const float4& a, const float4& b) { uint4 o; o.x = pack2(a.x, a.y); o.y = pack2(a.z, a.w); o.z = pack2(b.x, b.y); o.w = pack2(b.z, b.w); return o; }
DI float4 gelu4(const float4& a) { float4 o; o.x = gelu_tanh(a.x); o.y = gelu_tanh(a.y); o.z = gelu_tanh(a.z); o.w = gelu_tanh(a.w); return o; }
DI void rope8(float4& lo, float4& hi, const float4& plo, const float4& phi, const float* cs, const float* sn, int c) {
    const float4 c0 = *(const float4*)(cs + (c & 15)), c1 = *(const float4*)(cs + (c & 15) + 4);
    const float4 s0 = *(const float4*)(sn + (c & 15)), s1 = *(const float4*)(sn + (c & 15) + 4);
    const float sg = c < 16 ? -1.f : 1.f;
    lo.x = lo.x * c0.x + sg * plo.x * s0.x; lo.y = lo.y * c0.y + sg * plo.y * s0.y; lo.z = lo.z * c0.z + sg * plo.z * s0.z; lo.w = lo.w * c0.w + sg * plo.w * s0.w;
    hi.x = hi.x * c1.x + sg * phi.x * s1.x; hi.y = hi.y * c1.y + sg * phi.y * s1.y; hi.z = hi.z * c1.z + sg * phi.z * s1.z; hi.w = hi.w * c1.w + sg * phi.w * s1.w;
}

DI void ph_in(KP p, int l, const float* xin, char* smem) {
    for_tiles(512 * 12, [&](int t) __attribute__((always_inline)) {
        int rt, ct; tile_rc(t, 12, rt, ct);
        f32x16 acc[2][2];
        const float rsp = rs_load(p, rt * 128);
        gemm_tile<0, true>((const bf16_t*)(p->ws + OFF_XB), DM, rt * 128, 0, TOK, (const bf16_t*)(p->ws + OFF_WIN) + ((size_t)l * INCP + ct * 128) * DM, DM, DM, smem, acc);
        rs_finish(rsp, rt * 128, smem);
        const float* stg = stage_tile(acc, (const float*)(smem + RS_OFF), smem);
        const int tt = tid(), c8 = tt & 15, nb = ct * 128 + c8 * 8;
        if (nb < INC) {
#pragma unroll
            for (int i = 0; i < 8; ++i) {
                const int row = (tt >> 4) + 16 * i, tok = rt * 128 + row;
                float4 lo = *(const float4*)(stg + row * 132 + c8 * 8), hi = *(const float4*)(stg + row * 132 + c8 * 8 + 4);
                if (nb < 256) *(uint4*)((bf16_t*)(p->ws + OFF_HQ) + (size_t)tok * 256 + nb) = pack8(lo, hi);
                else if (nb < 384) *(uint4*)((bf16_t*)(p->ws + OFF_HKV) + (size_t)tok * 128 + (nb - 256)) = pack8(lo, hi);
                else if (nb < 416) {
                    const int c = nb - 384, pc = c8 * 8 + (c < 16 ? 16 : -16);
                    const float4 plo = *(const float4*)(stg + row * 132 + pc), phi = *(const float4*)(stg + row * 132 + pc + 4);
                    rope8(lo, hi, plo, phi, (const float*)(p->ws + OFF_COS) + (size_t)tok * 16, (const float*)(p->ws + OFF_SIN) + (size_t)tok * 16, c);
                    const uint4 ov = pack8(lo, hi);
                    const int b = tok >> 13, sx = tok & 8191;
                    bf16_t* dst = (bf16_t*)(p->ws + OFF_K) + (((size_t)(b * 8)) * SEQ + sx) * 96 + 64 + c;
#pragma unroll
                    for (int hd = 0; hd < 8; ++hd) *(uint4*)(dst + (size_t)hd * SEQ * 96) = ov;
                } else if (nb < 928) *(uint4*)((bf16_t*)(p->ws + OFF_U) + (size_t)tok * 512 + (nb - 416)) = pack8(gelu4(lo), gelu4(hi));
                else *(uint4*)((bf16_t*)(p->ws + OFF_V) + (size_t)tok * 512 + (nb - 928)) = pack8(gelu4(lo), gelu4(hi));
            }
        }
    });
}
DI void ph_qkv(KP p, int l, char* smem) {
    for_tiles(512 * 14, [&](int t) __attribute__((always_inline)) {
        int rt, ct; tile_rc(t, 14, rt, ct);
        f32x16 acc[2][2];
        if (ct < 6) {
            gemm_tile<1>((const bf16_t*)(p->ws + OFF_HQ), QL, rt * 128, 0, TOK, (const bf16_t*)(p->ws + OFF_WUQ) + ((size_t)l * 768 + ct * 128) * QL, QL, QL, smem, acc);
            const float* stg = stage_tile(acc, (const float*)(smem + RS_OFF), smem);
            const int tt = tid(), c8 = tt & 15, n8 = ct * 128 + c8 * 8, head = n8 / 96, w0 = n8 - head * 96;
            const float qs = 0.10206207261596575f * LOG2E;
#pragma unroll
            for (int i = 0; i < 8; ++i) {
                const int row = (tt >> 4) + 16 * i, tok = rt * 128 + row;
                float4 lo = *(const float4*)(stg + row * 132 + c8 * 8), hi = *(const float4*)(stg + row * 132 + c8 * 8 + 4);
                if (w0 >= 64) {
                    const int c = w0 - 64, pc = c8 * 8 + (c < 16 ? 16 : -16);
                    const float4 plo = *(const float4*)(stg + row * 132 + pc), phi = *(const float4*)(stg + row * 132 + pc + 4);
                    rope8(lo, hi, plo, phi, (const float*)(p->ws + OFF_COS) + (size_t)tok * 16, (const float*)(p->ws + OFF_SIN) + (size_t)tok * 16, c);
                }
                lo.x *= qs; lo.y *= qs; lo.z *= qs; lo.w *= qs; hi.x *= qs; hi.y *= qs; hi.z *= qs; hi.w *= qs;
                const int b = tok >> 13, sx = tok & 8191;
                *(uint4*)((bf16_t*)(p->ws + OFF_Q) + (((size_t)(b * 8 + head)) * SEQ + sx) * 96 + w0) = pack8(lo, hi);
            }
        } else {
            const int c2 = ct - 6;
            gemm_tile<1>((const bf16_t*)(p->ws + OFF_HKV), KVL, rt * 128, 0, TOK, (const bf16_t*)(p->ws + OFF_WUKV) + ((size_t)l * 1024 + c2 * 128) * KVL, KVL, KVL, smem, acc);
            const float* stg = stage_tile(acc, (const float*)(smem + RS_OFF), smem);
            const int tt = tid(), tok0 = rt * 128, b = tok0 >> 13, s0 = tok0 & 8191;
            {
                const int c8 = tt & 7;
#pragma unroll
                for (int i = 0; i < 4; ++i) {
                    const int row = (tt >> 3) + 32 * i;
                    const float4 lo = *(const float4*)(stg + row * 132 + c8 * 8), hi = *(const float4*)(stg + row * 132 + c8 * 8 + 4);
                    *(uint4*)((bf16_t*)(p->ws + OFF_K) + (((size_t)(b * 8 + c2)) * SEQ + s0 + row) * 96 + c8 * 8) = pack8(lo, hi);
                }
            }
            {
                const int tc = tt & 15;
#pragma unroll
                for (int i = 0; i < 4; ++i) {
                    const int d = (tt >> 4) + 16 * i;
                    const float* sp = stg + (tc * 8) * 132 + 64 + d;
                    uint4 ov;
                    ov.x = pack2(sp[0], sp[132]); ov.y = pack2(sp[2 * 132], sp[3 * 132]); ov.z = pack2(sp[4 * 132], sp[5 * 132]); ov.w = pack2(sp[6 * 132], sp[7 * 132]);
                    *(uint4*)((bf16_t*)(p->ws + OFF_VT) + (((size_t)(b * 8 + c2)) * 64 + d) * SEQ + s0 + tc * 8) = ov;
                }
            }
        }
    });
}
DI void ph_mix(KP p, int l, char* smem) {
    for_tiles(512, [&](int t) __attribute__((always_inline)) { mla_item(p, t, smem); });
    for_tiles(512, [&](int t) __attribute__((always_inline)) { gmlp_item(p, l, t, smem); });
}
DI void ph_res(KP p, const bf16_t* A, int K, const bf16_t* Wt, const float* xin, char* smem, bool dry) {
    for_tiles(512 * 8, [&](int t) __attribute__((always_inline)) {
        int rt, ct; tile_rc(t, 8, rt, ct);
        f32x16 acc[2][2];
        gemm_tile<0>(A, K, rt * 128, 0, TOK, Wt + (size_t)ct * 128 * K, K, K, smem, acc);
        if (dry) return;
        const int tt = tid(), lane = tt & 63, w = __builtin_amdgcn_readfirstlane(tt >> 6), wm = w >> 1, wn = w & 1, l32 = lane & 31, h = lane >> 5;
        float* stg = (float*)smem;
#pragma unroll
        for (int i = 0; i < 2; ++i)
#pragma unroll
            for (int j = 0; j < 2; ++j)
#pragma unroll
                for (int r = 0; r < 16; ++r) stg[(wm * 64 + i * 32 + crow(r, h)) * 132 + wn * 64 + j * 32 + l32] = acc[i][j][r];
        __syncthreads();
        bf16_t* xb = (bf16_t*)(p->ws + OFF_XB) + (size_t)(rt * 128) * DM + ct * 128;
        float* part = (float*)(p->ws + OFF_RSC) + (size_t)(rt * 128) * 16 + ct * 2;
        const int c8 = tt & 15;
#pragma unroll
        for (int i = 0; i < 8; ++i) {
            const int row = (tt >> 4) + 16 * i;
            const float4 lo = *(const float4*)(stg + row * 132 + c8 * 8), hi = *(const float4*)(stg + row * 132 + c8 * 8 + 4);
            uint4* gp = (uint4*)(xb + (size_t)row * DM + c8 * 8);
            const uint4 xv = *gp;
            uint4 nv;
            nv.x = pack2h(hlo(xv.x) + lo.x, hhi(xv.x) + lo.y); nv.y = pack2h(hlo(xv.y) + lo.z, hhi(xv.y) + lo.w);
            nv.z = pack2h(hlo(xv.z) + hi.x, hhi(xv.z) + hi.y); nv.w = pack2h(hlo(xv.w) + hi.z, hhi(xv.w) + hi.w);
            *gp = nv;
            float s0 = hlo(nv.x), s1 = hhi(nv.x), s2 = hlo(nv.y), s3 = hhi(nv.y), s4 = hlo(nv.z), s5 = hhi(nv.z), s6 = hlo(nv.w), s7 = hhi(nv.w);
            float sq = s0 * s0 + s1 * s1 + s2 * s2 + s3 * s3 + s4 * s4 + s5 * s5 + s6 * s6 + s7 * s7;
            sq += __shfl_xor(sq, 1); sq += __shfl_xor(sq, 2); sq += __shfl_xor(sq, 4); sq += __shfl_xor(sq, 8);
            if (c8 == 0) { float2 pv; pv.x = sq; pv.y = 0.f; *(float2*)(part + (size_t)row * 16) = pv; }
        }
    });
}
DI void ph_qm(KP p, int l, char* smem) {
    for_tiles(512 * 8, [&](int t) __attribute__((always_inline)) {
        int rt, ct; tile_rc(t, 8, rt, ct);
        f32x16 acc[2][2];
        const float rsp = rs_load(p, rt * 128);
        gemm_tile<0, true>((const bf16_t*)(p->ws + OFF_XB), DM, rt * 128, 0, TOK, (const bf16_t*)(p->ws + OFF_WMQ) + ((size_t)l * DM + ct * 128) * DM, DM, DM, smem, acc);
        rs_finish(rsp, rt * 128, smem);
        const float* stg = stage_tile(acc, (const float*)(smem + RS_OFF), smem);
        const int tt = tid(), c8 = tt & 15;
        const float qs = 0.0625f * LOG2E;
#pragma unroll
        for (int i = 0; i < 8; ++i) {
            const int row = (tt >> 4) + 16 * i;
            float4 lo = *(const float4*)(stg + row * 132 + c8 * 8), hi = *(const float4*)(stg + row * 132 + c8 * 8 + 4);
            lo.x *= qs; lo.y *= qs; lo.z *= qs; lo.w *= qs; hi.x *= qs; hi.y *= qs; hi.z *= qs; hi.w *= qs;
            *(uint4*)((bf16_t*)(p->ws + OFF_QM) + (size_t)(rt * 128 + row) * DM + ct * 128 + c8 * 8) = pack8(lo, hi);
        }
    });
}
DI void ph_memattn(KP p, int l, char* smem) {
    for_tiles(NBATCH * 128 * 4, [&](int t) __attribute__((always_inline)) { memattn_item(p, l, t, smem); });
}
typedef float f32p __attribute__((ext_vector_type(2)));
DI void ph_up(KP p, int l, char* smem) {
    for_tiles(NBATCH * 66 * 44, [&](int t) __attribute__((always_inline)) {
        int rt, ct; tile_rc(t, 44, rt, ct);
        const int b = rt / 66, rl = rt - b * 66, s0 = rl * 126;
        const float* cw = p->conv_w + (size_t)l * 3 * 2 * DFF; const float* cb = p->conv_b + (size_t)l * 2 * DFF;
        const int cp2 = (tid() & 31) * 2, c = ct * 64 + cp2, c2 = DFF + c;
        const f32p g0 = *(const f32p*)(cw + c), g1 = *(const f32p*)(cw + 2 * DFF + c), g2 = *(const f32p*)(cw + 4 * DFF + c), gb = *(const f32p*)(cb + c);
        const f32p u0 = *(const f32p*)(cw + c2), u1 = *(const f32p*)(cw + 2 * DFF + c2), u2 = *(const f32p*)(cw + 4 * DFF + c2), ub = *(const f32p*)(cb + c2);
        f32x16 acc[2][2];
        const float rsp = rs_load(p, b * SEQ + s0 - 1);
        if (rl == 0 || rl == 65) gemm_tile<0, true, true>((const bf16_t*)(p->ws + OFF_XB), DM, b * SEQ + s0 - 1, b * SEQ, (b + 1) * SEQ, (const bf16_t*)(p->ws + OFF_WUP) + ((size_t)l * 2 * DFF + ct * 128) * DM, DM, DM, smem, acc);
        else gemm_tile<0, true, false>((const bf16_t*)(p->ws + OFF_XB), DM, b * SEQ + s0 - 1, b * SEQ, (b + 1) * SEQ, (const bf16_t*)(p->ws + OFF_WUP) + ((size_t)l * 2 * DFF + ct * 128) * DM, DM, DM, smem, acc);
        rs_finish(rsp, b * SEQ + s0 - 1, smem);
        const float* rs = (const float*)(smem + RS_OFF);
        float* stg = (float*)smem;
        const int tt = tid(), lane = tt & 63, w = __builtin_amdgcn_readfirstlane(tt >> 6), wm = w >> 1, wn = w & 1, l32 = lane & 31, h = lane >> 5;
#pragma unroll
        for (int i = 0; i < 2; ++i)
#pragma unroll
            for (int j = 0; j < 2; ++j)
#pragma unroll
                for (int r = 0; r < 16; ++r) {
                    const int row = wm * 64 + i * 32 + crow(r, h), col = wn * 64 + j * 32 + l32;
                    stg[row * 130 + col] = acc[i][j][r] * rs[row];
                }
        __syncthreads();
        bf16_t* act = (bf16_t*)(p->ws + OFF_ACT);
        const int rmax = min(126, SEQ - s0);
        const int rbeg = w * 32 + h * 16, rend = min(rbeg + 16, rmax);
        if (rbeg < rend) {
            const float* sg = stg + rbeg * 130 + cp2;
            unsigned* arow = (unsigned*)(act + ((size_t)b * SEQ + s0 + rbeg) * DFF + c);
            f32p ga = *(const f32p*)sg, gm = *(const f32p*)(sg + 130), ua = *(const f32p*)(sg + 64), um = *(const f32p*)(sg + 130 + 64);
#pragma unroll 4
            for (int r = rbeg; r < rend; ++r) {
                sg += 130;
                const f32p gn = *(const f32p*)(sg + 130), un = *(const f32p*)(sg + 130 + 64);
                const f32p g = g0 * ga + g1 * gm + g2 * gn + gb;
                const f32p up = u0 * ua + u1 * um + u2 * un + ub;
                const f32p e = g * (-LOG2E);
                f32p den; den.x = 1.f + ex2(e.x); den.y = 1.f + ex2(e.y);
                f32p sig; sig.x = __builtin_amdgcn_rcpf(den.x); sig.y = __builtin_amdgcn_rcpf(den.y);
                const f32p o = g * sig * up;
                *arow = pack2(o.x, o.y);
                arow += DFF / 2;
                ga = gm; gm = gn; ua = um; um = un;
            }
        }
    });
}
DI void ph_final(KP p) {
    const int lane = tid() & 63, wv = blockIdx.x * 4 + (tid() >> 6), nw = gridDim.x * 4;
    const bf16_t* xbp = (const bf16_t*)(p->ws + OFF_XB);
    const float* rsc = (const float*)(p->ws + OFF_RSC);
    for (int row = wv; row < TOK; row += nw) {
        const uint4* xr = (const uint4*)(xbp + (size_t)row * DM);
        float4* orow = (float4*)(p->out + (size_t)row * DM);
        float ps = lane < 16 ? rsc[(size_t)row * 16 + lane] : 0.f;
        ps += __shfl_xor(ps, 1); ps += __shfl_xor(ps, 2); ps += __shfl_xor(ps, 4); ps += __shfl_xor(ps, 8);
        const float sc = rsqrtf(__shfl(ps, 0) * (1.f / DM) + EPS);
#pragma unroll
        for (int i = 0; i < 2; ++i) {
            const uint4 v = xr[lane + 64 * i];
            const float4 g0 = ((const float4*)p->final_norm_g)[2 * (lane + 64 * i)], g1 = ((const float4*)p->final_norm_g)[2 * (lane + 64 * i) + 1];
            float4 o0, o1;
            o0.x = hlo(v.x) * sc * g0.x; o0.y = hhi(v.x) * sc * g0.y; o0.z = hlo(v.y) * sc * g0.z; o0.w = hhi(v.y) * sc * g0.w;
            o1.x = hlo(v.z) * sc * g1.x; o1.y = hhi(v.z) * sc * g1.y; o1.z = hlo(v.w) * sc * g1.z; o1.w = hhi(v.w) * sc * g1.w;
            orow[2 * (lane + 64 * i)] = o0; orow[2 * (lane + 64 * i) + 1] = o1;
        }
    }
}

#define XB_TMO      128
#define XB_XCNT(j)  (256  + 64 * (j))
#define XB_XSUB(j)  (1280 + 64 * (j))
#define XB_XGEN(j)  (2304 + 64 * (j))
#define XB_TOP      3328
#define XB_TOPGEN   3392
#define XCD_BAR_WORDS 3456
#define XB_SPIN_CAP (1u << 22)
#define LAS __attribute__((address_space(3)))
static_assert(XCD_BAR_WORDS * 4 <= BAR_BYTES, "barrier words");
DI unsigned xb_ld(unsigned* p) { return __hip_atomic_load(p, __ATOMIC_RELAXED, __HIP_MEMORY_SCOPE_AGENT); }
DI unsigned xb_add(unsigned* p, unsigned v) { return __hip_atomic_fetch_add(p, v, __ATOMIC_RELAXED, __HIP_MEMORY_SCOPE_AGENT); }
DI unsigned xb_xcc_id() { return (unsigned)__builtin_amdgcn_s_getreg((3 << 11) | 20) & 0xFu; }
#define XB_SPIN(cond, bar) do { unsigned _sp = 0; while (cond) { __builtin_amdgcn_s_sleep(1); \
    if ((++_sp & 255u) == 0u) { if (xb_ld(&(bar)[XB_TMO])) break; if (_sp > XB_SPIN_CAP) { atomicAdd(&(bar)[XB_TMO], 1u); break; } } } } while (0)
struct XcdBarrier { unsigned* bar; unsigned x; volatile LAS unsigned* st; };
DI XcdBarrier xcd_barrier_post(unsigned* bar, volatile LAS unsigned* st) {
    XcdBarrier b; b.bar = bar; b.x = xb_xcc_id(); b.st = st;
    if (threadIdx.x == 0) (void)xb_add(&bar[XB_XCNT(b.x)], 1u);
    return b;
}
DI void xcd_barrier_complete(unsigned* bar, unsigned x, unsigned& nloc, unsigned& nx) {
    const unsigned G = gridDim.x * gridDim.y * gridDim.z;
    unsigned sum, cnt, mine, sp = 0u;
    for (;;) {
        sum = 0u; cnt = 0u; mine = 0u;
#pragma unroll
        for (unsigned j = 0; j < 16; ++j) { const unsigned c = xb_ld(&bar[XB_XCNT(j)]); sum += c; cnt += (c > 0u) ? 1u : 0u; mine = (j == x) ? c : mine; }
        if (sum == G) break;
        __builtin_amdgcn_s_sleep(1);
        if ((++sp & 255u) == 0u) { if (xb_ld(&bar[XB_TMO])) break; if (sp > XB_SPIN_CAP) { atomicAdd(&bar[XB_TMO], 1u); break; } }
    }
    nloc = mine > 0u ? mine : 1u; nx = cnt > 0u ? cnt : 1u;
}
DI void xcd_barrier(const XcdBarrier& b) {
    asm volatile("s_waitcnt vmcnt(0)" ::: "memory");
    __syncthreads();
    if (threadIdx.x == 0) {
        unsigned* bar = b.bar;
        __builtin_amdgcn_s_waitcnt(0);
        unsigned nloc = b.st[0], nx = b.st[1];
        if (nloc == 0u) { xcd_barrier_complete(bar, b.x, nloc, nx); b.st[0] = nloc; b.st[1] = nx; }
        const unsigned old = xb_add(&bar[XB_XSUB(b.x)], 1u);
        const unsigned gen = old / nloc;
        if (old + 1u == (gen + 1u) * nloc) {
            __builtin_amdgcn_fence(__ATOMIC_RELEASE, "agent");
            asm volatile("s_waitcnt vmcnt(0)" ::: "memory");
            const unsigned og = xb_add(&bar[XB_TOP], 1u);
            const unsigned tg = og / nx;
            if (og + 1u == (tg + 1u) * nx) xb_add(&bar[XB_TOPGEN], 1u);
            else XB_SPIN(xb_ld(&bar[XB_TOPGEN]) == tg, bar);
            __builtin_amdgcn_fence(__ATOMIC_ACQUIRE, "agent");
            xb_add(&bar[XB_XGEN(b.x)], 1u);
            asm volatile("s_waitcnt vmcnt(0)" ::: "memory");
        } else {
            XB_SPIN(xb_ld(&bar[XB_XGEN(b.x)]) == gen, bar);
            __builtin_amdgcn_fence(__ATOMIC_ACQUIRE, "agent");
            asm volatile("s_waitcnt vmcnt(0)" ::: "memory");
        }
    }
    __syncthreads();
}

constexpr int NPHASE = 2 + 9 * DEPTH + 1;
__global__ void __launch_bounds__(256, 2) mk(Params p_unused, int lo, int hi) {
    extern __shared__ __attribute__((aligned(16))) char smem[];
    cg::grid_group grid = cg::this_grid();
    volatile LAS unsigned* xst = (volatile LAS unsigned*)(smem + RS_OFF + 512);
    if (threadIdx.x == 0) { xst[0] = 0u; xst[1] = 0u; xst[2] = 0u; xst[3] = 0u; }
    __syncthreads();
    const XcdBarrier xbar = xcd_barrier_post((unsigned*)(kparams()->ws + OFF_BAR), xst);
    for (int ph = lo; ph < hi; ++ph) {
        KP p = kparams();
        if (ph == 0) phase_setup(p, smem);
        else if (ph == 1) ph_memkv(p, smem);
        else if (ph == NPHASE - 1) ph_final(p);
        else {
            const int l = (ph - 2) / 9, s = (ph - 2) % 9;
            const float* xin = l == 0 ? p->x : p->out;
            const int reps = ((REPMASK >> s) & 1) ? 2 : 1;
            for (int rep = 0; rep < reps; ++rep) {
                const bool dry = rep + 1 < reps;
                switch (s) {
                    case 0: ph_in(p, l, xin, smem); break;
                    case 1: ph_qkv(p, l, smem); break;
                    case 2: ph_mix(p, l, smem); break;
                    case 3: ph_res(p, (const bf16_t*)(p->ws + OFF_OMIX), DM, (const bf16_t*)(p->ws + OFF_WOUT) + (size_t)l * DM * DM, xin, smem, dry); break;
                    case 4: ph_qm(p, l, smem); break;
                    case 5: ph_memattn(p, l, smem); break;
                    case 6: ph_res(p, (const bf16_t*)(p->ws + OFF_OMEM), DM, (const bf16_t*)(p->ws + OFF_WMO) + (size_t)l * DM * DM, p->out, smem, dry); break;
                    case 7: ph_up(p, l, smem); break;
                    case 8: ph_res(p, (const bf16_t*)(p->ws + OFF_ACT), DFF, (const bf16_t*)(p->ws + OFF_WDN) + (size_t)l * DM * DFF, p->out, smem, dry); break;
                }
                if (dry) xcd_barrier(xbar);
            }
        }
        if (ph + 1 < hi) { if (ph == 0) grid.sync(); else xcd_barrier(xbar); }
    }
}

extern "C" void kernel_launch(void* const* d_in, const int* in_sizes, int n_in, void* d_out, int out_size, void* d_ws, size_t ws_size, hipStream_t stream) {
    static int grid_blocks = 0;
    if (!grid_blocks) {
        int dev = 0, cus = 0, per_cu = 0;
        hipGetDevice(&dev);
        hipDeviceGetAttribute(&cus, hipDeviceAttributeMultiprocessorCount, dev);
        hipFuncSetAttribute((const void*)mk, hipFuncAttributeMaxDynamicSharedMemorySize, LDS_BYTES);
        hipOccupancyMaxActiveBlocksPerMultiprocessor(&per_cu, (const void*)mk, 256, LDS_BYTES);
        if (per_cu < 1) per_cu = 1;
        if (per_cu > 2) per_cu = 2;
        grid_blocks = cus * per_cu;
        if (ws_size < OFF_END) fprintf(stderr, "kernel_launch: workspace too small: %zu < %zu\n", ws_size, (size_t)OFF_END);
    }
    Params p{};
    const float** fp = (const float**)&p;
    p.x = (const float*)d_in[0]; p.mem = (const float*)d_in[1]; p.pos = (const int*)d_in[2];
    p.norm_mix_g = (const float*)d_in[3]; p.w_in = (const float*)d_in[4]; p.q_norm_g = (const float*)d_in[5]; p.w_uq = (const float*)d_in[6];
    p.kv_norm_g = (const float*)d_in[7]; p.w_ukv = (const float*)d_in[8]; p.sg_ln_g = (const float*)d_in[9]; p.sg_ln_b = (const float*)d_in[10];
    p.sg_w_s = (const float*)d_in[11]; p.sg_b_s = (const float*)d_in[12]; p.out_norm_mla_g = (const float*)d_in[13]; p.out_norm_sg_g = (const float*)d_in[14];
    p.w_out = (const float*)d_in[15]; p.norm_mem_g = (const float*)d_in[16]; p.mem_norm_g = (const float*)d_in[17]; p.w_mq = (const float*)d_in[18];
    p.w_mkv = (const float*)d_in[19]; p.w_mo = (const float*)d_in[20]; p.norm_ffn_g = (const float*)d_in[21]; p.w_up = (const float*)d_in[22];
    p.conv_w = (const float*)d_in[23]; p.conv_b = (const float*)d_in[24]; p.w_down = (const float*)d_in[25]; p.final_norm_g = (const float*)d_in[26];
    p.out = (float*)d_out; p.ws = (char*)d_ws;
    (void)fp;
    (void)hipMemsetAsync((char*)d_ws + OFF_BAR, 0, BAR_BYTES, stream);
#if COOP
    int lo = 0, hi = NPHASE;
    void* args[] = {&p, &lo, &hi};
    hipError_t e = hipLaunchCooperativeKernel((const void*)mk, dim3(grid_blocks), dim3(256), args, LDS_BYTES, stream);
    if (e != hipSuccess) fprintf(stderr, "cooperative launch failed: %s (grid %d)\n", hipGetErrorString(e), grid_blocks);
#else
    for (int ph = 0; ph < NPHASE; ++ph) hipLaunchKernelGGL(mk, dim3(grid_blocks), dim3(256), LDS_BYTES, stream, p, ph, ph + 1);
#endif
}
```

```cpp
#include <hip/hip_runtime.h>
#include <hip/hip_cooperative_groups.h>
#include <stdint.h>
#include <stdio.h>
namespace cg = cooperative_groups;

#ifndef PHMASK
#define PHMASK 0xFFFF
#endif
#ifndef REPMASK
#define REPMASK 0
#endif
#ifndef COOP
#define COOP 1
#endif

typedef unsigned short bf16_t;
typedef __attribute__((ext_vector_type(8))) short bf16x8;
typedef __attribute__((ext_vector_type(16))) float f32x16;
typedef __attribute__((ext_vector_type(4))) unsigned u32x4;
#define DI __device__ __forceinline__
#define MFMA(a, b, c) __builtin_amdgcn_mfma_f32_32x32x16_bf16((a), (b), (c), 0, 0, 0)

constexpr int NBATCH = 8, SEQ = 8192, TOK = NBATCH * SEQ, DM = 1024, DEPTH = 4;
constexpr int NMEM = 256, QL = 256, KVL = 128, ROPE = 32, NOPE = 64, VD = 64, NH = 8;
constexpr int SGW = 512, INC = 1440, INCP = 1536, DFF = 2816;
constexpr float EPS = 1e-6f;
constexpr float LOG2E = 1.4426950408889634f;

constexpr size_t al256(size_t x) { return (x + 255) & ~(size_t)255; }
constexpr size_t SZ_WIN = (size_t)DEPTH * INCP * DM * 2;
constexpr size_t SZ_WUQ = (size_t)DEPTH * 768 * QL * 2;
constexpr size_t SZ_WUKV = (size_t)DEPTH * 1024 * KVL * 2;
constexpr size_t SZ_WS = (size_t)DEPTH * 8 * 128 * 128 * 2;
constexpr size_t SZ_W1K = (size_t)DEPTH * DM * DM * 2;
constexpr size_t SZ_WMKV = (size_t)DEPTH * 2048 * DM * 2;
constexpr size_t SZ_WUP = (size_t)DEPTH * 2 * DFF * DM * 2;
constexpr size_t SZ_WDN = (size_t)DEPTH * DM * DFF * 2;
constexpr size_t OFF_WIN = 0;
constexpr size_t OFF_WUQ = OFF_WIN + SZ_WIN;
constexpr size_t OFF_WUKV = OFF_WUQ + SZ_WUQ;
constexpr size_t OFF_WSG = OFF_WUKV + SZ_WUKV;
constexpr size_t OFF_WOUT = OFF_WSG + SZ_WS;
constexpr size_t OFF_WMQ = OFF_WOUT + SZ_W1K;
constexpr size_t OFF_WMKV = OFF_WMQ + SZ_W1K;
constexpr size_t OFF_WMO = OFF_WMKV + SZ_WMKV;
constexpr size_t OFF_WUP = OFF_WMO + SZ_W1K;
constexpr size_t OFF_WDN = OFF_WUP + SZ_WUP;
constexpr size_t OFF_COS = OFF_WDN + SZ_WDN;
constexpr size_t OFF_SIN = OFF_COS + (size_t)TOK * 16 * 4;
constexpr size_t OFF_KMEM = OFF_SIN + (size_t)TOK * 16 * 4;
constexpr size_t SZ_KMEM = (size_t)DEPTH * NBATCH * 4 * 256 * 256 * 2;
constexpr size_t OFF_VMEM = OFF_KMEM + SZ_KMEM;
constexpr size_t OFF_ACT0 = OFF_VMEM + SZ_KMEM;
constexpr size_t OFF_Q = OFF_ACT0;
constexpr size_t OFF_K = OFF_Q + (size_t)TOK * 8 * 96 * 2;
constexpr size_t OFF_VT = OFF_K + (size_t)TOK * 8 * 96 * 2;
constexpr size_t OFF_U = OFF_VT + (size_t)TOK * 512 * 2;
constexpr size_t OFF_V = OFF_U + (size_t)TOK * 512 * 2;
constexpr size_t OFF_OMIX = OFF_V + (size_t)TOK * 512 * 2;
constexpr size_t OFF_HQ = OFF_OMIX + (size_t)TOK * 1024 * 2;
constexpr size_t OFF_HKV = OFF_HQ + (size_t)TOK * 256 * 2;
constexpr size_t OFF_XB = OFF_HKV + (size_t)TOK * 128 * 2;
constexpr size_t OFF_MEMB = OFF_XB + (size_t)TOK * DM * 2;
constexpr size_t OFF_RSC = OFF_MEMB + (size_t)NBATCH * NMEM * DM * 2;
constexpr size_t OFF_BAR = OFF_RSC + (size_t)TOK * 16 * 4;
constexpr size_t BAR_BYTES = 16384;
constexpr size_t OFF_END = OFF_BAR + BAR_BYTES;
constexpr size_t OFF_QM = OFF_Q;
constexpr size_t OFF_OMEM = OFF_OMIX;
constexpr size_t OFF_ACT = OFF_ACT0;
static_assert(OFF_ACT + (size_t)TOK * DFF * 2 <= OFF_XB, "act alias");
static_assert(OFF_END <= (size_t)1000 * 1024 * 1024, "ws budget");

struct Params {
    const float *x, *mem; const int* pos;
    const float *norm_mix_g, *w_in, *q_norm_g, *w_uq, *kv_norm_g, *w_ukv, *sg_ln_g, *sg_ln_b, *sg_w_s, *sg_b_s,
        *out_norm_mla_g, *out_norm_sg_g, *w_out, *norm_mem_g, *mem_norm_g, *w_mq, *w_mkv, *w_mo, *norm_ffn_g, *w_up,
        *conv_w, *conv_b, *w_down, *final_norm_g;
    float* out; char* ws;
};

typedef const __attribute__((address_space(4))) Params* KP;
DI KP kparams() { KP k = (KP)__builtin_amdgcn_kernarg_segment_ptr(); asm volatile("" : "+s"(k)); return k; }
typedef __bf16 bf16v2_t __attribute__((ext_vector_type(2)));
typedef float f32v2_t __attribute__((ext_vector_type(2)));
DI unsigned pack2(float a, float b) { f32v2_t v = {a, b}; return __builtin_bit_cast(unsigned, __builtin_convertvector(v, bf16v2_t)); }
DI bf16_t f2bf(float f) { return (bf16_t)(pack2(f, f) & 0xffffu); }
typedef _Float16 f16x8 __attribute__((ext_vector_type(8)));
typedef _Float16 f16v2_t __attribute__((ext_vector_type(2)));
DI unsigned pack2h(float a, float b) { f16v2_t v = {(_Float16)a, (_Float16)b}; return __builtin_bit_cast(unsigned, v); }
DI bf16_t f2h(float f) { return __builtin_bit_cast(unsigned short, (_Float16)f); }
DI float h2f(bf16_t u) { return (float)__builtin_bit_cast(_Float16, u); }
DI float hlo(unsigned u) { return h2f((bf16_t)(u & 0xffffu)); }
DI float hhi(unsigned u) { return h2f((bf16_t)(u >> 16)); }
#define MFMA_H(a, b, c) __builtin_amdgcn_mfma_f32_32x32x16_f16(__builtin_bit_cast(f16x8, (a)), __builtin_bit_cast(f16x8, (b)), (c), 0, 0, 0)
DI float bf2f(bf16_t b) { return __uint_as_float((unsigned)b << 16); }
DI float bflo(unsigned u) { return __uint_as_float(u << 16); }
DI float bfhi(unsigned u) { return __uint_as_float(u & 0xffff0000u); }
DI float ex2(float x) { return __builtin_amdgcn_exp2f(x); }
DI float gelu_tanh(float x) { float y = 0.7978845608028654f * (x + 0.044715f * x * x * x); return x * __builtin_amdgcn_rcpf(1.f + ex2(-2.f * LOG2E * y)); }
DI float silu(float x) { return x * __builtin_amdgcn_rcpf(1.f + ex2(-LOG2E * x)); }
DI int tid() { int t = threadIdx.x; asm volatile("" : "+v"(t)); return t; }
DI int crow(int r, int h) { return (r & 3) + 8 * (r >> 2) + 4 * h; }
DI int swap23(int r) { return (r & ~12) | ((r & 4) << 1) | ((r & 8) >> 1); }

template <class F> DI void for_tiles(int ntiles, F f) {
    const int G = gridDim.x, b = blockIdx.x;
    const bool sw = (G & 7) == 0;
    const int tpx = (ntiles + 7) >> 3;
    const int start = sw ? (b >> 3) : b, step = sw ? (G >> 3) : G, lim = sw ? tpx : ntiles, base = sw ? (b & 7) * tpx : 0;
    for (int i = start; i < lim; i += step) {
        const int t = base + i;
        if (t < ntiles) f(t);
    }
}

constexpr int LK = 72;
constexpr int GEMM_LDS = 4 * 128 * LK * 2;
constexpr int RS_OFF = GEMM_LDS;
constexpr int LDS_BYTES = GEMM_LDS + 1024;

template <int AMODE, bool F16 = false, bool MASK = false>
DI void gemm_tile(const bf16_t* __restrict__ Ab, int lda, int row0, int rlo, int rhi,
                  const bf16_t* __restrict__ Bt, int ldb, int K, char* smem, f32x16 (&acc)[2][2]) {
    const int t = tid(), lane = t & 63, w = __builtin_amdgcn_readfirstlane(t >> 6), wm = w >> 1, wn = w & 1, l32 = lane & 31, h = lane >> 5;
    bf16_t* As = (bf16_t*)smem;
    bf16_t* Bs = As + 2 * 128 * LK;
    float* rs = (float*)(smem + RS_OFF);
#pragma unroll
    for (int i = 0; i < 2; ++i)
#pragma unroll
        for (int j = 0; j < 2; ++j)
#pragma unroll
            for (int r = 0; r < 16; ++r) acc[i][j][r] = 0.f;

    uint4 p0a0, p0a1, p0a2, p0a3, p0b0, p0b1, p0b2, p0b3, p1a0, p1a1, p1a2, p1a3, p1b0, p1b1, p1b2, p1b3;
    float ss0 = 0.f, ss1 = 0.f, ss2 = 0.f, ss3 = 0.f;
    const int gr0 = row0 + (t >> 3);
    const bool rv0 = gr0 >= rlo && gr0 < rhi, rv1 = gr0 + 32 >= rlo && gr0 + 32 < rhi, rv2 = gr0 + 64 >= rlo && gr0 + 64 < rhi, rv3 = gr0 + 96 >= rlo && gr0 + 96 < rhi;
    const int nk = K >> 6;
    const int rhm = rhi - 1;
    const unsigned aoff0 = (unsigned)min(max(gr0, rlo), rhm) * (unsigned)lda + 8u * (t & 7);
    const unsigned aoff1 = (unsigned)min(max(gr0 + 32, rlo), rhm) * (unsigned)lda + 8u * (t & 7);
    const unsigned aoff2 = (unsigned)min(max(gr0 + 64, rlo), rhm) * (unsigned)lda + 8u * (t & 7);
    const unsigned aoff3 = (unsigned)min(max(gr0 + 96, rlo), rhm) * (unsigned)lda + 8u * (t & 7);
    const unsigned btoff = (unsigned)((t >> 3) * ldb + 8 * (t & 7));

    __syncthreads();

#define LD1(S, j, k0)                                                                                         \
    {                                                                                                         \
        S##a##j = *(const uint4*)(Ab + (k0) + aoff##j);          \
        S##b##j = *(const uint4*)(Bt + (size_t)(32 * j) * ldb + (k0) + btoff);                                \
    }
#define LOADS(S, k0) { LD1(S, 0, k0) LD1(S, 1, k0) LD1(S, 2, k0) LD1(S, 3, k0) }
#define ST1(S, j, buf)                                                                                        \
    {                                                                                                         \
        uint4 v = S##a##j;                                                                                    \
        if constexpr (MASK) { if (!rv##j) v = make_uint4(0, 0, 0, 0); }     \
        if (AMODE == 1) {                                                                                     \
            float a0 = bflo(v.x), a1 = bfhi(v.x), a2 = bflo(v.y), a3 = bfhi(v.y), a4 = bflo(v.z), a5 = bfhi(v.z), a6 = bflo(v.w), a7 = bfhi(v.w); \
            ss##j += a0 * a0 + a1 * a1 + a2 * a2 + a3 * a3 + a4 * a4 + a5 * a5 + a6 * a6 + a7 * a7;          \
        }                                                                                                     \
        *(uint4*)(As + (buf) * 128 * LK + ((t >> 3) + 32 * j) * LK + 8 * (t & 7)) = v;                        \
        *(uint4*)(Bs + (buf) * 128 * LK + ((t >> 3) + 32 * j) * LK + 8 * (t & 7)) = S##b##j;                  \
    }
#define STORES(S, buf) { ST1(S, 0, buf) ST1(S, 1, buf) ST1(S, 2, buf) ST1(S, 3, buf) }
#define FRAGS(ks, A0, A1, B0, B1) { A0 = *(const bf16x8*)(a_s + (ks) * 16); A1 = *(const bf16x8*)(a_s + 32 * LK + (ks) * 16); B0 = *(const bf16x8*)(b_s + (ks) * 16); B1 = *(const bf16x8*)(b_s + 32 * LK + (ks) * 16); }
#define MMAS(A0, A1, B0, B1) { __builtin_amdgcn_s_setprio(1); if constexpr (F16) { acc[0][0] = MFMA_H(A0, B0, acc[0][0]); acc[0][1] = MFMA_H(A0, B1, acc[0][1]); acc[1][0] = MFMA_H(A1, B0, acc[1][0]); acc[1][1] = MFMA_H(A1, B1, acc[1][1]); } else { acc[0][0] = MFMA(A0, B0, acc[0][0]); acc[0][1] = MFMA(A0, B1, acc[0][1]); acc[1][0] = MFMA(A1, B0, acc[1][0]); acc[1][1] = MFMA(A1, B1, acc[1][1]); } __builtin_amdgcn_s_setprio(0); }
#define COMPUTE(buf)                                                                                          \
    {                                                                                                         \
        const bf16_t* a_s = As + (buf) * 128 * LK + (wm * 64 + l32) * LK + h * 8;                             \
        const bf16_t* b_s = Bs + (buf) * 128 * LK + (wn * 64 + l32) * LK + h * 8;                             \
        bf16x8 xa0, xa1, xb0, xb1, ya0, ya1, yb0, yb1;                                                        \
        FRAGS(0, xa0, xa1, xb0, xb1)                                                                          \
        FRAGS(1, ya0, ya1, yb0, yb1)                                                                          \
        MMAS(xa0, xa1, xb0, xb1)                                                                              \
        FRAGS(2, xa0, xa1, xb0, xb1)                                                                          \
        MMAS(ya0, ya1, yb0, yb1)                                                                              \
        FRAGS(3, ya0, ya1, yb0, yb1)                                                                          \
        MMAS(xa0, xa1, xb0, xb1)                                                                              \
        MMAS(ya0, ya1, yb0, yb1)                                                                              \
    }

    const int klast = (nk - 1) * 64;
    LOADS(p0, 0);
    LOADS(p1, 64);
    STORES(p0, 0);
    LOADS(p0, min(128, klast));
    __syncthreads();
    for (int kt = 0; kt < nk; kt += 2) {
        COMPUTE(0);
        STORES(p1, 1);
        LOADS(p1, min((kt + 3) * 64, klast));
        __syncthreads();
        COMPUTE(1);
        if (kt + 2 < nk) STORES(p0, 0);
        LOADS(p0, min((kt + 4) * 64, klast));
        __syncthreads();
    }
#undef LOADS
#undef STORES
#undef COMPUTE
#undef FRAGS
#undef MMAS
#undef LD1
#undef ST1
    if (AMODE == 1) {
#define RS1(j) { float s = ss##j; s += __shfl_xor(s, 1); s += __shfl_xor(s, 2); s += __shfl_xor(s, 4); if ((t & 7) == 0) rs[(t >> 3) + 32 * j] = rsqrtf(s / (float)K + EPS); }
        RS1(0) RS1(1) RS1(2) RS1(3)
#undef RS1
        __syncthreads();
    }
}

DI float rs_load(KP p, int row0) {
    const int t = tid(), r = row0 + (t >> 1);
    float sum = 0.f;
    if (r >= 0 && r < TOK) {
        const float4* ps = (const float4*)((const float*)(p->ws + OFF_RSC) + (size_t)r * 16 + (t & 1) * 8);
        const float4 a = ps[0], b = ps[1];
        sum = (a.x + a.y) + (a.z + a.w) + (b.x + b.y) + (b.z + b.w);
    }
    return sum;
}
DI void rs_finish(float sum, int row0, char* smem) {
    const int t = tid(), r = row0 + (t >> 1);
    sum += __shfl_xor(sum, 1);
    if ((t & 1) == 0) ((float*)(smem + RS_OFF))[t >> 1] = (r >= 0 && r < TOK) ? rsqrtf(sum * (1.f / DM) + EPS) : 0.f;
    __syncthreads();
}

DI void tile_rc(int t, int NT, int& rt, int& ct) { const int g = t / (8 * NT), rem = t - g * 8 * NT; ct = rem >> 3; rt = g * 8 + (rem & 7); }

template <class E> DI void run_epi(const f32x16 (&acc)[2][2], const E& e) {
    const int w = __builtin_amdgcn_readfirstlane(tid() >> 6), wm = w >> 1, wn = w & 1;
#pragma unroll
    for (int i = 0; i < 2; ++i)
#pragma unroll
        for (int j = 0; j < 2; ++j) e(wm * 64 + i * 32, wn * 64 + j * 32, acc[i][j]);
}

DI int up_perm(int n) { return n < DFF ? (n >> 6) * 128 + (n & 63) : ((n - DFF) >> 6) * 128 + 64 + ((n - DFF) & 63); }

DI void conv_tile(const float* __restrict__ src, int K, int N, const float* g1, const float* g2, int ksplit,
                  bf16_t* __restrict__ dst, int rowmap, int tile, float* lds, int mode, bool f16 = false) {
    const int ntn = N >> 5, tk = tile / ntn, tn = tile - tk * ntn, k0 = tk * 32, n0 = tn * 32;
    const int tx = tid() & 31, ty = tid() >> 5;
    if (mode == 0) {
#pragma unroll
        for (int i = 0; i < 4; ++i) {
            int k = k0 + ty + 8 * i;
            float v = src[(size_t)k * N + n0 + tx];
            float g = g1 ? (k < ksplit ? g1[k] : g2[k - ksplit]) : 1.f;
            lds[(ty + 8 * i) * 33 + tx] = v * g;
        }
    } else {
#pragma unroll
        for (int i = 0; i < 4; ++i) {
            int n = n0 + ty + 8 * i;
            int nn = rowmap ? up_perm(n) : n;
            const float wv = lds[tx * 33 + ty + 8 * i];
            dst[(size_t)nn * K + k0 + tx] = f16 ? f2h(wv) : f2bf(wv);
        }
    }
}

__device__ void phase_setup(KP p, char* smem) {
    float* lds = (float*)smem;
    char* ws = p->ws;
    constexpr int PER_LAYER = 1440 + 192 + 128 + 1024 + 1024 + 2048 + 1024 + 5632 + 2816;
    auto job = [&](int t, float* ldsq, int mode) __attribute__((always_inline)) {
        int l = t / PER_LAYER, r = t - l * PER_LAYER;
        if (r < 1440) conv_tile(p->w_in + (size_t)l * DM * INC, DM, INC, p->norm_mix_g + l * DM, nullptr, DM, (bf16_t*)(ws + OFF_WIN) + (size_t)l * INCP * DM, 0, r, ldsq, mode, true);
        else if ((r -= 1440) < 192) conv_tile(p->w_uq + (size_t)l * QL * 768, QL, 768, p->q_norm_g + l * QL, nullptr, QL, (bf16_t*)(ws + OFF_WUQ) + (size_t)l * 768 * QL, 0, r, ldsq, mode);
        else if ((r -= 192) < 128) conv_tile(p->w_ukv + (size_t)l * KVL * 1024, KVL, 1024, p->kv_norm_g + l * KVL, nullptr, KVL, (bf16_t*)(ws + OFF_WUKV) + (size_t)l * 1024 * KVL, 0, r, ldsq, mode);
        else if ((r -= 128) < 1024) conv_tile(p->w_out + (size_t)l * DM * DM, DM, DM, p->out_norm_mla_g + l * 512, p->out_norm_sg_g + l * 512, 512, (bf16_t*)(ws + OFF_WOUT) + (size_t)l * DM * DM, 0, r, ldsq, mode);
        else if ((r -= 1024) < 1024) conv_tile(p->w_mq + (size_t)l * DM * DM, DM, DM, p->norm_mem_g + l * DM, nullptr, DM, (bf16_t*)(ws + OFF_WMQ) + (size_t)l * DM * DM, 0, r, ldsq, mode, true);
        else if ((r -= 1024) < 2048) conv_tile(p->w_mkv + (size_t)l * DM * 2048, DM, 2048, p->mem_norm_g + l * DM, nullptr, DM, (bf16_t*)(ws + OFF_WMKV) + (size_t)l * 2048 * DM, 0, r, ldsq, mode);
        else if ((r -= 2048) < 1024) conv_tile(p->w_mo + (size_t)l * DM * DM, DM, DM, nullptr, nullptr, DM, (bf16_t*)(ws + OFF_WMO) + (size_t)l * DM * DM, 0, r, ldsq, mode);
        else if ((r -= 1024) < 5632) conv_tile(p->w_up + (size_t)l * DM * 2 * DFF, DM, 2 * DFF, p->norm_ffn_g + l * DM, nullptr, DM, (bf16_t*)(ws + OFF_WUP) + (size_t)l * 2 * DFF * DM, 1, r, ldsq, mode, true);
        else { r -= 5632; conv_tile(p->w_down + (size_t)l * DFF * DM, DFF, DM, nullptr, nullptr, DFF, (bf16_t*)(ws + OFF_WDN) + (size_t)l * DM * DFF, 0, r, ldsq, mode); }
    };
    constexpr int NJOB = PER_LAYER * DEPTH, TPB = 4;
    for (int t0 = blockIdx.x; t0 < NJOB; t0 += TPB * gridDim.x) {
#pragma unroll
        for (int u = 0; u < TPB; ++u) { const int t = t0 + u * gridDim.x; if (t < NJOB) job(t, lds + u * 32 * 33, 0); }
        __syncthreads();
#pragma unroll
        for (int u = 0; u < TPB; ++u) { const int t = t0 + u * gridDim.x; if (t < NJOB) job(t, lds + u * 32 * 33, 1); }
        __syncthreads();
    }
    const size_t gt = (size_t)blockIdx.x * 256 + tid(), gn = (size_t)gridDim.x * 256;
    bf16_t* wsg = (bf16_t*)(ws + OFF_WSG);
    for (size_t i = gt; i < (size_t)DEPTH * 8 * 128 * 128; i += gn) wsg[i] = f2bf(p->sg_w_s[i]);
    for (size_t i = gt; i < (size_t)DEPTH * 96 * DM; i += gn) {
        size_t l = i / (96 * DM), r = i - l * (96 * DM);
        ((bf16_t*)(ws + OFF_WIN))[(l * INCP + INC) * DM + r] = 0;
    }
    {
        {
            const int lane = tid() & 63, wv = blockIdx.x * 4 + (tid() >> 6), nw = gridDim.x * 4;
            float* rsc = (float*)(ws + OFF_RSC);
            for (int row = wv; row < TOK; row += nw) {
                const float4* xs = (const float4*)(p->x + (size_t)row * DM); uint2* xd = (uint2*)(ws + OFF_XB) + (size_t)row * (DM / 4);
                float sacc = 0.f;
#pragma unroll
                for (int i = 0; i < 4; ++i) { float4 v = xs[lane + 64 * i]; sacc += v.x * v.x + v.y * v.y + v.z * v.z + v.w * v.w; uint2 o; o.x = pack2h(v.x, v.y); o.y = pack2h(v.z, v.w); xd[lane + 64 * i] = o; }
#pragma unroll
                for (int o = 1; o < 64; o <<= 1) sacc += __shfl_xor(sacc, o);
                if (lane < 16) rsc[(size_t)row * 16 + lane] = lane == 0 ? sacc : 0.f;
            }
        }
        const float4* ms = (const float4*)p->mem; uint2* md = (uint2*)(ws + OFF_MEMB);
        for (size_t i = gt; i < (size_t)NBATCH * NMEM * DM / 4; i += gn) { float4 v = ms[i]; uint2 o; o.x = pack2(v.x, v.y); o.y = pack2(v.z, v.w); md[i] = o; }
    }
    float* cs = (float*)(ws + OFF_COS); float* sn = (float*)(ws + OFF_SIN);
    for (size_t i = gt; i < (size_t)TOK * 16; i += gn) {
        int tok = (int)(i >> 4), f = (int)(i & 15);
        const float inv = ex2(-(float)f * 0.83048202372184058f);
        const float ang = (float)p->pos[tok] * inv;
        const float c_hi = 0.15915494309189535f, c_lo = 6.4206383e-9f;
        const float rh = ang * c_hi;
        const float re = fmaf(ang, c_hi, -rh) + ang * c_lo;
        float rf = (rh - floorf(rh)) + re;
        cs[i] = __builtin_amdgcn_cosf(rf);
        sn[i] = __builtin_amdgcn_sinf(rf);
    }
}

struct EpiMemKV {
    bf16_t* km; bf16_t* vm; const float* rs; int row0, col0;
    DI void operator()(int rb, int cb, const f32x16& a) const {
        const int lane = tid() & 63, c = lane & 31, h = lane >> 5;
        const int n0 = col0 + cb;
        if (n0 < 1024) {
            const int head = n0 >> 8, d = (n0 & 255) + c;
#pragma unroll
            for (int r = 0; r < 16; ++r) {
                int row = rb + crow(r, h), gr = row0 + row, b = gr >> 8, key = gr & 255;
                km[(((size_t)(b * 4 + head)) * 256 + key) * 256 + d] = f2bf(a[r] * rs[row]);
            }
        } else {
            const int head = (n0 - 1024) >> 8, d = ((n0 - 1024) & 255) + c;
#pragma unroll
            for (int g = 0; g < 4; ++g) {
                int row = rb + 8 * g + 4 * h, gr = row0 + row, b = gr >> 8, key = gr & 255;
                uint2 pk;
                pk.x = pack2(a[4 * g] * rs[row], a[4 * g + 1] * rs[row + 1]);
                pk.y = pack2(a[4 * g + 2] * rs[row + 2], a[4 * g + 3] * rs[row + 3]);
                *(uint2*)(vm + (((size_t)(b * 4 + head)) * 256 + d) * 256 + key) = pk;
            }
        }
    }
};

struct EpiIn {
    bf16_t *hq, *hkv, *u, *v, *kb; const float *cs, *sn, *rs; int row0, col0;
    DI void operator()(int rb, int cb, const f32x16& a) const {
        const int lane = tid() & 63, c = lane & 31, h = lane >> 5;
        const int nb = col0 + cb;
        if (nb >= INC) return;
        if (nb == 384) {
#pragma unroll
            for (int r = 0; r < 16; ++r) {
                const int row = rb + crow(r, h), tok = row0 + row;
                const float val = a[r] * rs[row];
                float pt = __shfl_xor(val, 16);
                float co = cs[tok * 16 + (c & 15)], si = sn[tok * 16 + (c & 15)];
                float o = (c < 16) ? val * co - pt * si : val * co + pt * si;
                bf16_t ob = f2bf(o);
                const int b = tok >> 13, s = tok & 8191;
                bf16_t* dst = kb + (((size_t)(b * 8)) * SEQ + s) * 96 + 64 + c;
                for (int hd = 0; hd < 8; ++hd) dst[(size_t)hd * SEQ * 96] = ob;
            }
            return;
        }
        bf16_t* dst; int pitch, off; bool act;
        if (nb < 256) { dst = hq; pitch = 256; off = nb; act = false; }
        else if (nb < 384) { dst = hkv; pitch = 128; off = nb - 256; act = false; }
        else if (nb < 928) { dst = u; pitch = 512; off = nb - 416; act = true; }
        else { dst = v; pitch = 512; off = nb - 928; act = true; }
        dst += (size_t)(row0 + rb + 4 * h) * pitch + off + c;
#pragma unroll
        for (int r = 0; r < 16; ++r) {
            const int rr = (r & 3) + 8 * (r >> 2);
            float val = a[r] * rs[rb + rr + 4 * h];
            if (act) val = gelu_tanh(val);
            dst[(size_t)rr * pitch] = f2bf(val);
        }
    }
};

struct EpiQ {
    bf16_t* q; const float *cs, *sn, *rs; int row0, col0;
    DI void operator()(int rb, int cb, const f32x16& a) const {
        const int lane = tid() & 63, c = lane & 31, h = lane >> 5;
        const int n0 = col0 + cb, head = n0 / 96, w0 = n0 - head * 96;
        const float qs = 0.10206207261596575f * LOG2E;
#pragma unroll
        for (int r = 0; r < 16; ++r) {
            const int row = rb + crow(r, h), tok = row0 + row;
            float val = a[r] * rs[row] * qs;
            if (w0 == 64) {
                float pt = __shfl_xor(val, 16);
                float co = cs[tok * 16 + (c & 15)], si = sn[tok * 16 + (c & 15)];
                val = (c < 16) ? val * co - pt * si : val * co + pt * si;
            }
            const int b = tok >> 13, s = tok & 8191;
            q[(((size_t)(b * 8 + head)) * SEQ + s) * 96 + w0 + c] = f2bf(val);
        }
    }
};

struct EpiKV {
    bf16_t *kb, *vstage; const float* rs; int row0, col0;
    DI void operator()(int rb, int cb, const f32x16& a) const {
        const int lane = tid() & 63, c = lane & 31, h = lane >> 5;
        const int n0 = col0 + cb, head = n0 >> 7, w0 = n0 & 127;
        if (w0 < 64) {
#pragma unroll
            for (int r = 0; r < 16; ++r) {
                const int row = rb + crow(r, h), tok = row0 + row, b = tok >> 13, s = tok & 8191;
                kb[(((size_t)(b * 8 + head)) * SEQ + s) * 96 + w0 + c] = f2bf(a[r] * rs[row]);
            }
        } else {
            const int d = w0 - 64 + c;
#pragma unroll
            for (int g = 0; g < 4; ++g) {
                const int row = rb + 8 * g + 4 * h;
                uint2 pk;
                pk.x = pack2(a[4 * g] * rs[row], a[4 * g + 1] * rs[row + 1]);
                pk.y = pack2(a[4 * g + 2] * rs[row + 2], a[4 * g + 3] * rs[row + 3]);
                *(uint2*)(vstage + d * 136 + row) = pk;
            }
        }
    }
};

struct EpiRes {
    bf16_t* xb; int row0, col0; bool dry;
    DI void operator()(int rb, int cb, const f32x16& a, f32x16& sq) const {
        const int lane = tid() & 63, c = lane & 31, h = lane >> 5;
        if (dry && a[0] != 1.2345e30f) return;
        bf16_t* ptr = xb + (size_t)(row0 + rb + 4 * h) * DM + col0 + cb + c;
#pragma unroll
        for (int r = 0; r < 16; ++r) {
            const int rr = (r & 3) + 8 * (r >> 2);
            const bf16_t nb = f2h(h2f(ptr[(size_t)rr * DM]) + a[r]);
            ptr[(size_t)rr * DM] = nb;
            const float nv = h2f(nb);
            sq[r] += nv * nv;
        }
    }
};

struct EpiQm {
    bf16_t* qm; const float* rs; int row0, col0;
    DI void operator()(int rb, int cb, const f32x16& a) const {
        const int lane = tid() & 63, c = lane & 31, h = lane >> 5;
#pragma unroll
        for (int r = 0; r < 16; ++r) {
            const int row = rb + crow(r, h);
            qm[(size_t)(row0 + row) * DM + col0 + cb + c] = f2bf(a[r] * rs[row] * (0.0625f * LOG2E));
        }
    }
};

template <int DQK, int DV, int NBUF, bool QREG, int QW, int LDQ, int LDK, int LDV, int LDO>
DI void flash_item(const bf16_t* __restrict__ Qp, const bf16_t* __restrict__ Kp, const bf16_t* __restrict__ Vtp, int nkt,
                   bf16_t* __restrict__ Op, char* smem, float& ssq) {
    constexpr int KP = DQK + 8;
    constexpr int VP = 72;
    constexpr int CPR = DQK / 8;
    constexpr int KCH = 64 * CPR / 256;
    constexpr int VCH = DV * 8 / 256;
    constexpr int NKS = DQK / 16, NMT = DV / 32 / QW;
    constexpr bool KROWS = (256 % CPR) == 0;
    static_assert(KROWS || LDK == DQK, "K tile addressing");
    static_assert(KCH <= 8 && VCH <= 8, "staging regs");
    static_assert(NBUF == 2 ? (KCH <= 4 && VCH <= 2) : (KCH == 8 && VCH == 8), "staging");
    bf16_t* Ks = (bf16_t*)smem;
    bf16_t* Vs = Ks + NBUF * 64 * KP;
    const int t = tid(), lane = t & 63, w = __builtin_amdgcn_readfirstlane(t >> 6), l32 = lane & 31, h = lane >> 5;
    const int q = (w / QW) * 32 + l32, dv0 = (w % QW) * (DV / QW);
    const unsigned ktoff = KROWS ? (unsigned)((t / CPR) * LDK + (t % CPR) * 8) : (unsigned)(t * 8);
    const unsigned vtoff = (unsigned)((t >> 3) * LDV + (t & 7) * 8);

    bf16x8 qf[QREG ? NKS : 1];
    if constexpr (QREG) {
#pragma unroll
        for (int ks = 0; ks < NKS; ++ks) qf[ks] = *(const bf16x8*)(Qp + (size_t)q * LDQ + ks * 16 + 8 * h);
    }
    f32x16 o[NMT];
#pragma unroll
    for (int mt = 0; mt < NMT; ++mt)
#pragma unroll
        for (int r = 0; r < 16; ++r) o[mt][r] = 0.f;
    float m = -INFINITY, lsum = 0.f;

    uint4 rk0, rk1, rk2, rk3, rk4, rk5, rk6, rk7, rv0, rv1;
    (void)rk0; (void)rk1; (void)rk2; (void)rk3; (void)rk4; (void)rk5; (void)rk6; (void)rk7; (void)rv0; (void)rv1;
#define LKJ(kt, i, R) { const bf16_t* kb_ = KROWS ? Kp + (size_t)((kt) * 64 + (i) * (256 / CPR)) * LDK : Kp + (size_t)(kt) * 64 * DQK + (i) * 2048; R = *(const uint4*)(kb_ + ktoff); }
#define SKJ(buf, i, R) { int c = t + 256 * (i), row = c / CPR, cc = c - row * CPR; *(uint4*)(Ks + (buf) * 64 * KP + swap23(row) * KP + cc * 8) = R; }
#define LVJ(kt, i, R) { const bf16_t* vb_ = Vtp + (size_t)(i) * 32 * LDV + (kt) * 64; R = *(const uint4*)(vb_ + vtoff); }
#define SVJ(buf, i, R) { int c = t + 256 * (i), d = c >> 3, cc = c & 7; *(uint4*)(Vs + (buf) * DV * VP + d * VP + cc * 8) = R; }
#define ATT_LOAD(kt) { LKJ(kt, 0, rk0) if constexpr (KCH > 1) LKJ(kt, 1, rk1) if constexpr (KCH > 2) LKJ(kt, 2, rk2) if constexpr (KCH > 3) LKJ(kt, 3, rk3) LVJ(kt, 0, rv0) if constexpr (VCH > 1) LVJ(kt, 1, rv1) }
#define ATT_STORE(buf) { SKJ(buf, 0, rk0) if constexpr (KCH > 1) SKJ(buf, 1, rk1) if constexpr (KCH > 2) SKJ(buf, 2, rk2) if constexpr (KCH > 3) SKJ(buf, 3, rk3) SVJ(buf, 0, rv0) if constexpr (VCH > 1) SVJ(buf, 1, rv1) }

    __syncthreads();
    if constexpr (NBUF == 2) ATT_LOAD(0);
    for (int kt = 0; kt < nkt; ++kt) {
        const int buf = (NBUF == 2) ? (kt & 1) : 0;
        if constexpr (NBUF == 1) {
            __syncthreads();
            LKJ(kt, 0, rk0) LKJ(kt, 1, rk1) LKJ(kt, 2, rk2) LKJ(kt, 3, rk3)
            LKJ(kt, 4, rk4) LKJ(kt, 5, rk5) LKJ(kt, 6, rk6) LKJ(kt, 7, rk7)
            SKJ(0, 0, rk0) SKJ(0, 1, rk1) SKJ(0, 2, rk2) SKJ(0, 3, rk3)
            asm volatile("" ::: "memory");
            LVJ(kt, 0, rk0) LVJ(kt, 1, rk1) LVJ(kt, 2, rk2) LVJ(kt, 3, rk3)
            SKJ(0, 4, rk4) SKJ(0, 5, rk5) SKJ(0, 6, rk6) SKJ(0, 7, rk7)
            asm volatile("" ::: "memory");
            LVJ(kt, 4, rk4) LVJ(kt, 5, rk5) LVJ(kt, 6, rk6) LVJ(kt, 7, rk7)
            SVJ(0, 0, rk0) SVJ(0, 1, rk1) SVJ(0, 2, rk2) SVJ(0, 3, rk3)
            asm volatile("" ::: "memory");
            SVJ(0, 4, rk4) SVJ(0, 5, rk5) SVJ(0, 6, rk6) SVJ(0, 7, rk7)
        } else { ATT_STORE(buf); }
        __syncthreads();
        if constexpr (NBUF == 2) { if (kt + 1 < nkt) ATT_LOAD(kt + 1); }

        const bf16_t* kb = Ks + buf * 64 * KP + l32 * KP + 8 * h;
        f32x16 s0, s1;
#pragma unroll
        for (int r = 0; r < 16; ++r) { s0[r] = 0.f; s1[r] = 0.f; }
#pragma unroll
        for (int ks = 0; ks < NKS; ++ks) {
            bf16x8 qq;
            if constexpr (QREG) qq = qf[ks]; else qq = *(const bf16x8*)(Qp + (size_t)q * LDQ + ks * 16 + 8 * h);
            bf16x8 k0 = *(const bf16x8*)(kb + ks * 16);
            bf16x8 k1 = *(const bf16x8*)(kb + 32 * KP + ks * 16);
            s0 = MFMA(k0, qq, s0);
            s1 = MFMA(k1, qq, s1);
        }
        float mx = s0[0];
#pragma unroll
        for (int r = 1; r < 16; ++r) mx = fmaxf(mx, s0[r]);
#pragma unroll
        for (int r = 0; r < 16; ++r) mx = fmaxf(mx, s1[r]);
        mx = fmaxf(mx, __shfl_xor(mx, 32));
        const float mn = fmaxf(m, mx);
        const float alpha = ex2(m - mn);
        m = mn;
        float psum = 0.f;
#pragma unroll
        for (int r = 0; r < 16; ++r) { s0[r] = ex2(s0[r] - mn); psum += s0[r]; }
#pragma unroll
        for (int r = 0; r < 16; ++r) { s1[r] = ex2(s1[r] - mn); psum += s1[r]; }
        lsum = lsum * alpha + psum;
        if (__builtin_amdgcn_ballot_w64(alpha != 1.f) != 0ull) {
#pragma unroll
            for (int mt = 0; mt < NMT; ++mt)
#pragma unroll
                for (int r = 0; r < 16; ++r) o[mt][r] *= alpha;
        }
        const bf16_t* vb = Vs + buf * DV * VP + (dv0 + l32) * VP + 8 * h;
#pragma unroll
        for (int t2 = 0; t2 < 2; ++t2)
#pragma unroll
            for (int s2 = 0; s2 < 2; ++s2) {
                u32x4 pu;
#pragma unroll
                for (int j = 0; j < 4; ++j)
                    pu[j] = t2 ? pack2(s1[8 * s2 + 2 * j], s1[8 * s2 + 2 * j + 1]) : pack2(s0[8 * s2 + 2 * j], s0[8 * s2 + 2 * j + 1]);
                const bf16x8 pfv = __builtin_bit_cast(bf16x8, pu);
#pragma unroll
                for (int mt = 0; mt < NMT; ++mt) {
                    bf16x8 vv = *(const bf16x8*)(vb + mt * 32 * VP + t2 * 32 + s2 * 16);
                    o[mt] = MFMA(vv, pfv, o[mt]);
                }
            }
    }
#undef ATT_LOAD
#undef ATT_STORE
#undef LKJ
#undef SKJ
#undef LVJ
#undef SVJ
    const float inv = 1.f / (lsum + __shfl_xor(lsum, 32));
#pragma unroll
    for (int mt = 0; mt < NMT; ++mt)
#pragma unroll
        for (int g = 0; g < 4; ++g) {
            float v0 = o[mt][4 * g] * inv, v1 = o[mt][4 * g + 1] * inv, v2 = o[mt][4 * g + 2] * inv, v3 = o[mt][4 * g + 3] * inv;
            uint2 pk; pk.x = pack2(v0, v1); pk.y = pack2(v2, v3);
            float r0 = bflo(pk.x), r1 = bfhi(pk.x), r2 = bflo(pk.y), r3 = bfhi(pk.y);
            ssq += r0 * r0 + r1 * r1 + r2 * r2 + r3 * r3;
            *(uint2*)(Op + (size_t)q * LDO + dv0 + mt * 32 + 8 * g + 4 * h) = pk;
        }
}

DI void flash_mla2(const bf16_t* __restrict__ Qp, const bf16_t* __restrict__ Kp, const bf16_t* __restrict__ Vtp,
                   bf16_t* __restrict__ Op, char* smem, float& ssq) {
    constexpr int DQK = 96, DV = 64, LDQ = 96, LDV = SEQ, LDO = DM, NKT = SEQ / 64;
    constexpr int KP = DQK + 8, VP = 72, CPR = DQK / 8, NKS = DQK / 16, NMT = DV / 32;
    bf16_t* Ks = (bf16_t*)smem;
    bf16_t* Vs = Ks + 2 * 64 * KP;
    const int t = tid(), lane = t & 63, w = __builtin_amdgcn_readfirstlane(t >> 6), l32 = lane & 31, h = lane >> 5;
    const int q = w * 32 + l32;
    const unsigned ktoff = (unsigned)(t * 8);
    const unsigned vtoff = (unsigned)((t >> 3) * LDV + (t & 7) * 8);
    bf16x8 qf[NKS];
#pragma unroll
    for (int ks = 0; ks < NKS; ++ks) qf[ks] = *(const bf16x8*)(Qp + (size_t)q * LDQ + ks * 16 + 8 * h);
    f32x16 o[NMT];
#pragma unroll
    for (int mt = 0; mt < NMT; ++mt)
#pragma unroll
        for (int r = 0; r < 16; ++r) o[mt][r] = 0.f;
    float m = 0.f, lsum = 0.f;
    uint4 ak0, ak1, ak2, av0, av1, bk0, bk1, bk2, bv0, bv1;
#define M2_LOAD(S, kt) { const bf16_t* kb_ = Kp + (size_t)(kt) * 64 * DQK; S##k0 = *(const uint4*)(kb_ + ktoff); S##k1 = *(const uint4*)(kb_ + 2048 + ktoff); S##k2 = *(const uint4*)(kb_ + 4096 + ktoff); \
        const bf16_t* vb_ = Vtp + (kt) * 64; S##v0 = *(const uint4*)(vb_ + vtoff); S##v1 = *(const uint4*)(vb_ + (size_t)32 * LDV + vtoff); }
#define M2_SK(i, R, buf) { int c = t + 256 * (i), row = c / CPR, cc = c - row * CPR; *(uint4*)(Ks + (buf) * 64 * KP + swap23(row) * KP + cc * 8) = R; }
#define M2_SV(i, R, buf) { int c = t + 256 * (i), d = c >> 3, cc = c & 7; *(uint4*)(Vs + (buf) * DV * VP + d * VP + cc * 8) = R; }
#define M2_STORE(S, buf) { M2_SK(0, S##k0, buf) M2_SK(1, S##k1, buf) M2_SK(2, S##k2, buf) M2_SV(0, S##v0, buf) M2_SV(1, S##v1, buf) }
#define M2_COMPUTE(buf) { \
        if (__builtin_amdgcn_ballot_w64(alpha != 1.f) != 0ull) { \
            _Pragma("unroll") for (int mt = 0; mt < NMT; ++mt) _Pragma("unroll") for (int r = 0; r < 16; ++r) o[mt][r] *= alpha; } \
        lsum *= alpha; \
        const bf16_t* kb = Ks + (buf) * 64 * KP + l32 * KP + 8 * h; \
        f32x16 s0, s1; \
        const float nm = -m; \
        _Pragma("unroll") for (int r = 0; r < 16; ++r) { s0[r] = nm; s1[r] = nm; } \
        _Pragma("unroll") for (int ks = 0; ks < NKS; ++ks) { bf16x8 k0 = *(const bf16x8*)(kb + ks * 16); bf16x8 k1 = *(const bf16x8*)(kb + 32 * KP + ks * 16); s0 = MFMA(k0, qf[ks], s0); s1 = MFMA(k1, qf[ks], s1); } \
        float mx = s0[0]; \
        _Pragma("unroll") for (int r = 1; r < 16; ++r) mx = fmaxf(mx, s0[r]); \
        _Pragma("unroll") for (int r = 0; r < 16; ++r) mx = fmaxf(mx, s1[r]); \
        mx = fmaxf(mx, __shfl_xor(mx, 32)); \
        float psum = 0.f; \
        _Pragma("unroll") for (int r = 0; r < 16; ++r) { s0[r] = ex2(s0[r]); psum += s0[r]; } \
        _Pragma("unroll") for (int r = 0; r < 16; ++r) { s1[r] = ex2(s1[r]); psum += s1[r]; } \
        lsum += psum; \
        const float dgrow = fmaxf(mx, 0.f); alpha = ex2(-dgrow); m += dgrow; \
        const bf16_t* vb = Vs + (buf) * DV * VP + l32 * VP + 8 * h; \
        _Pragma("unroll") for (int s2 = 0; s2 < 2; ++s2) { \
            u32x4 pu0, pu1; \
            _Pragma("unroll") for (int j = 0; j < 4; ++j) { pu0[j] = pack2(s0[8 * s2 + 2 * j], s0[8 * s2 + 2 * j + 1]); pu1[j] = pack2(s1[8 * s2 + 2 * j], s1[8 * s2 + 2 * j + 1]); } \
            const bf16x8 pf0 = __builtin_bit_cast(bf16x8, pu0), pf1 = __builtin_bit_cast(bf16x8, pu1); \
            _Pragma("unroll") for (int mt = 0; mt < NMT; ++mt) { \
                bf16x8 v0 = *(const bf16x8*)(vb + mt * 32 * VP + s2 * 16); bf16x8 v1 = *(const bf16x8*)(vb + mt * 32 * VP + 32 + s2 * 16); \
                o[mt] = MFMA(v0, pf0, o[mt]); o[mt] = MFMA(v1, pf1, o[mt]); } } }

    float alpha = 1.f;
    __syncthreads();
    M2_LOAD(a, 0);
    M2_LOAD(b, 1);
    {
        M2_STORE(a, 0);
        __syncthreads();
        const bf16_t* kb = Ks + l32 * KP + 8 * h;
        f32x16 s0, s1;
#pragma unroll
        for (int r = 0; r < 16; ++r) { s0[r] = 0.f; s1[r] = 0.f; }
#pragma unroll
        for (int ks = 0; ks < NKS; ++ks) { bf16x8 k0 = *(const bf16x8*)(kb + ks * 16); bf16x8 k1 = *(const bf16x8*)(kb + 32 * KP + ks * 16); s0 = MFMA(k0, qf[ks], s0); s1 = MFMA(k1, qf[ks], s1); }
        float mx = s0[0];
#pragma unroll
        for (int r = 1; r < 16; ++r) mx = fmaxf(mx, s0[r]);
#pragma unroll
        for (int r = 0; r < 16; ++r) mx = fmaxf(mx, s1[r]);
        m = fmaxf(mx, __shfl_xor(mx, 32));
        __syncthreads();
    }
    for (int kt = 0; kt < NKT; kt += 2) {
        M2_STORE(a, 0);
        __syncthreads();
        M2_LOAD(a, min(kt + 2, NKT - 1));
        M2_COMPUTE(0);
        M2_STORE(b, 1);
        __syncthreads();
        M2_LOAD(b, min(kt + 3, NKT - 1));
        M2_COMPUTE(1);
    }
#undef M2_LOAD
#undef M2_SK
#undef M2_SV
#undef M2_STORE
#undef M2_COMPUTE
    const float inv = 1.f / (lsum + __shfl_xor(lsum, 32));
#pragma unroll
    for (int mt = 0; mt < NMT; ++mt)
#pragma unroll
        for (int g = 0; g < 4; ++g) {
            float v0 = o[mt][4 * g] * inv, v1 = o[mt][4 * g + 1] * inv, v2 = o[mt][4 * g + 2] * inv, v3 = o[mt][4 * g + 3] * inv;
            uint2 pk; pk.x = pack2(v0, v1); pk.y = pack2(v2, v3);
            float r0 = bflo(pk.x), r1 = bfhi(pk.x), r2 = bflo(pk.y), r3 = bfhi(pk.y);
            ssq += r0 * r0 + r1 * r1 + r2 * r2 + r3 * r3;
            *(uint2*)(Op + (size_t)q * LDO + mt * 32 + 8 * g + 4 * h) = pk;
        }
}

DI void mla_item(KP p, int item, char* smem) {
    const int b = item >> 6, qb = item & 63;
    const bf16_t* Q = (const bf16_t*)(p->ws + OFF_Q);
    const bf16_t* K = (const bf16_t*)(p->ws + OFF_K);
    const bf16_t* Vt = (const bf16_t*)(p->ws + OFF_VT);
    bf16_t* om = (bf16_t*)(p->ws + OFF_OMIX) + ((size_t)b * SEQ + qb * 128) * DM;
    float ssq = 0.f;
    for (int hd = 0; hd < 8; ++hd) {
        const size_t bh = (size_t)(b * 8 + hd);
        flash_mla2(Q + (bh * SEQ + qb * 128) * 96, K + bh * SEQ * 96, Vt + bh * 64 * SEQ, om + hd * 64, smem, ssq);
    }
    ssq += __shfl_xor(ssq, 32);
    const float sc = rsqrtf(ssq * (1.f / 512.f) + EPS);
    const int lane = tid() & 63, w = tid() >> 6, q = w * 32 + (lane & 31), h = lane >> 5;
    for (int i = 0; i < 64; ++i) {
        uint2* ptr = (uint2*)(om + (size_t)q * DM + (i >> 3) * 64 + ((i >> 2) & 1) * 32 + (i & 3) * 8 + 4 * h);
        uint2 v = *ptr;
        v.x = pack2(bflo(v.x) * sc, bfhi(v.x) * sc);
        v.y = pack2(bflo(v.y) * sc, bfhi(v.y) * sc);
        *ptr = v;
    }
}

DI void memattn_item(KP p, int l, int item, char* smem) {
    const int head = item & 3, qt = (item >> 2) & 127, b = item >> 9;
    const bf16_t* qm = (const bf16_t*)(p->ws + OFF_QM) + ((size_t)b * SEQ + qt * 64) * DM + head * 256;
    const bf16_t* km = (const bf16_t*)(p->ws + OFF_KMEM) + ((size_t)((l * NBATCH + b) * 4 + head)) * 256 * 256;
    const bf16_t* vm = (const bf16_t*)(p->ws + OFF_VMEM) + ((size_t)((l * NBATCH + b) * 4 + head)) * 256 * 256;
    bf16_t* om = (bf16_t*)(p->ws + OFF_OMEM) + ((size_t)b * SEQ + qt * 64) * DM + head * 256;
    float dummy = 0.f;
    flash_item<256, 256, 1, true, 2, DM, 256, 256, DM>(qm, km, vm, 4, om, smem, dummy);
}

DI void gmlp_item(KP p, int l, int ci, char* smem) {
    constexpr int AP = 136;
    bf16_t* As = (bf16_t*)smem;
    bf16_t* Bs = As + 128 * AP;
    float* st = (float*)(Bs + 64 * AP);
    const int t = tid(), lane = t & 63, w = __builtin_amdgcn_readfirstlane(t >> 6), l32 = lane & 31, h = lane >> 5;
    const int tok0 = ci * 128;
    const bf16_t* vbuf = (const bf16_t*)(p->ws + OFF_V) + (size_t)tok0 * 512;
    const bf16_t* ubuf = (const bf16_t*)(p->ws + OFF_U) + (size_t)(tok0 + w * 32) * 512;
    bf16_t* om = (bf16_t*)(p->ws + OFF_OMIX) + (size_t)(tok0 + w * 32) * DM + 512;
    const bf16_t* wsg = (const bf16_t*)(p->ws + OFF_WSG) + (size_t)l * 8 * 128 * 128;
    const float* lng = p->sg_ln_g + l * 512; const float* lnb = p->sg_ln_b + l * 512;
    const float* bs = p->sg_b_s + l * 8 * 128 + w * 32;
    __syncthreads();
    {
        const int row = t >> 1, half = t & 1;
        const uint4* src = (const uint4*)(vbuf + (size_t)row * 512 + half * 256);
        float s = 0.f, s2 = 0.f;
#pragma unroll 4
        for (int i = 0; i < 32; ++i) {
            uint4 qv = src[i];
            float a0 = bflo(qv.x), a1 = bfhi(qv.x), a2 = bflo(qv.y), a3 = bfhi(qv.y), a4 = bflo(qv.z), a5 = bfhi(qv.z), a6 = bflo(qv.w), a7 = bfhi(qv.w);
            s += a0 + a1 + a2 + a3 + a4 + a5 + a6 + a7;
            s2 += a0 * a0 + a1 * a1 + a2 * a2 + a3 * a3 + a4 * a4 + a5 * a5 + a6 * a6 + a7 * a7;
        }
        s += __shfl_xor(s, 1); s2 += __shfl_xor(s2, 1);
        const float mean = s * (1.f / 512.f);
        const float var = fmaxf(s2 * (1.f / 512.f) - mean * mean, 0.f);
        if (half == 0) { st[2 * row] = mean; st[2 * row + 1] = rsqrtf(var + EPS); }
    }
    __syncthreads();
    float rq0 = 0.f, rq1 = 0.f, rq2 = 0.f, rq3 = 0.f;
    const bf16_t* ub0 = (const bf16_t*)(p->ws + OFF_U) + (size_t)tok0 * 512;
    bf16_t* om0 = (bf16_t*)(p->ws + OFF_OMIX) + (size_t)tok0 * DM + 512;
    const unsigned wtoff = (unsigned)((t >> 4) * 128 + (t & 15) * 8);
    const unsigned vtoff = (unsigned)((t >> 3) * 512 + (t & 7) * 8);
    const unsigned eoff_u = (unsigned)(4 * h * 512 + l32), eoff_o = (unsigned)(4 * h * DM + l32);
    for (int hd = 0; hd < 8; ++hd) {
        const bf16_t* wh = wsg + (size_t)hd * 128 * 128;
#pragma unroll
        for (int i = 0; i < 8; ++i)
            *(uint4*)(As + ((t >> 4) + 16 * i) * AP + (t & 15) * 8) = *(const uint4*)(wh + i * 16 * 128 + wtoff);
#pragma unroll
        for (int i = 0; i < 4; ++i) {
            const int j = (t >> 3) + 32 * i, c8 = t & 7;
            uint4 qv = *(const uint4*)(vbuf + (size_t)i * 32 * 512 + hd * 64 + vtoff);
            const float mean = st[2 * j], rstd = st[2 * j + 1];
            const int ch = hd * 64 + c8 * 8;
            const float4 g0 = *(const float4*)(lng + ch), g1 = *(const float4*)(lng + ch + 4);
            const float4 b0 = *(const float4*)(lnb + ch), b1 = *(const float4*)(lnb + ch + 4);
            bf16_t* bd = Bs + (c8 * 8) * AP + j;
            bd[0 * AP] = f2bf((bflo(qv.x) - mean) * rstd * g0.x + b0.x);
            bd[1 * AP] = f2bf((bfhi(qv.x) - mean) * rstd * g0.y + b0.y);
            bd[2 * AP] = f2bf((bflo(qv.y) - mean) * rstd * g0.z + b0.z);
            bd[3 * AP] = f2bf((bfhi(qv.y) - mean) * rstd * g0.w + b0.w);
            bd[4 * AP] = f2bf((bflo(qv.z) - mean) * rstd * g1.x + b1.x);
            bd[5 * AP] = f2bf((bfhi(qv.z) - mean) * rstd * g1.y + b1.y);
            bd[6 * AP] = f2bf((bflo(qv.w) - mean) * rstd * g1.z + b1.z);
            bd[7 * AP] = f2bf((bfhi(qv.w) - mean) * rstd * g1.w + b1.w);
        }
        __syncthreads();
        f32x16 acc[2];
#pragma unroll
        for (int r = 0; r < 16; ++r) { acc[0][r] = 0.f; acc[1][r] = 0.f; }
        const bf16_t* a_s = As + (w * 32 + l32) * AP + 8 * h;
        const bf16_t* b_s = Bs + l32 * AP + 8 * h;
#pragma unroll
        for (int ks = 0; ks < 8; ++ks) {
            bf16x8 a = *(const bf16x8*)(a_s + ks * 16);
            bf16x8 b0 = *(const bf16x8*)(b_s + ks * 16);
            bf16x8 b1 = *(const bf16x8*)(b_s + 32 * AP + ks * 16);
            acc[0] = MFMA(a, b0, acc[0]);
            acc[1] = MFMA(a, b1, acc[1]);
        }
        __syncthreads();
        float* stgf = (float*)As;
#pragma unroll
        for (int j2 = 0; j2 < 2; ++j2)
#pragma unroll
            for (int r = 0; r < 16; ++r) {
                const int rr = (r & 3) + 8 * (r >> 2);
                stgf[(w * 32 + rr + 4 * h) * 68 + j2 * 32 + l32] = acc[j2][r] + (bs + hd * 128 + rr)[4 * h];
            }
        __syncthreads();
#pragma unroll
        for (int i = 0; i < 4; ++i) {
            const int row = (t >> 3) + 32 * i, c8 = t & 7;
            const float4 lo = *(const float4*)(stgf + row * 68 + c8 * 8), hi = *(const float4*)(stgf + row * 68 + c8 * 8 + 4);
            const uint4 uv = *(const uint4*)(ub0 + (size_t)row * 512 + hd * 64 + c8 * 8);
            uint4 ov;
            ov.x = pack2(bflo(uv.x) * lo.x, bfhi(uv.x) * lo.y); ov.y = pack2(bflo(uv.y) * lo.z, bfhi(uv.y) * lo.w);
            ov.z = pack2(bflo(uv.z) * hi.x, bfhi(uv.z) * hi.y); ov.w = pack2(bflo(uv.w) * hi.z, bfhi(uv.w) * hi.w);
            *(uint4*)(om0 + (size_t)row * DM + hd * 64 + c8 * 8) = ov;
            const float q0 = bflo(ov.x), q1 = bfhi(ov.x), q2 = bflo(ov.y), q3 = bfhi(ov.y), q4 = bflo(ov.z), q5 = bfhi(ov.z), q6 = bflo(ov.w), q7 = bfhi(ov.w);
            const float sqp = q0 * q0 + q1 * q1 + q2 * q2 + q3 * q3 + q4 * q4 + q5 * q5 + q6 * q6 + q7 * q7;
            if (i == 0) rq0 += sqp; else if (i == 1) rq1 += sqp; else if (i == 2) rq2 += sqp; else rq3 += sqp;
        }
        __syncthreads();
    }
#define GM_FIN(RQ, i) { float s_ = RQ; s_ += __shfl_xor(s_, 1); s_ += __shfl_xor(s_, 2); s_ += __shfl_xor(s_, 4); const float sc_ = rsqrtf(s_ * (1.f / 512.f) + EPS); \
        const int row = (t >> 3) + 32 * (i), c8 = t & 7; \
        for (int hd = 0; hd < 8; ++hd) { uint4* ptr = (uint4*)(om0 + (size_t)row * DM + hd * 64 + c8 * 8); uint4 v = *ptr; \
            v.x = pack2(bflo(v.x) * sc_, bfhi(v.x) * sc_); v.y = pack2(bflo(v.y) * sc_, bfhi(v.y) * sc_); v.z = pack2(bflo(v.z) * sc_, bfhi(v.z) * sc_); v.w = pack2(bflo(v.w) * sc_, bfhi(v.w) * sc_); *ptr = v; } }
    GM_FIN(rq0, 0) GM_FIN(rq1, 1) GM_FIN(rq2, 2) GM_FIN(rq3, 3)
#undef GM_FIN
}

DI void ph_memkv(KP p, char* smem) {
    for_tiles(DEPTH * 16 * 16, [&](int t) __attribute__((always_inline)) {
        const int l = t >> 8, rt = (t >> 4) & 15, ct = t & 15;
        f32x16 acc[2][2];
        gemm_tile<1>((const bf16_t*)(p->ws + OFF_MEMB), DM, rt * 128, 0, NBATCH * NMEM, (const bf16_t*)(p->ws + OFF_WMKV) + ((size_t)l * 2048 + ct * 128) * DM, DM, DM, smem, acc);
        EpiMemKV e{(bf16_t*)(p->ws + OFF_KMEM) + (size_t)l * NBATCH * 4 * 256 * 256, (bf16_t*)(p->ws + OFF_VMEM) + (size_t)l * NBATCH * 4 * 256 * 256,
                   (const float*)(smem + RS_OFF), rt * 128, ct * 128};
        run_epi(acc, e);
    });
}
DI float* stage_tile(const f32x16 (&acc)[2][2], const float* rs, char* smem) {
    const int tt = tid(), lane = tt & 63, w = __builtin_amdgcn_readfirstlane(tt >> 6), wm = w >> 1, wn = w & 1, l32 = lane & 31, h = lane >> 5;
    float* stg = (float*)smem;
#pragma unroll
    for (int i = 0; i < 2; ++i)
#pragma unroll
        for (int j = 0; j < 2; ++j)
#pragma unroll
            for (int r = 0; r < 16; ++r) {
                const int row = wm * 64 + i * 32 + crow(r, h);
                stg[row * 132 + wn * 64 + j * 32 + l32] = rs ? acc[i][j][r] * rs[row] : acc[i][j][r];
            }
    __syncthreads();
    return stg;
}
DI uint4 pack8(const float4& a, const float4& b) { uint4 o; o.x = pack2(a.x, a.y); o.y = pack2(a.z, a.w); o.z = pack2(b.x, b.y); o.w = pack2(b.z, b.w); return o; }
DI float4 gelu4(const float4& a) { float4 o; o.x = gelu_tanh(a.x); o.y = gelu_tanh(a.y); o.z = gelu_tanh(a.z); o.w = gelu_tanh(a.w); return o; }
DI void rope8(float4& lo, float4& hi, const float4& plo, const float4& phi, const float* cs, const float* sn, int c) {
    const float4 c0 = *(const float4*)(cs + (c & 15)), c1 = *(const float4*)(cs + (c & 15) + 4);
    const float4 s0 = *(const float4*)(sn + (c & 15)), s1 = *(const float4*)(sn + (c & 15) + 4);
    const float sg = c < 16 ? -1.f : 1.f;
    lo.x = lo.x * c0.x + sg * plo.x * s0.x; lo.y = lo.y * c0.y + sg * plo.y * s0.y; lo.z = lo.z * c0.z + sg * plo.z * s0.z; lo.w = lo.w * c0.w + sg * plo.w * s0.w;
    hi.x = hi.x * c1.x + sg * phi.x * s1.x; hi.y = hi.y * c1.y + sg * phi.y * s1.y; hi.z = hi.z * c1.z + sg * phi.z * s1.z; hi.w = hi.w * c1.w + sg * phi.w * s1.w;
}

DI void ph_in(KP p, int l, const float* xin, char* smem) {
    for_tiles(512 * 12, [&](int t) __attribute__((always_inline)) {
        int rt, ct; tile_rc(t, 12, rt, ct);
        f32x16 acc[2][2];
        const float rsp = rs_load(p, rt * 128);
        gemm_tile<0, true>((const bf16_t*)(p->ws + OFF_XB), DM, rt * 128, 0, TOK, (const bf16_t*)(p->ws + OFF_WIN) + ((size_t)l * INCP + ct * 128) * DM, DM, DM, smem, acc);
        rs_finish(rsp, rt * 128, smem);
        const float* stg = stage_tile(acc, (const float*)(smem + RS_OFF), smem);
        const int tt = tid(), c8 = tt & 15, nb = ct * 128 + c8 * 8;
        if (nb < INC) {
#pragma unroll
            for (int i = 0; i < 8; ++i) {
                const int row = (tt >> 4) + 16 * i, tok = rt * 128 + row;
                float4 lo = *(const float4*)(stg + row * 132 + c8 * 8), hi = *(const float4*)(stg + row * 132 + c8 * 8 + 4);
                if (nb < 256) *(uint4*)((bf16_t*)(p->ws + OFF_HQ) + (size_t)tok * 256 + nb) = pack8(lo, hi);
                else if (nb < 384) *(uint4*)((bf16_t*)(p->ws + OFF_HKV) + (size_t)tok * 128 + (nb - 256)) = pack8(lo, hi);
                else if (nb < 416) {
                    const int c = nb - 384, pc = c8 * 8 + (c < 16 ? 16 : -16);
                    const float4 plo = *(const float4*)(stg + row * 132 + pc), phi = *(const float4*)(stg + row * 132 + pc + 4);
                    rope8(lo, hi, plo, phi, (const float*)(p->ws + OFF_COS) + (size_t)tok * 16, (const float*)(p->ws + OFF_SIN) + (size_t)tok * 16, c);
                    const uint4 ov = pack8(lo, hi);
                    const int b = tok >> 13, sx = tok & 8191;
                    bf16_t* dst = (bf16_t*)(p->ws + OFF_K) + (((size_t)(b * 8)) * SEQ + sx) * 96 + 64 + c;
#pragma unroll
                    for (int hd = 0; hd < 8; ++hd) *(uint4*)(dst + (size_t)hd * SEQ * 96) = ov;
                } else if (nb < 928) *(uint4*)((bf16_t*)(p->ws + OFF_U) + (size_t)tok * 512 + (nb - 416)) = pack8(gelu4(lo), gelu4(hi));
                else *(uint4*)((bf16_t*)(p->ws + OFF_V) + (size_t)tok * 512 + (nb - 928)) = pack8(gelu4(lo), gelu4(hi));
            }
        }
    });
}
DI void ph_qkv(KP p, int l, char* smem) {
    for_tiles(512 * 14, [&](int t) __attribute__((always_inline)) {
        int rt, ct; tile_rc(t, 14, rt, ct);
        f32x16 acc[2][2];
        if (ct < 6) {
            gemm_tile<1>((const bf16_t*)(p->ws + OFF_HQ), QL, rt * 128, 0, TOK, (const bf16_t*)(p->ws + OFF_WUQ) + ((size_t)l * 768 + ct * 128) * QL, QL, QL, smem, acc);
            const float* stg = stage_tile(acc, (const float*)(smem + RS_OFF), smem);
            const int tt = tid(), c8 = tt & 15, n8 = ct * 128 + c8 * 8, head = n8 / 96, w0 = n8 - head * 96;
            const float qs = 0.10206207261596575f * LOG2E;
#pragma unroll
            for (int i = 0; i < 8; ++i) {
                const int row = (tt >> 4) + 16 * i, tok = rt * 128 + row;
                float4 lo = *(const float4*)(stg + row * 132 + c8 * 8), hi = *(const float4*)(stg + row * 132 + c8 * 8 + 4);
                if (w0 >= 64) {
                    const int c = w0 - 64, pc = c8 * 8 + (c < 16 ? 16 : -16);
                    const float4 plo = *(const float4*)(stg + row * 132 + pc), phi = *(const float4*)(stg + row * 132 + pc + 4);
                    rope8(lo, hi, plo, phi, (const float*)(p->ws + OFF_COS) + (size_t)tok * 16, (const float*)(p->ws + OFF_SIN) + (size_t)tok * 16, c);
                }
                lo.x *= qs; lo.y *= qs; lo.z *= qs; lo.w *= qs; hi.x *= qs; hi.y *= qs; hi.z *= qs; hi.w *= qs;
                const int b = tok >> 13, sx = tok & 8191;
                *(uint4*)((bf16_t*)(p->ws + OFF_Q) + (((size_t)(b * 8 + head)) * SEQ + sx) * 96 + w0) = pack8(lo, hi);
            }
        } else {
            const int c2 = ct - 6;
            gemm_tile<1>((const bf16_t*)(p->ws + OFF_HKV), KVL, rt * 128, 0, TOK, (const bf16_t*)(p->ws + OFF_WUKV) + ((size_t)l * 1024 + c2 * 128) * KVL, KVL, KVL, smem, acc);
            const float* stg = stage_tile(acc, (const float*)(smem + RS_OFF), smem);
            const int tt = tid(), tok0 = rt * 128, b = tok0 >> 13, s0 = tok0 & 8191;
            {
                const int c8 = tt & 7;
#pragma unroll
                for (int i = 0; i < 4; ++i) {
                    const int row = (tt >> 3) + 32 * i;
                    const float4 lo = *(const float4*)(stg + row * 132 + c8 * 8), hi = *(const float4*)(stg + row * 132 + c8 * 8 + 4);
                    *(uint4*)((bf16_t*)(p->ws + OFF_K) + (((size_t)(b * 8 + c2)) * SEQ + s0 + row) * 96 + c8 * 8) = pack8(lo, hi);
                }
            }
            {
                const int tc = tt & 15;
#pragma unroll
                for (int i = 0; i < 4; ++i) {
                    const int d = (tt >> 4) + 16 * i;
                    const float* sp = stg + (tc * 8) * 132 + 64 + d;
                    uint4 ov;
                    ov.x = pack2(sp[0], sp[132]); ov.y = pack2(sp[2 * 132], sp[3 * 132]); ov.z = pack2(sp[4 * 132], sp[5 * 132]); ov.w = pack2(sp[6 * 132], sp[7 * 132]);
                    *(uint4*)((bf16_t*)(p->ws + OFF_VT) + (((size_t)(b * 8 + c2)) * 64 + d) * SEQ + s0 + tc * 8) = ov;
                }
            }
        }
    });
}
DI void ph_mix(KP p, int l, char* smem) {
    for_tiles(512, [&](int t) __attribute__((always_inline)) { mla_item(p, t, smem); });
    for_tiles(512, [&](int t) __attribute__((always_inline)) { gmlp_item(p, l, t, smem); });
}
DI void ph_res(KP p, const bf16_t* A, int K, const bf16_t* Wt, const float* xin, char* smem, bool dry) {
    for_tiles(512 * 8, [&](int t) __attribute__((always_inline)) {
        int rt, ct; tile_rc(t, 8, rt, ct);
        f32x16 acc[2][2];
        gemm_tile<0>(A, K, rt * 128, 0, TOK, Wt + (size_t)ct * 128 * K, K, K, smem, acc);
        if (dry) return;
        const int tt = tid(), lane = tt & 63, w = __builtin_amdgcn_readfirstlane(tt >> 6), wm = w >> 1, wn = w & 1, l32 = lane & 31, h = lane >> 5;
        float* stg = (float*)smem;
#pragma unroll
        for (int i = 0; i < 2; ++i)
#pragma unroll
            for (int j = 0; j < 2; ++j)
#pragma unroll
                for (int r = 0; r < 16; ++r) stg[(wm * 64 + i * 32 + crow(r, h)) * 132 + wn * 64 + j * 32 + l32] = acc[i][j][r];
        __syncthreads();
        bf16_t* xb = (bf16_t*)(p->ws + OFF_XB) + (size_t)(rt * 128) * DM + ct * 128;
        float* part = (float*)(p->ws + OFF_RSC) + (size_t)(rt * 128) * 16 + ct * 2;
        const int c8 = tt & 15;
#pragma unroll
        for (int i = 0; i < 8; ++i) {
            const int row = (tt >> 4) + 16 * i;
            const float4 lo = *(const float4*)(stg + row * 132 + c8 * 8), hi = *(const float4*)(stg + row * 132 + c8 * 8 + 4);
            uint4* gp = (uint4*)(xb + (size_t)row * DM + c8 * 8);
            const uint4 xv = *gp;
            uint4 nv;
            nv.x = pack2h(hlo(xv.x) + lo.x, hhi(xv.x) + lo.y); nv.y = pack2h(hlo(xv.y) + lo.z, hhi(xv.y) + lo.w);
            nv.z = pack2h(hlo(xv.z) + hi.x, hhi(xv.z) + hi.y); nv.w = pack2h(hlo(xv.w) + hi.z, hhi(xv.w) + hi.w);
            *gp = nv;
            float s0 = hlo(nv.x), s1 = hhi(nv.x), s2 = hlo(nv.y), s3 = hhi(nv.y), s4 = hlo(nv.z), s5 = hhi(nv.z), s6 = hlo(nv.w), s7 = hhi(nv.w);
            float sq = s0 * s0 + s1 * s1 + s2 * s2 + s3 * s3 + s4 * s4 + s5 * s5 + s6 * s6 + s7 * s7;
            sq += __shfl_xor(sq, 1); sq += __shfl_xor(sq, 2); sq += __shfl_xor(sq, 4); sq += __shfl_xor(sq, 8);
            if (c8 == 0) { float2 pv; pv.x = sq; pv.y = 0.f; *(float2*)(part + (size_t)row * 16) = pv; }
        }
    });
}
DI void ph_qm(KP p, int l, char* smem) {
    for_tiles(512 * 8, [&](int t) __attribute__((always_inline)) {
        int rt, ct; tile_rc(t, 8, rt, ct);
        f32x16 acc[2][2];
        const float rsp = rs_load(p, rt * 128);
        gemm_tile<0, true>((const bf16_t*)(p->ws + OFF_XB), DM, rt * 128, 0, TOK, (const bf16_t*)(p->ws + OFF_WMQ) + ((size_t)l * DM + ct * 128) * DM, DM, DM, smem, acc);
        rs_finish(rsp, rt * 128, smem);
        const float* stg = stage_tile(acc, (const float*)(smem + RS_OFF), smem);
        const int tt = tid(), c8 = tt & 15;
        const float qs = 0.0625f * LOG2E;
#pragma unroll
        for (int i = 0; i < 8; ++i) {
            const int row = (tt >> 4) + 16 * i;
            float4 lo = *(const float4*)(stg + row * 132 + c8 * 8), hi = *(const float4*)(stg + row * 132 + c8 * 8 + 4);
            lo.x *= qs; lo.y *= qs; lo.z *= qs; lo.w *= qs; hi.x *= qs; hi.y *= qs; hi.z *= qs; hi.w *= qs;
            *(uint4*)((bf16_t*)(p->ws + OFF_QM) + (size_t)(rt * 128 + row) * DM + ct * 128 + c8 * 8) = pack8(lo, hi);
        }
    });
}
DI void ph_memattn(KP p, int l, char* smem) {
    for_tiles(NBATCH * 128 * 4, [&](int t) __attribute__((always_inline)) { memattn_item(p, l, t, smem); });
}
typedef float f32p __attribute__((ext_vector_type(2)));
DI void ph_up(KP p, int l, char* smem) {
    for_tiles(NBATCH * 66 * 44, [&](int t) __attribute__((always_inline)) {
        int rt, ct; tile_rc(t, 44, rt, ct);
        const int b = rt / 66, rl = rt - b * 66, s0 = rl * 126;
        const float* cw = p->conv_w + (size_t)l * 3 * 2 * DFF; const float* cb = p->conv_b + (size_t)l * 2 * DFF;
        const int cp2 = (tid() & 31) * 2, c = ct * 64 + cp2, c2 = DFF + c;
        const f32p g0 = *(const f32p*)(cw + c), g1 = *(const f32p*)(cw + 2 * DFF + c), g2 = *(const f32p*)(cw + 4 * DFF + c), gb = *(const f32p*)(cb + c);
        const f32p u0 = *(const f32p*)(cw + c2), u1 = *(const f32p*)(cw + 2 * DFF + c2), u2 = *(const f32p*)(cw + 4 * DFF + c2), ub = *(const f32p*)(cb + c2);
        f32x16 acc[2][2];
        const float rsp = rs_load(p, b * SEQ + s0 - 1);
        if (rl == 0 || rl == 65) gemm_tile<0, true, true>((const bf16_t*)(p->ws + OFF_XB), DM, b * SEQ + s0 - 1, b * SEQ, (b + 1) * SEQ, (const bf16_t*)(p->ws + OFF_WUP) + ((size_t)l * 2 * DFF + ct * 128) * DM, DM, DM, smem, acc);
        else gemm_tile<0, true, false>((const bf16_t*)(p->ws + OFF_XB), DM, b * SEQ + s0 - 1, b * SEQ, (b + 1) * SEQ, (const bf16_t*)(p->ws + OFF_WUP) + ((size_t)l * 2 * DFF + ct * 128) * DM, DM, DM, smem, acc);
        rs_finish(rsp, b * SEQ + s0 - 1, smem);
        const float* rs = (const float*)(smem + RS_OFF);
        float* stg = (float*)smem;
        const int tt = tid(), lane = tt & 63, w = __builtin_amdgcn_readfirstlane(tt >> 6), wm = w >> 1, wn = w & 1, l32 = lane & 31, h = lane >> 5;
#pragma unroll
        for (int i = 0; i < 2; ++i)
#pragma unroll
            for (int j = 0; j < 2; ++j)
#pragma unroll
                for (int r = 0; r < 16; ++r) {
                    const int row = wm * 64 + i * 32 + crow(r, h), col = wn * 64 + j * 32 + l32;
                    stg[row * 130 + col] = acc[i][j][r] * rs[row];
                }
        __syncthreads();
        bf16_t* act = (bf16_t*)(p->ws + OFF_ACT);
        const int rmax = min(126, SEQ - s0);
        const int rbeg = w * 32 + h * 16, rend = min(rbeg + 16, rmax);
        if (rbeg < rend) {
            const float* sg = stg + rbeg * 130 + cp2;
            unsigned* arow = (unsigned*)(act + ((size_t)b * SEQ + s0 + rbeg) * DFF + c);
            f32p ga = *(const f32p*)sg, gm = *(const f32p*)(sg + 130), ua = *(const f32p*)(sg + 64), um = *(const f32p*)(sg + 130 + 64);
#pragma unroll 4
            for (int r = rbeg; r < rend; ++r) {
                sg += 130;
                const f32p gn = *(const f32p*)(sg + 130), un = *(const f32p*)(sg + 130 + 64);
                const f32p g = g0 * ga + g1 * gm + g2 * gn + gb;
                const f32p up = u0 * ua + u1 * um + u2 * un + ub;
                const f32p e = g * (-LOG2E);
                f32p den; den.x = 1.f + ex2(e.x); den.y = 1.f + ex2(e.y);
                f32p sig; sig.x = __builtin_amdgcn_rcpf(den.x); sig.y = __builtin_amdgcn_rcpf(den.y);
                const f32p o = g * sig * up;
                *arow = pack2(o.x, o.y);
                arow += DFF / 2;
                ga = gm; gm = gn; ua = um; um = un;
            }
        }
    });
}
DI void ph_final(KP p) {
    const int lane = tid() & 63, wv = blockIdx.x * 4 + (tid() >> 6), nw = gridDim.x * 4;
    const bf16_t* xbp = (const bf16_t*)(p->ws + OFF_XB);
    const float* rsc = (const float*)(p->ws + OFF_RSC);
    for (int row = wv; row < TOK; row += nw) {
        const uint4* xr = (const uint4*)(xbp + (size_t)row * DM);
        float4* orow = (float4*)(p->out + (size_t)row * DM);
        float ps = lane < 16 ? rsc[(size_t)row * 16 + lane] : 0.f;
        ps += __shfl_xor(ps, 1); ps += __shfl_xor(ps, 2); ps += __shfl_xor(ps, 4); ps += __shfl_xor(ps, 8);
        const float sc = rsqrtf(__shfl(ps, 0) * (1.f / DM) + EPS);
#pragma unroll
        for (int i = 0; i < 2; ++i) {
            const uint4 v = xr[lane + 64 * i];
            const float4 g0 = ((const float4*)p->final_norm_g)[2 * (lane + 64 * i)], g1 = ((const float4*)p->final_norm_g)[2 * (lane + 64 * i) + 1];
            float4 o0, o1;
            o0.x = hlo(v.x) * sc * g0.x; o0.y = hhi(v.x) * sc * g0.y; o0.z = hlo(v.y) * sc * g0.z; o0.w = hhi(v.y) * sc * g0.w;
            o1.x = hlo(v.z) * sc * g1.x; o1.y = hhi(v.z) * sc * g1.y; o1.z = hlo(v.w) * sc * g1.z; o1.w = hhi(v.w) * sc * g1.w;
            orow[2 * (lane + 64 * i)] = o0; orow[2 * (lane + 64 * i) + 1] = o1;
        }
    }
}

#define XB_TMO      128
#define XB_XCNT(j)  (256  + 64 * (j))
#define XB_XSUB(j)  (1280 + 64 * (j))
#define XB_XGEN(j)  (2304 + 64 * (j))
#define XB_TOP      3328
#define XB_TOPGEN   3392
#define XCD_BAR_WORDS 3456
#define XB_SPIN_CAP (1u << 22)
#define LAS __attribute__((address_space(3)))
static_assert(XCD_BAR_WORDS * 4 <= BAR_BYTES, "barrier words");
DI unsigned xb_ld(unsigned* p) { return __hip_atomic_load(p, __ATOMIC_RELAXED, __HIP_MEMORY_SCOPE_AGENT); }
DI unsigned xb_add(unsigned* p, unsigned v) { return __hip_atomic_fetch_add(p, v, __ATOMIC_RELAXED, __HIP_MEMORY_SCOPE_AGENT); }
DI unsigned xb_xcc_id() { return (unsigned)__builtin_amdgcn_s_getreg((3 << 11) | 20) & 0xFu; }
#define XB_SPIN(cond, bar) do { unsigned _sp = 0; while (cond) { __builtin_amdgcn_s_sleep(1); \
    if ((++_sp & 255u) == 0u) { if (xb_ld(&(bar)[XB_TMO])) break; if (_sp > XB_SPIN_CAP) { atomicAdd(&(bar)[XB_TMO], 1u); break; } } } } while (0)
struct XcdBarrier { unsigned* bar; unsigned x; volatile LAS unsigned* st; };
DI XcdBarrier xcd_barrier_post(unsigned* bar, volatile LAS unsigned* st) {
    XcdBarrier b; b.bar = bar; b.x = xb_xcc_id(); b.st = st;
    if (threadIdx.x == 0) (void)xb_add(&bar[XB_XCNT(b.x)], 1u);
    return b;
}
DI void xcd_barrier_complete(unsigned* bar, unsigned x, unsigned& nloc, unsigned& nx) {
    const unsigned G = gridDim.x * gridDim.y * gridDim.z;
    unsigned sum, cnt, mine, sp = 0u;
    for (;;) {
        sum = 0u; cnt = 0u; mine = 0u;
#pragma unroll
        for (unsigned j = 0; j < 16; ++j) { const unsigned c = xb_ld(&bar[XB_XCNT(j)]); sum += c; cnt += (c > 0u) ? 1u : 0u; mine = (j == x) ? c : mine; }
        if (sum == G) break;
        __builtin_amdgcn_s_sleep(1);
        if ((++sp & 255u) == 0u) { if (xb_ld(&bar[XB_TMO])) break; if (sp > XB_SPIN_CAP) { atomicAdd(&bar[XB_TMO], 1u); break; } }
    }
    nloc = mine > 0u ? mine : 1u; nx = cnt > 0u ? cnt : 1u;
}
DI void xcd_barrier(const XcdBarrier& b) {
    asm volatile("s_waitcnt vmcnt(0)" ::: "memory");
    __syncthreads();
    if (threadIdx.x == 0) {
        unsigned* bar = b.bar;
        __builtin_amdgcn_s_waitcnt(0);
        unsigned nloc = b.st[0], nx = b.st[1];
        if (nloc == 0u) { xcd_barrier_complete(bar, b.x, nloc, nx); b.st[0] = nloc; b.st[1] = nx; }
        const unsigned old = xb_add(&bar[XB_XSUB(b.x)], 1u);
        const unsigned gen = old / nloc;
        if (old + 1u == (gen + 1u) * nloc) {
            __builtin_amdgcn_fence(__ATOMIC_RELEASE, "agent");
            asm volatile("s_waitcnt vmcnt(0)" ::: "memory");
            const unsigned og = xb_add(&bar[XB_TOP], 1u);
            const unsigned tg = og / nx;
            if (og + 1u == (tg + 1u) * nx) xb_add(&bar[XB_TOPGEN], 1u);
            else XB_SPIN(xb_ld(&bar[XB_TOPGEN]) == tg, bar);
            __builtin_amdgcn_fence(__ATOMIC_ACQUIRE, "agent");
            xb_add(&bar[XB_XGEN(b.x)], 1u);
            asm volatile("s_waitcnt vmcnt(0)" ::: "memory");
        } else {
            XB_SPIN(xb_ld(&bar[XB_XGEN(b.x)]) == gen, bar);
            __builtin_amdgcn_fence(__ATOMIC_ACQUIRE, "agent");
            asm volatile("s_waitcnt vmcnt(0)" ::: "memory");
        }
    }
    __syncthreads();
}

constexpr int NPHASE = 2 + 9 * DEPTH + 1;
__global__ void __launch_bounds__(256, 2) mk(Params p_unused, int lo, int hi) {
    extern __shared__ __attribute__((aligned(16))) char smem[];
    cg::grid_group grid = cg::this_grid();
    volatile LAS unsigned* xst = (volatile LAS unsigned*)(smem + RS_OFF + 512);
    if (threadIdx.x == 0) { xst[0] = 0u; xst[1] = 0u; xst[2] = 0u; xst[3] = 0u; }
    __syncthreads();
    const XcdBarrier xbar = xcd_barrier_post((unsigned*)(kparams()->ws + OFF_BAR), xst);
    for (int ph = lo; ph < hi; ++ph) {
        KP p = kparams();
        if (ph == 0) phase_setup(p, smem);
        else if (ph == 1) ph_memkv(p, smem);
        else if (ph == NPHASE - 1) ph_final(p);
        else {
            const int l = (ph - 2) / 9, s = (ph - 2) % 9;
            const float* xin = l == 0 ? p->x : p->out;
            const int reps = ((REPMASK >> s) & 1) ? 2 : 1;
            for (int rep = 0; rep < reps; ++rep) {
                const bool dry = rep + 1 < reps;
                switch (s) {
                    case 0: ph_in(p, l, xin, smem); break;
                    case 1: ph_qkv(p, l, smem); break;
                    case 2: ph_mix(p, l, smem); break;
                    case 3: ph_res(p, (const bf16_t*)(p->ws + OFF_OMIX), DM, (const bf16_t*)(p->ws + OFF_WOUT) + (size_t)l * DM * DM, xin, smem, dry); break;
                    case 4: ph_qm(p, l, smem); break;
                    case 5: ph_memattn(p, l, smem); break;
                    case 6: ph_res(p, (const bf16_t*)(p->ws + OFF_OMEM), DM, (const bf16_t*)(p->ws + OFF_WMO) + (size_t)l * DM * DM, p->out, smem, dry); break;
                    case 7: ph_up(p, l, smem); break;
                    case 8: ph_res(p, (const bf16_t*)(p->ws + OFF_ACT), DFF, (const bf16_t*)(p->ws + OFF_WDN) + (size_t)l * DM * DFF, p->out, smem, dry); break;
                }
                if (dry) xcd_barrier(xbar);
            }
        }
        if (ph + 1 < hi) { if (ph == 0) grid.sync(); else xcd_barrier(xbar); }
    }
}

extern "C" void kernel_launch(void* const* d_in, const int* in_sizes, int n_in, void* d_out, int out_size, void* d_ws, size_t ws_size, hipStream_t stream) {
    static int grid_blocks = 0;
    if (!grid_blocks) {
        int dev = 0, cus = 0, per_cu = 0;
        hipGetDevice(&dev);
        hipDeviceGetAttribute(&cus, hipDeviceAttributeMultiprocessorCount, dev);
        hipFuncSetAttribute((const void*)mk, hipFuncAttributeMaxDynamicSharedMemorySize, LDS_BYTES);
        hipOccupancyMaxActiveBlocksPerMultiprocessor(&per_cu, (const void*)mk, 256, LDS_BYTES);
        if (per_cu < 1) per_cu = 1;
        if (per_cu > 2) per_cu = 2;
        grid_blocks = cus * per_cu;
        if (ws_size < OFF_END) fprintf(stderr, "kernel_launch: workspace too small: %zu < %zu\n", ws_size, (size_t)OFF_END);
    }
    Params p{};
    const float** fp = (const float**)&p;
    p.x = (const float*)d_in[0]; p.mem = (const float*)d_in[1]; p.pos = (const int*)d_in[2];
    p.norm_mix_g = (const float*)d_in[3]; p.w_in = (const float*)d_in[4]; p.q_norm_g = (const float*)d_in[5]; p.w_uq = (const float*)d_in[6];
    p.kv_norm_g = (const float*)d_in[7]; p.w_ukv = (const float*)d_in[8]; p.sg_ln_g = (const float*)d_in[9]; p.sg_ln_b = (const float*)d_in[10];
    p.sg_w_s = (const float*)d_in[11]; p.sg_b_s = (const float*)d_in[12]; p.out_norm_mla_g = (const float*)d_in[13]; p.out_norm_sg_g = (const float*)d_in[14];
    p.w_out = (const float*)d_in[15]; p.norm_mem_g = (const float*)d_in[16]; p.mem_norm_g = (const float*)d_in[17]; p.w_mq = (const float*)d_in[18];
    p.w_mkv = (const float*)d_in[19]; p.w_mo = (const float*)d_in[20]; p.norm_ffn_g = (const float*)d_in[21]; p.w_up = (const float*)d_in[22];
    p.conv_w = (const float*)d_in[23]; p.conv_b = (const float*)d_in[24]; p.w_down = (const float*)d_in[25]; p.final_norm_g = (const float*)d_in[26];
    p.out = (float*)d_out; p.ws = (char*)d_ws;
    (void)fp;
    (void)hipMemsetAsync((char*)d_ws + OFF_BAR, 0, BAR_BYTES, stream);
#if COOP
    int lo = 0, hi = NPHASE;
    void* args[] = {&p, &lo, &hi};
    hipError_t e = hipLaunchCooperativeKernel((const void*)mk, dim3(grid_blocks), dim3(256), args, LDS_BYTES, stream);
    if (e != hipSuccess) fprintf(stderr, "cooperative launch failed: %s (grid %d)\n", hipGetErrorString(e), grid_blocks);
#else
    for (int ph = 0; ph < NPHASE; ++ph) hipLaunchKernelGGL(mk, dim3(grid_blocks), dim3(256), LDS_BYTES, stream, p, ph, ph + 1);
#endif
}
```

```cpp
#include <hip/hip_runtime.h>
#include <hip/hip_cooperative_groups.h>
#include <stdint.h>
#include <stdio.h>
namespace cg = cooperative_groups;

#ifndef PHMASK
#define PHMASK 0xFFFF
#endif
#ifndef REPMASK
#define REPMASK 0
#endif
#ifndef COOP
#define COOP 1
#endif

typedef unsigned short bf16_t;
typedef __attribute__((ext_vector_type(8))) short bf16x8;
typedef __attribute__((ext_vector_type(16))) float f32x16;
typedef __attribute__((ext_vector_type(4))) unsigned u32x4;
#define DI __device__ __forceinline__
#define MFMA(a, b, c) __builtin_amdgcn_mfma_f32_32x32x16_bf16((a), (b), (c), 0, 0, 0)

constexpr int NBATCH = 8, SEQ = 8192, TOK = NBATCH * SEQ, DM = 1024, DEPTH = 4;
constexpr int NMEM = 256, QL = 256, KVL = 128, ROPE = 32, NOPE = 64, VD = 64, NH = 8;
constexpr int SGW = 512, INC = 1440, INCP = 1536, DFF = 2816;
constexpr float EPS = 1e-6f;
constexpr float LOG2E = 1.4426950408889634f;

constexpr size_t al256(size_t x) { return (x + 255) & ~(size_t)255; }
constexpr size_t SZ_WIN = (size_t)DEPTH * INCP * DM * 2;
constexpr size_t SZ_WUQ = (size_t)DEPTH * 768 * QL * 2;
constexpr size_t SZ_WUKV = (size_t)DEPTH * 1024 * KVL * 2;
constexpr size_t SZ_WS = (size_t)DEPTH * 8 * 128 * 128 * 2;
constexpr size_t SZ_W1K = (size_t)DEPTH * DM * DM * 2;
constexpr size_t SZ_WMKV = (size_t)DEPTH * 2048 * DM * 2;
constexpr size_t SZ_WUP = (size_t)DEPTH * 2 * DFF * DM * 2;
constexpr size_t SZ_WDN = (size_t)DEPTH * DM * DFF * 2;
constexpr size_t OFF_WIN = 0;
constexpr size_t OFF_WUQ = OFF_WIN + SZ_WIN;
constexpr size_t OFF_WUKV = OFF_WUQ + SZ_WUQ;
constexpr size_t OFF_WSG = OFF_WUKV + SZ_WUKV;
constexpr size_t OFF_WOUT = OFF_WSG + SZ_WS;
constexpr size_t OFF_WMQ = OFF_WOUT + SZ_W1K;
constexpr size_t OFF_WMKV = OFF_WMQ + SZ_W1K;
constexpr size_t OFF_WMO = OFF_WMKV + SZ_WMKV;
constexpr size_t OFF_WUP = OFF_WMO + SZ_W1K;
constexpr size_t OFF_WDN = OFF_WUP + SZ_WUP;
constexpr size_t OFF_COS = OFF_WDN + SZ_WDN;
constexpr size_t OFF_SIN = OFF_COS + (size_t)TOK * 16 * 4;
constexpr size_t OFF_KMEM = OFF_SIN + (size_t)TOK * 16 * 4;
constexpr size_t SZ_KMEM = (size_t)DEPTH * NBATCH * 4 * 256 * 256 * 2;
constexpr size_t OFF_VMEM = OFF_KMEM + SZ_KMEM;
constexpr size_t OFF_ACT0 = OFF_VMEM + SZ_KMEM;
constexpr size_t OFF_Q = OFF_ACT0;
constexpr size_t OFF_K = OFF_Q + (size_t)TOK * 8 * 96 * 2;
constexpr size_t OFF_VT = OFF_K + (size_t)TOK * 8 * 96 * 2;
constexpr size_t OFF_U = OFF_VT + (size_t)TOK * 512 * 2;
constexpr size_t OFF_V = OFF_U + (size_t)TOK * 512 * 2;
constexpr size_t OFF_OMIX = OFF_V + (size_t)TOK * 512 * 2;
constexpr size_t OFF_HQ = OFF_OMIX + (size_t)TOK * 1024 * 2;
constexpr size_t OFF_HKV = OFF_HQ + (size_t)TOK * 256 * 2;
constexpr size_t OFF_XB = OFF_HKV + (size_t)TOK * 128 * 2;
constexpr size_t OFF_MEMB = OFF_XB + (size_t)TOK * DM * 2;
constexpr size_t OFF_RSC = OFF_MEMB + (size_t)NBATCH * NMEM * DM * 2;
constexpr size_t OFF_BAR = OFF_RSC + (size_t)TOK * 16 * 4;
constexpr size_t BAR_BYTES = 16384;
constexpr size_t OFF_END = OFF_BAR + BAR_BYTES;
constexpr size_t OFF_QM = OFF_Q;
constexpr size_t OFF_OMEM = OFF_OMIX;
constexpr size_t OFF_ACT = OFF_ACT0;
static_assert(OFF_ACT + (size_t)TOK * DFF * 2 <= OFF_XB, "act alias");
static_assert(OFF_END <= (size_t)1000 * 1024 * 1024, "ws budget");

struct Params {
    const float *x, *mem; const int* pos;
    const float *norm_mix_g, *w_in, *q_norm_g, *w_uq, *kv_norm_g, *w_ukv, *sg_ln_g, *sg_ln_b, *sg_w_s, *sg_b_s,
        *out_norm_mla_g, *out_norm_sg_g, *w_out, *norm_mem_g, *mem_norm_g, *w_mq, *w_mkv, *w_mo, *norm_ffn_g, *w_up,
        *conv_w, *conv_b, *w_down, *final_norm_g;
    float* out; char* ws;
};

typedef const __attribute__((address_space(4))) Params* KP;
DI KP kparams() { KP k = (KP)__builtin_amdgcn_kernarg_segment_ptr(); asm volatile("" : "+s"(k)); return k; }
typedef __bf16 bf16v2_t __attribute__((ext_vector_type(2)));
typedef float f32v2_t __attribute__((ext_vector_type(2)));
DI unsigned pack2(float a, float b) { f32v2_t v = {a, b}; return __builtin_bit_cast(unsigned, __builtin_convertvector(v, bf16v2_t)); }
DI bf16_t f2bf(float f) { return (bf16_t)(pack2(f, f) & 0xffffu); }
typedef _Float16 f16x8 __attribute__((ext_vector_type(8)));
typedef _Float16 f16v2_t __attribute__((ext_vector_type(2)));
DI unsigned pack2h(float a, float b) { f16v2_t v = {(_Float16)a, (_Float16)b}; return __builtin_bit_cast(unsigned, v); }
DI bf16_t f2h(float f) { return __builtin_bit_cast(unsigned short, (_Float16)f); }
DI float h2f(bf16_t u) { return (float)__builtin_bit_cast(_Float16, u); }
DI float hlo(unsigned u) { return h2f((bf16_t)(u & 0xffffu)); }
DI float hhi(unsigned u) { return h2f((bf16_t)(u >> 16)); }
#define MFMA_H(a, b, c) __builtin_amdgcn_mfma_f32_32x32x16_f16(__builtin_bit_cast(f16x8, (a)), __builtin_bit_cast(f16x8, (b)), (c), 0, 0, 0)
DI float bf2f(bf16_t b) { return __uint_as_float((unsigned)b << 16); }
DI float bflo(unsigned u) { return __uint_as_float(u << 16); }
DI float bfhi(unsigned u) { return __uint_as_float(u & 0xffff0000u); }
DI float ex2(float x) { return __builtin_amdgcn_exp2f(x); }
DI float gelu_tanh(float x) { float y = 0.7978845608028654f * (x + 0.044715f * x * x * x); return x * __builtin_amdgcn_rcpf(1.f + ex2(-2.f * LOG2E * y)); }
DI float silu(float x) { return x * __builtin_amdgcn_rcpf(1.f + ex2(-LOG2E * x)); }
DI int tid() { int t = threadIdx.x; asm volatile("" : "+v"(t)); return t; }
DI int crow(int r, int h) { return (r & 3) + 8 * (r >> 2) + 4 * h; }
DI int swap23(int r) { return (r & ~12) | ((r & 4) << 1) | ((r & 8) >> 1); }

template <class F> DI void for_tiles(int ntiles, F f) {
    const int G = gridDim.x, b = blockIdx.x;
    const bool sw = (G & 7) == 0;
    const int tpx = (ntiles + 7) >> 3;
    const int start = sw ? (b >> 3) : b, step = sw ? (G >> 3) : G, lim = sw ? tpx : ntiles, base = sw ? (b & 7) * tpx : 0;
    for (int i = start; i < lim; i += step) {
        const int t = base + i;
        if (t < ntiles) f(t);
    }
}

constexpr int LK = 72;
constexpr int GEMM_LDS = 4 * 128 * LK * 2;
constexpr int RS_OFF = GEMM_LDS;
constexpr int LDS_BYTES = GEMM_LDS + 1024;

template <int AMODE, bool F16 = false, bool MASK = false>
DI void gemm_tile(const bf16_t* __restrict__ Ab, int lda, int row0, int rlo, int rhi,
                  const bf16_t* __restrict__ Bt, int ldb, int K, char* smem, f32x16 (&acc)[2][2]) {
    const int t = tid(), lane = t & 63, w = __builtin_amdgcn_readfirstlane(t >> 6), wm = w >> 1, wn = w & 1, l32 = lane & 31, h = lane >> 5;
    bf16_t* As = (bf16_t*)smem;
    bf16_t* Bs = As + 2 * 128 * LK;
    float* rs = (float*)(smem + RS_OFF);
#pragma unroll
    for (int i = 0; i < 2; ++i)
#pragma unroll
        for (int j = 0; j < 2; ++j)
#pragma unroll
            for (int r = 0; r < 16; ++r) acc[i][j][r] = 0.f;

    uint4 p0a0, p0a1, p0a2, p0a3, p0b0, p0b1, p0b2, p0b3, p1a0, p1a1, p1a2, p1a3, p1b0, p1b1, p1b2, p1b3;
    float ss0 = 0.f, ss1 = 0.f, ss2 = 0.f, ss3 = 0.f;
    const int gr0 = row0 + (t >> 3);
    const bool rv0 = gr0 >= rlo && gr0 < rhi, rv1 = gr0 + 32 >= rlo && gr0 + 32 < rhi, rv2 = gr0 + 64 >= rlo && gr0 + 64 < rhi, rv3 = gr0 + 96 >= rlo && gr0 + 96 < rhi;
    const int nk = K >> 6;
    const int rhm = rhi - 1;
    const unsigned aoff0 = (unsigned)min(max(gr0, rlo), rhm) * (unsigned)lda + 8u * (t & 7);
    const unsigned aoff1 = (unsigned)min(max(gr0 + 32, rlo), rhm) * (unsigned)lda + 8u * (t & 7);
    const unsigned aoff2 = (unsigned)min(max(gr0 + 64, rlo), rhm) * (unsigned)lda + 8u * (t & 7);
    const unsigned aoff3 = (unsigned)min(max(gr0 + 96, rlo), rhm) * (unsigned)lda + 8u * (t & 7);
    const unsigned btoff = (unsigned)((t >> 3) * ldb + 8 * (t & 7));

    __syncthreads();

#define LD1(S, j, k0)                                                                                         \
    {                                                                                                         \
        S##a##j = *(const uint4*)(Ab + (k0) + aoff##j);          \
        S##b##j = *(const uint4*)(Bt + (size_t)(32 * j) * ldb + (k0) + btoff);                                \
    }
#define LOADS(S, k0) { LD1(S, 0, k0) LD1(S, 1, k0) LD1(S, 2, k0) LD1(S, 3, k0) }
#define ST1(S, j, buf)                                                                                        \
    {                                                                                                         \
        uint4 v = S##a##j;                                                                                    \
        if constexpr (MASK) { if (!rv##j) v = make_uint4(0, 0, 0, 0); }     \
        if (AMODE == 1) {                                                                                     \
            float a0 = bflo(v.x), a1 = bfhi(v.x), a2 = bflo(v.y), a3 = bfhi(v.y), a4 = bflo(v.z), a5 = bfhi(v.z), a6 = bflo(v.w), a7 = bfhi(v.w); \
            ss##j += a0 * a0 + a1 * a1 + a2 * a2 + a3 * a3 + a4 * a4 + a5 * a5 + a6 * a6 + a7 * a7;          \
        }                                                                                                     \
        *(uint4*)(As + (buf) * 128 * LK + ((t >> 3) + 32 * j) * LK + 8 * (t & 7)) = v;                        \
        *(uint4*)(Bs + (buf) * 128 * LK + ((t >> 3) + 32 * j) * LK + 8 * (t & 7)) = S##b##j;                  \
    }
#define STORES(S, buf) { ST1(S, 0, buf) ST1(S, 1, buf) ST1(S, 2, buf) ST1(S, 3, buf) }
#define FRAGS(ks, A0, A1, B0, B1) { A0 = *(const bf16x8*)(a_s + (ks) * 16); A1 = *(const bf16x8*)(a_s + 32 * LK + (ks) * 16); B0 = *(const bf16x8*)(b_s + (ks) * 16); B1 = *(const bf16x8*)(b_s + 32 * LK + (ks) * 16); }
#define MMAS(A0, A1, B0, B1) { __builtin_amdgcn_s_setprio(1); if constexpr (F16) { acc[0][0] = MFMA_H(A0, B0, acc[0][0]); acc[0][1] = MFMA_H(A0, B1, acc[0][1]); acc[1][0] = MFMA_H(A1, B0, acc[1][0]); acc[1][1] = MFMA_H(A1, B1, acc[1][1]); } else { acc[0][0] = MFMA(A0, B0, acc[0][0]); acc[0][1] = MFMA(A0, B1, acc[0][1]); acc[1][0] = MFMA(A1, B0, acc[1][0]); acc[1][1] = MFMA(A1, B1, acc[1][1]); } __builtin_amdgcn_s_setprio(0); }
#define COMPUTE(buf)                                                                                          \
    {                                                                                                         \
        const bf16_t* a_s = As + (buf) * 128 * LK + (wm * 64 + l32) * LK + h * 8;                             \
        const bf16_t* b_s = Bs + (buf) * 128 * LK + (wn * 64 + l32) * LK + h * 8;                             \
        bf16x8 xa0, xa1, xb0, xb1, ya0, ya1, yb0, yb1;                                                        \
        FRAGS(0, xa0, xa1, xb0, xb1)                                                                          \
        FRAGS(1, ya0, ya1, yb0, yb1)                                                                          \
        MMAS(xa0, xa1, xb0, xb1)                                                                              \
        FRAGS(2, xa0, xa1, xb0, xb1)                                                                          \
        MMAS(ya0, ya1, yb0, yb1)                                                                              \
        FRAGS(3, ya0, ya1, yb0, yb1)                                                                          \
        MMAS(xa0, xa1, xb0, xb1)                                                                              \
        MMAS(ya0, ya1, yb0, yb1)                                                                              \
    }

    const int klast = (nk - 1) * 64;
    LOADS(p0, 0);
    LOADS(p1, 64);
    STORES(p0, 0);
    LOADS(p0, min(128, klast));
    __syncthreads();
    for (int kt = 0; kt < nk; kt += 2) {
        COMPUTE(0);
        STORES(p1, 1);
        LOADS(p1, min((kt + 3) * 64, klast));
        __syncthreads();
        COMPUTE(1);
        if (kt + 2 < nk) STORES(p0, 0);
        LOADS(p0, min((kt + 4) * 64, klast));
        __syncthreads();
    }
#undef LOADS
#undef STORES
#undef COMPUTE
#undef FRAGS
#undef MMAS
#undef LD1
#undef ST1
    if (AMODE == 1) {
#define RS1(j) { float s = ss##j; s += __shfl_xor(s, 1); s += __shfl_xor(s, 2); s += __shfl_xor(s, 4); if ((t & 7) == 0) rs[(t >> 3) + 32 * j] = rsqrtf(s / (float)K + EPS); }
        RS1(0) RS1(1) RS1(2) RS1(3)
#undef RS1
        __syncthreads();
    }
}

DI float rs_load(KP p, int row0) {
    const int t = tid(), r = row0 + (t >> 1);
    float sum = 0.f;
    if (r >= 0 && r < TOK) {
        const float4* ps = (const float4*)((const float*)(p->ws + OFF_RSC) + (size_t)r * 16 + (t & 1) * 8);
        const float4 a = ps[0], b = ps[1];
        sum = (a.x + a.y) + (a.z + a.w) + (b.x + b.y) + (b.z + b.w);
    }
    return sum;
}
DI void rs_finish(float sum, int row0, char* smem) {
    const int t = tid(), r = row0 + (t >> 1);
    sum += __shfl_xor(sum, 1);
    if ((t & 1) == 0) ((float*)(smem + RS_OFF))[t >> 1] = (r >= 0 && r < TOK) ? rsqrtf(sum * (1.f / DM) + EPS) : 0.f;
    __syncthreads();
}

DI void tile_rc(int t, int NT, int& rt, int& ct) { const int g = t / (8 * NT), rem = t - g * 8 * NT; ct = rem >> 3; rt = g * 8 + (rem & 7); }

template <class E> DI void run_epi(const f32x16 (&acc)[2][2], const E& e) {
    const int w = __builtin_amdgcn_readfirstlane(tid() >> 6), wm = w >> 1, wn = w & 1;
#pragma unroll
    for (int i = 0; i < 2; ++i)
#pragma unroll
        for (int j = 0; j < 2; ++j) e(wm * 64 + i * 32, wn * 64 + j * 32, acc[i][j]);
}

DI int up_perm(int n) { return n < DFF ? (n >> 6) * 128 + (n & 63) : ((n - DFF) >> 6) * 128 + 64 + ((n - DFF) & 63); }

DI void conv_tile(const float* __restrict__ src, int K, int N, const float* g1, const float* g2, int ksplit,
                  bf16_t* __restrict__ dst, int rowmap, int tile, float* lds, int mode, bool f16 = false) {
    const int ntn = N >> 5, tk = tile / ntn, tn = tile - tk * ntn, k0 = tk * 32, n0 = tn * 32;
    const int tx = tid() & 31, ty = tid() >> 5;
    if (mode == 0) {
#pragma unroll
        for (int i = 0; i < 4; ++i) {
            int k = k0 + ty + 8 * i;
            float v = src[(size_t)k * N + n0 + tx];
            float g = g1 ? (k < ksplit ? g1[k] : g2[k - ksplit]) : 1.f;
            lds[(ty + 8 * i) * 33 + tx] = v * g;
        }
    } else {
#pragma unroll
        for (int i = 0; i < 4; ++i) {
            int n = n0 + ty + 8 * i;
            int nn = rowmap ? up_perm(n) : n;
            const float wv = lds[tx * 33 + ty + 8 * i];
            dst[(size_t)nn * K + k0 + tx] = f16 ? f2h(wv) : f2bf(wv);
        }
    }
}

__device__ void phase_setup(KP p, char* smem) {
    float* lds = (float*)smem;
    char* ws = p->ws;
    constexpr int PER_LAYER = 1440 + 192 + 128 + 1024 + 1024 + 2048 + 1024 + 5632 + 2816;
    auto job = [&](int t, float* ldsq, int mode) __attribute__((always_inline)) {
        int l = t / PER_LAYER, r = t - l * PER_LAYER;
        if (r < 1440) conv_tile(p->w_in + (size_t)l * DM * INC, DM, INC, p->norm_mix_g + l * DM, nullptr, DM, (bf16_t*)(ws + OFF_WIN) + (size_t)l * INCP * DM, 0, r, ldsq, mode, true);
        else if ((r -= 1440) < 192) conv_tile(p->w_uq + (size_t)l * QL * 768, QL, 768, p->q_norm_g + l * QL, nullptr, QL, (bf16_t*)(ws + OFF_WUQ) + (size_t)l * 768 * QL, 0, r, ldsq, mode);
        else if ((r -= 192) < 128) conv_tile(p->w_ukv + (size_t)l * KVL * 1024, KVL, 1024, p->kv_norm_g + l * KVL, nullptr, KVL, (bf16_t*)(ws + OFF_WUKV) + (size_t)l * 1024 * KVL, 0, r, ldsq, mode);
        else if ((r -= 128) < 1024) conv_tile(p->w_out + (size_t)l * DM * DM, DM, DM, p->out_norm_mla_g + l * 512, p->out_norm_sg_g + l * 512, 512, (bf16_t*)(ws + OFF_WOUT) + (size_t)l * DM * DM, 0, r, ldsq, mode);
        else if ((r -= 1024) < 1024) conv_tile(p->w_mq + (size_t)l * DM * DM, DM, DM, p->norm_mem_g + l * DM, nullptr, DM, (bf16_t*)(ws + OFF_WMQ) + (size_t)l * DM * DM, 0, r, ldsq, mode, true);
        else if ((r -= 1024) < 2048) conv_tile(p->w_mkv + (size_t)l * DM * 2048, DM, 2048, p->mem_norm_g + l * DM, nullptr, DM, (bf16_t*)(ws + OFF_WMKV) + (size_t)l * 2048 * DM, 0, r, ldsq, mode);
        else if ((r -= 2048) < 1024) conv_tile(p->w_mo + (size_t)l * DM * DM, DM, DM, nullptr, nullptr, DM, (bf16_t*)(ws + OFF_WMO) + (size_t)l * DM * DM, 0, r, ldsq, mode);
        else if ((r -= 1024) < 5632) conv_tile(p->w_up + (size_t)l * DM * 2 * DFF, DM, 2 * DFF, p->norm_ffn_g + l * DM, nullptr, DM, (bf16_t*)(ws + OFF_WUP) + (size_t)l * 2 * DFF * DM, 1, r, ldsq, mode, true);
        else { r -= 5632; conv_tile(p->w_down + (size_t)l * DFF * DM, DFF, DM, nullptr, nullptr, DFF, (bf16_t*)(ws + OFF_WDN) + (size_t)l * DM * DFF, 0, r, ldsq, mode); }
    };
    constexpr int NJOB = PER_LAYER * DEPTH, TPB = 4;
    for (int t0 = blockIdx.x; t0 < NJOB; t0 += TPB * gridDim.x) {
#pragma unroll
        for (int u = 0; u < TPB; ++u) { const int t = t0 + u * gridDim.x; if (t < NJOB) job(t, lds + u * 32 * 33, 0); }
        __syncthreads();
#pragma unroll
        for (int u = 0; u < TPB; ++u) { const int t = t0 + u * gridDim.x; if (t < NJOB) job(t, lds + u * 32 * 33, 1); }
        __syncthreads();
    }
    const size_t gt = (size_t)blockIdx.x * 256 + tid(), gn = (size_t)gridDim.x * 256;
    bf16_t* wsg = (bf16_t*)(ws + OFF_WSG);
    for (size_t i = gt; i < (size_t)DEPTH * 8 * 128 * 128; i += gn) wsg[i] = f2bf(p->sg_w_s[i]);
    for (size_t i = gt; i < (size_t)DEPTH * 96 * DM; i += gn) {
        size_t l = i / (96 * DM), r = i - l * (96 * DM);
        ((bf16_t*)(ws + OFF_WIN))[(l * INCP + INC) * DM + r] = 0;
    }
    {
        {
            const int lane = tid() & 63, wv = blockIdx.x * 4 + (tid() >> 6), nw = gridDim.x * 4;
            float* rsc = (float*)(ws + OFF_RSC);
            for (int row = wv; row < TOK; row += nw) {
                const float4* xs = (const float4*)(p->x + (size_t)row * DM); uint2* xd = (uint2*)(ws + OFF_XB) + (size_t)row * (DM / 4);
                float sacc = 0.f;
#pragma unroll
                for (int i = 0; i < 4; ++i) { float4 v = xs[lane + 64 * i]; sacc += v.x * v.x + v.y * v.y + v.z * v.z + v.w * v.w; uint2 o; o.x = pack2h(v.x, v.y); o.y = pack2h(v.z, v.w); xd[lane + 64 * i] = o; }
#pragma unroll
                for (int o = 1; o < 64; o <<= 1) sacc += __shfl_xor(sacc, o);
                if (lane < 16) rsc[(size_t)row * 16 + lane] = lane == 0 ? sacc : 0.f;
            }
        }
        const float4* ms = (const float4*)p->mem; uint2* md = (uint2*)(ws + OFF_MEMB);
        for (size_t i = gt; i < (size_t)NBATCH * NMEM * DM / 4; i += gn) { float4 v = ms[i]; uint2 o; o.x = pack2(v.x, v.y); o.y = pack2(v.z, v.w); md[i] = o; }
    }
    float* cs = (float*)(ws + OFF_COS); float* sn = (float*)(ws + OFF_SIN);
    for (size_t i = gt; i < (size_t)TOK * 16; i += gn) {
        int tok = (int)(i >> 4), f = (int)(i & 15);
        const float inv = ex2(-(float)f * 0.83048202372184058f);
        const float ang = (float)p->pos[tok] * inv;
        const float c_hi = 0.15915494309189535f, c_lo = 6.4206383e-9f;
        const float rh = ang * c_hi;
        const float re = fmaf(ang, c_hi, -rh) + ang * c_lo;
        float rf = (rh - floorf(rh)) + re;
        cs[i] = __builtin_amdgcn_cosf(rf);
        sn[i] = __builtin_amdgcn_sinf(rf);
    }
}

struct EpiMemKV {
    bf16_t* km; bf16_t* vm; const float* rs; int row0, col0;
    DI void operator()(int rb, int cb, const f32x16& a) const {
        const int lane = tid() & 63, c = lane & 31, h = lane >> 5;
        const int n0 = col0 + cb;
        if (n0 < 1024) {
            const int head = n0 >> 8, d = (n0 & 255) + c;
#pragma unroll
            for (int r = 0; r < 16; ++r) {
                int row = rb + crow(r, h), gr = row0 + row, b = gr >> 8, key = gr & 255;
                km[(((size_t)(b * 4 + head)) * 256 + key) * 256 + d] = f2bf(a[r] * rs[row]);
            }
        } else {
            const int head = (n0 - 1024) >> 8, d = ((n0 - 1024) & 255) + c;
#pragma unroll
            for (int g = 0; g < 4; ++g) {
                int row = rb + 8 * g + 4 * h, gr = row0 + row, b = gr >> 8, key = gr & 255;
                uint2 pk;
                pk.x = pack2(a[4 * g] * rs[row], a[4 * g + 1] * rs[row + 1]);
                pk.y = pack2(a[4 * g + 2] * rs[row + 2], a[4 * g + 3] * rs[row + 3]);
                *(uint2*)(vm + (((size_t)(b * 4 + head)) * 256 + d) * 256 + key) = pk;
            }
        }
    }
};

struct EpiIn {
    bf16_t *hq, *hkv, *u, *v, *kb; const float *cs, *sn, *rs; int row0, col0;
    DI void operator()(int rb, int cb, const f32x16& a) const {
        const int lane = tid() & 63, c = lane & 31, h = lane >> 5;
        const int nb = col0 + cb;
        if (nb >= INC) return;
        if (nb == 384) {
#pragma unroll
            for (int r = 0; r < 16; ++r) {
                const int row = rb + crow(r, h), tok = row0 + row;
                const float val = a[r] * rs[row];
                float pt = __shfl_xor(val, 16);
                float co = cs[tok * 16 + (c & 15)], si = sn[tok * 16 + (c & 15)];
                float o = (c < 16) ? val * co - pt * si : val * co + pt * si;
                bf16_t ob = f2bf(o);
                const int b = tok >> 13, s = tok & 8191;
                bf16_t* dst = kb + (((size_t)(b * 8)) * SEQ + s) * 96 + 64 + c;
                for (int hd = 0; hd < 8; ++hd) dst[(size_t)hd * SEQ * 96] = ob;
            }
            return;
        }
        bf16_t* dst; int pitch, off; bool act;
        if (nb < 256) { dst = hq; pitch = 256; off = nb; act = false; }
        else if (nb < 384) { dst = hkv; pitch = 128; off = nb - 256; act = false; }
        else if (nb < 928) { dst = u; pitch = 512; off = nb - 416; act = true; }
        else { dst = v; pitch = 512; off = nb - 928; act = true; }
        dst += (size_t)(row0 + rb + 4 * h) * pitch + off + c;
#pragma unroll
        for (int r = 0; r < 16; ++r) {
            const int rr = (r & 3) + 8 * (r >> 2);
            float val = a[r] * rs[rb + rr + 4 * h];
            if (act) val = gelu_tanh(val);
            dst[(size_t)rr * pitch] = f2bf(val);
        }
    }
};

struct EpiQ {
    bf16_t* q; const float *cs, *sn, *rs; int row0, col0;
    DI void operator()(int rb, int cb, const f32x16& a) const {
        const int lane = tid() & 63, c = lane & 31, h = lane >> 5;
        const int n0 = col0 + cb, head = n0 / 96, w0 = n0 - head * 96;
        const float qs = 0.10206207261596575f * LOG2E;
#pragma unroll
        for (int r = 0; r < 16; ++r) {
            const int row = rb + crow(r, h), tok = row0 + row;
            float val = a[r] * rs[row] * qs;
            if (w0 == 64) {
                float pt = __shfl_xor(val, 16);
                float co = cs[tok * 16 + (c & 15)], si = sn[tok * 16 + (c & 15)];
                val = (c < 16) ? val * co - pt * si : val * co + pt * si;
            }
            const int b = tok >> 13, s = tok & 8191;
            q[(((size_t)(b * 8 + head)) * SEQ + s) * 96 + w0 + c] = f2bf(val);
        }
    }
};

struct EpiKV {
    bf16_t *kb, *vstage; const float* rs; int row0, col0;
    DI void operator()(int rb, int cb, const f32x16& a) const {
        const int lane = tid() & 63, c = lane & 31, h = lane >> 5;
        const int n0 = col0 + cb, head = n0 >> 7, w0 = n0 & 127;
        if (w0 < 64) {
#pragma unroll
            for (int r = 0; r < 16; ++r) {
                const int row = rb + crow(r, h), tok = row0 + row, b = tok >> 13, s = tok & 8191;
                kb[(((size_t)(b * 8 + head)) * SEQ + s) * 96 + w0 + c] = f2bf(a[r] * rs[row]);
            }
        } else {
            const int d = w0 - 64 + c;
#pragma unroll
            for (int g = 0; g < 4; ++g) {
                const int row = rb + 8 * g + 4 * h;
                uint2 pk;
                pk.x = pack2(a[4 * g] * rs[row], a[4 * g + 1] * rs[row + 1]);
                pk.y = pack2(a[4 * g + 2] * rs[row + 2], a[4 * g + 3] * rs[row + 3]);
                *(uint2*)(vstage + d * 136 + row) = pk;
            }
        }
    }
};

struct EpiRes {
    bf16_t* xb; int row0, col0; bool dry;
    DI void operator()(int rb, int cb, const f32x16& a, f32x16& sq) const {
        const int lane = tid() & 63, c = lane & 31, h = lane >> 5;
        if (dry && a[0] != 1.2345e30f) return;
        bf16_t* ptr = xb + (size_t)(row0 + rb + 4 * h) * DM + col0 + cb + c;
#pragma unroll
        for (int r = 0; r < 16; ++r) {
            const int rr = (r & 3) + 8 * (r >> 2);
            const bf16_t nb = f2h(h2f(ptr[(size_t)rr * DM]) + a[r]);
            ptr[(size_t)rr * DM] = nb;
            const float nv = h2f(nb);
            sq[r] += nv * nv;
        }
    }
};

struct EpiQm {
    bf16_t* qm; const float* rs; int row0, col0;
    DI void operator()(int rb, int cb, const f32x16& a) const {
        const int lane = tid() & 63, c = lane & 31, h = lane >> 5;
#pragma unroll
        for (int r = 0; r < 16; ++r) {
            const int row = rb + crow(r, h);
            qm[(size_t)(row0 + row) * DM + col0 + cb + c] = f2bf(a[r] * rs[row] * (0.0625f * LOG2E));
        }
    }
};

template <int DQK, int DV, int NBUF, bool QREG, int QW, int LDQ, int LDK, int LDV, int LDO>
DI void flash_item(const bf16_t* __restrict__ Qp, const bf16_t* __restrict__ Kp, const bf16_t* __restrict__ Vtp, int nkt,
                   bf16_t* __restrict__ Op, char* smem, float& ssq) {
    constexpr int KP = DQK + 8;
    constexpr int VP = 72;
    constexpr int CPR = DQK / 8;
    constexpr int KCH = 64 * CPR / 256;
    constexpr int VCH = DV * 8 / 256;
    constexpr int NKS = DQK / 16, NMT = DV / 32 / QW;
    constexpr bool KROWS = (256 % CPR) == 0;
    static_assert(KROWS || LDK == DQK, "K tile addressing");
    static_assert(KCH <= 8 && VCH <= 8, "staging regs");
    static_assert(NBUF == 2 ? (KCH <= 4 && VCH <= 2) : (KCH == 8 && VCH == 8), "staging");
    bf16_t* Ks = (bf16_t*)smem;
    bf16_t* Vs = Ks + NBUF * 64 * KP;
    const int t = tid(), lane = t & 63, w = __builtin_amdgcn_readfirstlane(t >> 6), l32 = lane & 31, h = lane >> 5;
    const int q = (w / QW) * 32 + l32, dv0 = (w % QW) * (DV / QW);
    const unsigned ktoff = KROWS ? (unsigned)((t / CPR) * LDK + (t % CPR) * 8) : (unsigned)(t * 8);
    const unsigned vtoff = (unsigned)((t >> 3) * LDV + (t & 7) * 8);

    bf16x8 qf[QREG ? NKS : 1];
    if constexpr (QREG) {
#pragma unroll
        for (int ks = 0; ks < NKS; ++ks) qf[ks] = *(const bf16x8*)(Qp + (size_t)q * LDQ + ks * 16 + 8 * h);
    }
    f32x16 o[NMT];
#pragma unroll
    for (int mt = 0; mt < NMT; ++mt)
#pragma unroll
        for (int r = 0; r < 16; ++r) o[mt][r] = 0.f;
    float m = -INFINITY, lsum = 0.f;

    uint4 rk0, rk1, rk2, rk3, rk4, rk5, rk6, rk7, rv0, rv1;
    (void)rk0; (void)rk1; (void)rk2; (void)rk3; (void)rk4; (void)rk5; (void)rk6; (void)rk7; (void)rv0; (void)rv1;
#define LKJ(kt, i, R) { const bf16_t* kb_ = KROWS ? Kp + (size_t)((kt) * 64 + (i) * (256 / CPR)) * LDK : Kp + (size_t)(kt) * 64 * DQK + (i) * 2048; R = *(const uint4*)(kb_ + ktoff); }
#define SKJ(buf, i, R) { int c = t + 256 * (i), row = c / CPR, cc = c - row * CPR; *(uint4*)(Ks + (buf) * 64 * KP + swap23(row) * KP + cc * 8) = R; }
#define LVJ(kt, i, R) { const bf16_t* vb_ = Vtp + (size_t)(i) * 32 * LDV + (kt) * 64; R = *(const uint4*)(vb_ + vtoff); }
#define SVJ(buf, i, R) { int c = t + 256 * (i), d = c >> 3, cc = c & 7; *(uint4*)(Vs + (buf) * DV * VP + d * VP + cc * 8) = R; }
#define ATT_LOAD(kt) { LKJ(kt, 0, rk0) if constexpr (KCH > 1) LKJ(kt, 1, rk1) if constexpr (KCH > 2) LKJ(kt, 2, rk2) if constexpr (KCH > 3) LKJ(kt, 3, rk3) LVJ(kt, 0, rv0) if constexpr (VCH > 1) LVJ(kt, 1, rv1) }
#define ATT_STORE(buf) { SKJ(buf, 0, rk0) if constexpr (KCH > 1) SKJ(buf, 1, rk1) if constexpr (KCH > 2) SKJ(buf, 2, rk2) if constexpr (KCH > 3) SKJ(buf, 3, rk3) SVJ(buf, 0, rv0) if constexpr (VCH > 1) SVJ(buf, 1, rv1) }

    __syncthreads();
    if constexpr (NBUF == 2) ATT_LOAD(0);
    for (int kt = 0; kt < nkt; ++kt) {
        const int buf = (NBUF == 2) ? (kt & 1) : 0;
        if constexpr (NBUF == 1) {
            __syncthreads();
            LKJ(kt, 0, rk0) LKJ(kt, 1, rk1) LKJ(kt, 2, rk2) LKJ(kt, 3, rk3)
            LKJ(kt, 4, rk4) LKJ(kt, 5, rk5) LKJ(kt, 6, rk6) LKJ(kt, 7, rk7)
            SKJ(0, 0, rk0) SKJ(0, 1, rk1) SKJ(0, 2, rk2) SKJ(0, 3, rk3)
            asm volatile("" ::: "memory");
            LVJ(kt, 0, rk0) LVJ(kt, 1, rk1) LVJ(kt, 2, rk2) LVJ(kt, 3, rk3)
            SKJ(0, 4, rk4) SKJ(0, 5, rk5) SKJ(0, 6, rk6) SKJ(0, 7, rk7)
            asm volatile("" ::: "memory");
            LVJ(kt, 4, rk4) LVJ(kt, 5, rk5) LVJ(kt, 6, rk6) LVJ(kt, 7, rk7)
            SVJ(0, 0, rk0) SVJ(0, 1, rk1) SVJ(0, 2, rk2) SVJ(0, 3, rk3)
            asm volatile("" ::: "memory");
            SVJ(0, 4, rk4) SVJ(0, 5, rk5) SVJ(0, 6, rk6) SVJ(0, 7, rk7)
        } else { ATT_STORE(buf); }
        __syncthreads();
        if constexpr (NBUF == 2) { if (kt + 1 < nkt) ATT_LOAD(kt + 1); }

        const bf16_t* kb = Ks + buf * 64 * KP + l32 * KP + 8 * h;
        f32x16 s0, s1;
#pragma unroll
        for (int r = 0; r < 16; ++r) { s0[r] = 0.f; s1[r] = 0.f; }
#pragma unroll
        for (int ks = 0; ks < NKS; ++ks) {
            bf16x8 qq;
            if constexpr (QREG) qq = qf[ks]; else qq = *(const bf16x8*)(Qp + (size_t)q * LDQ + ks * 16 + 8 * h);
            bf16x8 k0 = *(const bf16x8*)(kb + ks * 16);
            bf16x8 k1 = *(const bf16x8*)(kb + 32 * KP + ks * 16);
            s0 = MFMA(k0, qq, s0);
            s1 = MFMA(k1, qq, s1);
        }
        float mx = s0[0];
#pragma unroll
        for (int r = 1; r < 16; ++r) mx = fmaxf(mx, s0[r]);
#pragma unroll
        for (int r = 0; r < 16; ++r) mx = fmaxf(mx, s1[r]);
        mx = fmaxf(mx, __shfl_xor(mx, 32));
        const float mn = fmaxf(m, mx);
        const float alpha = ex2(m - mn);
        m = mn;
        float psum = 0.f;
#pragma unroll
        for (int r = 0; r < 16; ++r) { s0[r] = ex2(s0[r] - mn); psum += s0[r]; }
#pragma unroll
        for (int r = 0; r < 16; ++r) { s1[r] = ex2(s1[r] - mn); psum += s1[r]; }
        lsum = lsum * alpha + psum;
        if (__builtin_amdgcn_ballot_w64(alpha != 1.f) != 0ull) {
#pragma unroll
            for (int mt = 0; mt < NMT; ++mt)
#pragma unroll
                for (int r = 0; r < 16; ++r) o[mt][r] *= alpha;
        }
        const bf16_t* vb = Vs + buf * DV * VP + (dv0 + l32) * VP + 8 * h;
#pragma unroll
        for (int t2 = 0; t2 < 2; ++t2)
#pragma unroll
            for (int s2 = 0; s2 < 2; ++s2) {
                u32x4 pu;
#pragma unroll
                for (int j = 0; j < 4; ++j)
                    pu[j] = t2 ? pack2(s1[8 * s2 + 2 * j], s1[8 * s2 + 2 * j + 1]) : pack2(s0[8 * s2 + 2 * j], s0[8 * s2 + 2 * j + 1]);
                const bf16x8 pfv = __builtin_bit_cast(bf16x8, pu);
#pragma unroll
                for (int mt = 0; mt < NMT; ++mt) {
                    bf16x8 vv = *(const bf16x8*)(vb + mt * 32 * VP + t2 * 32 + s2 * 16);
                    o[mt] = MFMA(vv, pfv, o[mt]);
                }
            }
    }
#undef ATT_LOAD
#undef ATT_STORE
#undef LKJ
#undef SKJ
#undef LVJ
#undef SVJ
    const float inv = 1.f / (lsum + __shfl_xor(lsum, 32));
#pragma unroll
    for (int mt = 0; mt < NMT; ++mt)
#pragma unroll
        for (int g = 0; g < 4; ++g) {
            float v0 = o[mt][4 * g] * inv, v1 = o[mt][4 * g + 1] * inv, v2 = o[mt][4 * g + 2] * inv, v3 = o[mt][4 * g + 3] * inv;
            uint2 pk; pk.x = pack2(v0, v1); pk.y = pack2(v2, v3);
            float r0 = bflo(pk.x), r1 = bfhi(pk.x), r2 = bflo(pk.y), r3 = bfhi(pk.y);
            ssq += r0 * r0 + r1 * r1 + r2 * r2 + r3 * r3;
            *(uint2*)(Op + (size_t)q * LDO + dv0 + mt * 32 + 8 * g + 4 * h) = pk;
        }
}

DI void flash_mla2(const bf16_t* __restrict__ Qp, const bf16_t* __restrict__ Kp, const bf16_t* __restrict__ Vtp,
                   bf16_t* __restrict__ Op, char* smem, float& ssq) {
    constexpr int DQK = 96, DV = 64, LDQ = 96, LDV = SEQ, LDO = DM, NKT = SEQ / 64;
    constexpr int KP = DQK + 8, VP = 72, CPR = DQK / 8, NKS = DQK / 16, NMT = DV / 32;
    bf16_t* Ks = (bf16_t*)smem;
    bf16_t* Vs = Ks + 2 * 64 * KP;
    const int t = tid(), lane = t & 63, w = __builtin_amdgcn_readfirstlane(t >> 6), l32 = lane & 31, h = lane >> 5;
    const int q = w * 32 + l32;
    const unsigned ktoff = (unsigned)(t * 8);
    const unsigned vtoff = (unsigned)((t >> 3) * LDV + (t & 7) * 8);
    bf16x8 qf[NKS];
#pragma unroll
    for (int ks = 0; ks < NKS; ++ks) qf[ks] = *(const bf16x8*)(Qp + (size_t)q * LDQ + ks * 16 + 8 * h);
    f32x16 o[NMT];
#pragma unroll
    for (int mt = 0; mt < NMT; ++mt)
#pragma unroll
        for (int r = 0; r < 16; ++r) o[mt][r] = 0.f;
    float m = 0.f, lsum = 0.f;
    uint4 ak0, ak1, ak2, av0, av1, bk0, bk1, bk2, bv0, bv1;
#define M2_LOAD(S, kt) { const bf16_t* kb_ = Kp + (size_t)(kt) * 64 * DQK; S##k0 = *(const uint4*)(kb_ + ktoff); S##k1 = *(const uint4*)(kb_ + 2048 + ktoff); S##k2 = *(const uint4*)(kb_ + 4096 + ktoff); \
        const bf16_t* vb_ = Vtp + (kt) * 64; S##v0 = *(const uint4*)(vb_ + vtoff); S##v1 = *(const uint4*)(vb_ + (size_t)32 * LDV + vtoff); }
#define M2_SK(i, R, buf) { int c = t + 256 * (i), row = c / CPR, cc = c - row * CPR; *(uint4*)(Ks + (buf) * 64 * KP + swap23(row) * KP + cc * 8) = R; }
#define M2_SV(i, R, buf) { int c = t + 256 * (i), d = c >> 3, cc = c & 7; *(uint4*)(Vs + (buf) * DV * VP + d * VP + cc * 8) = R; }
#define M2_STORE(S, buf) { M2_SK(0, S##k0, buf) M2_SK(1, S##k1, buf) M2_SK(2, S##k2, buf) M2_SV(0, S##v0, buf) M2_SV(1, S##v1, buf) }
#define M2_COMPUTE(buf) { \
        if (__builtin_amdgcn_ballot_w64(alpha != 1.f) != 0ull) { \
            _Pragma("unroll") for (int mt = 0; mt < NMT; ++mt) _Pragma("unroll") for (int r = 0; r < 16; ++r) o[mt][r] *= alpha; } \
        lsum *= alpha; \
        const bf16_t* kb = Ks + (buf) * 64 * KP + l32 * KP + 8 * h; \
        f32x16 s0, s1; \
        const float nm = -m; \
        _Pragma("unroll") for (int r = 0; r < 16; ++r) { s0[r] = nm; s1[r] = nm; } \
        _Pragma("unroll") for (int ks = 0; ks < NKS; ++ks) { bf16x8 k0 = *(const bf16x8*)(kb + ks * 16); bf16x8 k1 = *(const bf16x8*)(kb + 32 * KP + ks * 16); s0 = MFMA(k0, qf[ks], s0); s1 = MFMA(k1, qf[ks], s1); } \
        float mx = s0[0]; \
        _Pragma("unroll") for (int r = 1; r < 16; ++r) mx = fmaxf(mx, s0[r]); \
        _Pragma("unroll") for (int r = 0; r < 16; ++r) mx = fmaxf(mx, s1[r]); \
        mx = fmaxf(mx, __shfl_xor(mx, 32)); \
        float psum = 0.f; \
        _Pragma("unroll") for (int r = 0; r < 16; ++r) { s0[r] = ex2(s0[r]); psum += s0[r]; } \
        _Pragma("unroll") for (int r = 0; r < 16; ++r) { s1[r] = ex2(s1[r]); psum += s1[r]; } \
        lsum += psum; \
        const float dgrow = fmaxf(mx, 0.f); alpha = ex2(-dgrow); m += dgrow; \
        const bf16_t* vb = Vs + (buf) * DV * VP + l32 * VP + 8 * h; \
        _Pragma("unroll") for (int s2 = 0; s2 < 2; ++s2) { \
            u32x4 pu0, pu1; \
            _Pragma("unroll") for (int j = 0; j < 4; ++j) { pu0[j] = pack2(s0[8 * s2 + 2 * j], s0[8 * s2 + 2 * j + 1]); pu1[j] = pack2(s1[8 * s2 + 2 * j], s1[8 * s2 + 2 * j + 1]); } \
            const bf16x8 pf0 = __builtin_bit_cast(bf16x8, pu0), pf1 = __builtin_bit_cast(bf16x8, pu1); \
            _Pragma("unroll") for (int mt = 0; mt < NMT; ++mt) { \
                bf16x8 v0 = *(const bf16x8*)(vb + mt * 32 * VP + s2 * 16); bf16x8 v1 = *(const bf16x8*)(vb + mt * 32 * VP + 32 + s2 * 16); \
                o[mt] = MFMA(v0, pf0, o[mt]); o[mt] = MFMA(v1, pf1, o[mt]); } } }

    float alpha = 1.f;
    __syncthreads();
    M2_LOAD(a, 0);
    M2_LOAD(b, 1);
    {
        M2_STORE(a, 0);
        __syncthreads();
        const bf16_t* kb = Ks + l32 * KP + 8 * h;
        f32x16 s0, s1;
#pragma unroll
        for (int r = 0; r < 16; ++r) { s0[r] = 0.f; s1[r] = 0.f; }
#pragma unroll
        for (int ks = 0; ks < NKS; ++ks) { bf16x8 k0 = *(const bf16x8*)(kb + ks * 16); bf16x8 k1 = *(const bf16x8*)(kb + 32 * KP + ks * 16); s0 = MFMA(k0, qf[ks], s0); s1 = MFMA(k1, qf[ks], s1); }
        float mx = s0[0];
#pragma unroll
        for (int r = 1; r < 16; ++r) mx = fmaxf(mx, s0[r]);
#pragma unroll
        for (int r = 0; r < 16; ++r) mx = fmaxf(mx, s1[r]);
        m = fmaxf(mx, __shfl_xor(mx, 32));
        __syncthreads();
    }
    for (int kt = 0; kt < NKT; kt += 2) {
        M2_STORE(a, 0);
        __syncthreads();
        M2_LOAD(a, min(kt + 2, NKT - 1));
        M2_COMPUTE(0);
        M2_STORE(b, 1);
        __syncthreads();
        M2_LOAD(b, min(kt + 3, NKT - 1));
        M2_COMPUTE(1);
    }
#undef M2_LOAD
#undef M2_SK
#undef M2_SV
#undef M2_STORE
#undef M2_COMPUTE
    const float inv = 1.f / (lsum + __shfl_xor(lsum, 32));
#pragma unroll
    for (int mt = 0; mt < NMT; ++mt)
#pragma unroll
        for (int g = 0; g < 4; ++g) {
            float v0 = o[mt][4 * g] * inv, v1 = o[mt][4 * g + 1] * inv, v2 = o[mt][4 * g + 2] * inv, v3 = o[mt][4 * g + 3] * inv;
            uint2 pk; pk.x = pack2(v0, v1); pk.y = pack2(v2, v3);
            float r0 = bflo(pk.x), r1 = bfhi(pk.x), r2 = bflo(pk.y), r3 = bfhi(pk.y);
            ssq += r0 * r0 + r1 * r1 + r2 * r2 + r3 * r3;
            *(uint2*)(Op + (size_t)q * LDO + mt * 32 + 8 * g + 4 * h) = pk;
        }
}

DI void mla_item(KP p, int item, char* smem) {
    const int b = item >> 6, qb = item & 63;
    const bf16_t* Q = (const bf16_t*)(p->ws + OFF_Q);
    const bf16_t* K = (const bf16_t*)(p->ws + OFF_K);
    const bf16_t* Vt = (const bf16_t*)(p->ws + OFF_VT);
    bf16_t* om = (bf16_t*)(p->ws + OFF_OMIX) + ((size_t)b * SEQ + qb * 128) * DM;
    float ssq = 0.f;
    for (int hd = 0; hd < 8; ++hd) {
        const size_t bh = (size_t)(b * 8 + hd);
        flash_mla2(Q + (bh * SEQ + qb * 128) * 96, K + bh * SEQ * 96, Vt + bh * 64 * SEQ, om + hd * 64, smem, ssq);
    }
    ssq += __shfl_xor(ssq, 32);
    const float sc = rsqrtf(ssq * (1.f / 512.f) + EPS);
    const int lane = tid() & 63, w = tid() >> 6, q = w * 32 + (lane & 31), h = lane >> 5;
    for (int i = 0; i < 64; ++i) {
        uint2* ptr = (uint2*)(om + (size_t)q * DM + (i >> 3) * 64 + ((i >> 2) & 1) * 32 + (i & 3) * 8 + 4 * h);
        uint2 v = *ptr;
        v.x = pack2(bflo(v.x) * sc, bfhi(v.x) * sc);
        v.y = pack2(bflo(v.y) * sc, bfhi(v.y) * sc);
        *ptr = v;
    }
}

DI void memattn_item(KP p, int l, int item, char* smem) {
    const int head = item & 3, qt = (item >> 2) & 127, b = item >> 9;
    const bf16_t* qm = (const bf16_t*)(p->ws + OFF_QM) + ((size_t)b * SEQ + qt * 64) * DM + head * 256;
    const bf16_t* km = (const bf16_t*)(p->ws + OFF_KMEM) + ((size_t)((l * NBATCH + b) * 4 + head)) * 256 * 256;
    const bf16_t* vm = (const bf16_t*)(p->ws + OFF_VMEM) + ((size_t)((l * NBATCH + b) * 4 + head)) * 256 * 256;
    bf16_t* om = (bf16_t*)(p->ws + OFF_OMEM) + ((size_t)b * SEQ + qt * 64) * DM + head * 256;
    float dummy = 0.f;
    flash_item<256, 256, 1, true, 2, DM, 256, 256, DM>(qm, km, vm, 4, om, smem, dummy);
}

DI void gmlp_item(KP p, int l, int ci, char* smem) {
    constexpr int AP = 136;
    bf16_t* As = (bf16_t*)smem;
    bf16_t* Bs = As + 128 * AP;
    float* st = (float*)(Bs + 64 * AP);
    const int t = tid(), lane = t & 63, w = __builtin_amdgcn_readfirstlane(t >> 6), l32 = lane & 31, h = lane >> 5;
    const int tok0 = ci * 128;
    const bf16_t* vbuf = (const bf16_t*)(p->ws + OFF_V) + (size_t)tok0 * 512;
    const bf16_t* ubuf = (const bf16_t*)(p->ws + OFF_U) + (size_t)(tok0 + w * 32) * 512;
    bf16_t* om = (bf16_t*)(p->ws + OFF_OMIX) + (size_t)(tok0 + w * 32) * DM + 512;
    const bf16_t* wsg = (const bf16_t*)(p->ws + OFF_WSG) + (size_t)l * 8 * 128 * 128;
    const float* lng = p->sg_ln_g + l * 512; const float* lnb = p->sg_ln_b + l * 512;
    const float* bs = p->sg_b_s + l * 8 * 128 + w * 32;
    __syncthreads();
    {
        const int row = t >> 1, half = t & 1;
        const uint4* src = (const uint4*)(vbuf + (size_t)row * 512 + half * 256);
        float s = 0.f, s2 = 0.f;
#pragma unroll 4
        for (int i = 0; i < 32; ++i) {
            uint4 qv = src[i];
            float a0 = bflo(qv.x), a1 = bfhi(qv.x), a2 = bflo(qv.y), a3 = bfhi(qv.y), a4 = bflo(qv.z), a5 = bfhi(qv.z), a6 = bflo(qv.w), a7 = bfhi(qv.w);
            s += a0 + a1 + a2 + a3 + a4 + a5 + a6 + a7;
            s2 += a0 * a0 + a1 * a1 + a2 * a2 + a3 * a3 + a4 * a4 + a5 * a5 + a6 * a6 + a7 * a7;
        }
        s += __shfl_xor(s, 1); s2 += __shfl_xor(s2, 1);
        const float mean = s * (1.f / 512.f);
        const float var = fmaxf(s2 * (1.f / 512.f) - mean * mean, 0.f);
        if (half == 0) { st[2 * row] = mean; st[2 * row + 1] = rsqrtf(var + EPS); }
    }
    __syncthreads();
    float rq0 = 0.f, rq1 = 0.f, rq2 = 0.f, rq3 = 0.f;
    const bf16_t* ub0 = (const bf16_t*)(p->ws + OFF_U) + (size_t)tok0 * 512;
    bf16_t* om0 = (bf16_t*)(p->ws + OFF_OMIX) + (size_t)tok0 * DM + 512;
    const unsigned wtoff = (unsigned)((t >> 4) * 128 + (t & 15) * 8);
    const unsigned vtoff = (unsigned)((t >> 3) * 512 + (t & 7) * 8);
    const unsigned eoff_u = (unsigned)(4 * h * 512 + l32), eoff_o = (unsigned)(4 * h * DM + l32);
    for (int hd = 0; hd < 8; ++hd) {
        const bf16_t* wh = wsg + (size_t)hd * 128 * 128;
#pragma unroll
        for (int i = 0; i < 8; ++i)
            *(uint4*)(As + ((t >> 4) + 16 * i) * AP + (t & 15) * 8) = *(const uint4*)(wh + i * 16 * 128 + wtoff);
#pragma unroll
        for (int i = 0; i < 4; ++i) {
            const int j = (t >> 3) + 32 * i, c8 = t & 7;
            uint4 qv = *(const uint4*)(vbuf + (size_t)i * 32 * 512 + hd * 64 + vtoff);
            const float mean = st[2 * j], rstd = st[2 * j + 1];
            const int ch = hd * 64 + c8 * 8;
            const float4 g0 = *(const float4*)(lng + ch), g1 = *(const float4*)(lng + ch + 4);
            const float4 b0 = *(const float4*)(lnb + ch), b1 = *(const float4*)(lnb + ch + 4);
            bf16_t* bd = Bs + (c8 * 8) * AP + j;
            bd[0 * AP] = f2bf((bflo(qv.x) - mean) * rstd * g0.x + b0.x);
            bd[1 * AP] = f2bf((bfhi(qv.x) - mean) * rstd * g0.y + b0.y);
            bd[2 * AP] = f2bf((bflo(qv.y) - mean) * rstd * g0.z + b0.z);
            bd[3 * AP] = f2bf((bfhi(qv.y) - mean) * rstd * g0.w + b0.w);
            bd[4 * AP] = f2bf((bflo(qv.z) - mean) * rstd * g1.x + b1.x);
            bd[5 * AP] = f2bf((bfhi(qv.z) - mean) * rstd * g1.y + b1.y);
            bd[6 * AP] = f2bf((bflo(qv.w) - mean) * rstd * g1.z + b1.z);
            bd[7 * AP] = f2bf((bfhi(qv.w) - mean) * rstd * g1.w + b1.w);
        }
        __syncthreads();
        f32x16 acc[2];
#pragma unroll
        for (int r = 0; r < 16; ++r) { acc[0][r] = 0.f; acc[1][r] = 0.f; }
        const bf16_t* a_s = As + (w * 32 + l32) * AP + 8 * h;
        const bf16_t* b_s = Bs + l32 * AP + 8 * h;
#pragma unroll
        for (int ks = 0; ks < 8; ++ks) {
            bf16x8 a = *(const bf16x8*)(a_s + ks * 16);
            bf16x8 b0 = *(const bf16x8*)(b_s + ks * 16);
            bf16x8 b1 = *(const bf16x8*)(b_s + 32 * AP + ks * 16);
            acc[0] = MFMA(a, b0, acc[0]);
            acc[1] = MFMA(a, b1, acc[1]);
        }
        __syncthreads();
        float* stgf = (float*)As;
#pragma unroll
        for (int j2 = 0; j2 < 2; ++j2)
#pragma unroll
            for (int r = 0; r < 16; ++r) {
                const int rr = (r & 3) + 8 * (r >> 2);
                stgf[(w * 32 + rr + 4 * h) * 68 + j2 * 32 + l32] = acc[j2][r] + (bs + hd * 128 + rr)[4 * h];
            }
        __syncthreads();
#pragma unroll
        for (int i = 0; i < 4; ++i) {
            const int row = (t >> 3) + 32 * i, c8 = t & 7;
            const float4 lo = *(const float4*)(stgf + row * 68 + c8 * 8), hi = *(const float4*)(stgf + row * 68 + c8 * 8 + 4);
            const uint4 uv = *(const uint4*)(ub0 + (size_t)row * 512 + hd * 64 + c8 * 8);
            uint4 ov;
            ov.x = pack2(bflo(uv.x) * lo.x, bfhi(uv.x) * lo.y); ov.y = pack2(bflo(uv.y) * lo.z, bfhi(uv.y) * lo.w);
            ov.z = pack2(bflo(uv.z) * hi.x, bfhi(uv.z) * hi.y); ov.w = pack2(bflo(uv.w) * hi.z, bfhi(uv.w) * hi.w);
            *(uint4*)(om0 + (size_t)row * DM + hd * 64 + c8 * 8) = ov;
            const float q0 = bflo(ov.x), q1 = bfhi(ov.x), q2 = bflo(ov.y), q3 = bfhi(ov.y), q4 = bflo(ov.z), q5 = bfhi(ov.z), q6 = bflo(ov.w), q7 = bfhi(ov.w);
            const float sqp = q0 * q0 + q1 * q1 + q2 * q2 + q3 * q3 + q4 * q4 + q5 * q5 + q6 * q6 + q7 * q7;
            if (i == 0) rq0 += sqp; else if (i == 1) rq1 += sqp; else if (i == 2) rq2 += sqp; else rq3 += sqp;
        }
        __syncthreads();
    }
#define GM_FIN(RQ, i) { float s_ = RQ; s_ += __shfl_xor(s_, 1); s_ += __shfl_xor(s_, 2); s_ += __shfl_xor(s_, 4); const float sc_ = rsqrtf(s_ * (1.f / 512.f) + EPS); \
        const int row = (t >> 3) + 32 * (i), c8 = t & 7; \
        for (int hd = 0; hd < 8; ++hd) { uint4* ptr = (uint4*)(om0 + (size_t)row * DM + hd * 64 + c8 * 8); uint4 v = *ptr; \
            v.x = pack2(bflo(v.x) * sc_, bfhi(v.x) * sc_); v.y = pack2(bflo(v.y) * sc_, bfhi(v.y) * sc_); v.z = pack2(bflo(v.z) * sc_, bfhi(v.z) * sc_); v.w = pack2(bflo(v.w) * sc_, bfhi(v.w) * sc_); *ptr = v; } }
    GM_FIN(rq0, 0) GM_FIN(rq1, 1) GM_FIN(rq2, 2) GM_FIN(rq3, 3)
#undef GM_FIN
}

DI void ph_memkv(KP p, char* smem) {
    for_tiles(DEPTH * 16 * 16, [&](int t) __attribute__((always_inline)) {
        const int l = t >> 8, rt = (t >> 4) & 15, ct = t & 15;
        f32x16 acc[2][2];
        gemm_tile<1>((const bf16_t*)(p->ws + OFF_MEMB), DM, rt * 128, 0, NBATCH * NMEM, (const bf16_t*)(p->ws + OFF_WMKV) + ((size_t)l * 2048 + ct * 128) * DM, DM, DM, smem, acc);
        EpiMemKV e{(bf16_t*)(p->ws + OFF_KMEM) + (size_t)l * NBATCH * 4 * 256 * 256, (bf16_t*)(p->ws + OFF_VMEM) + (size_t)l * NBATCH * 4 * 256 * 256,
                   (const float*)(smem + RS_OFF), rt * 128, ct * 128};
        run_epi(acc, e);
    });
}
DI float* stage_tile(const f32x16 (&acc)[2][2], const float* rs, char* smem) {
    const int tt = tid(), lane = tt & 63, w = __builtin_amdgcn_readfirstlane(tt >> 6), wm = w >> 1, wn = w & 1, l32 = lane & 31, h = lane >> 5;
    float* stg = (float*)smem;
#pragma unroll
    for (int i = 0; i < 2; ++i)
#pragma unroll
        for (int j = 0; j < 2; ++j)
#pragma unroll
            for (int r = 0; r < 16; ++r) {
                const int row = wm * 64 + i * 32 + crow(r, h);
                stg[row * 132 + wn * 64 + j * 32 + l32] = rs ? acc[i][j][r] * rs[row] : acc[i][j][r];
            }
    __syncthreads();
    return stg;
}
DI uint4 pack8(const float4& a, const float4& b) { uint4 o; o.x = pack2(a.x, a.y); o.y = pack2(a.z, a.w); o.z = pack2(b.x, b.y); o.w = pack2(b.z, b.w); return o; }
DI float4 gelu4(const float4& a) { float4 o; o.x = gelu_tanh(a.x); o.y = gelu_tanh(a.y); o.z = gelu_tanh(a.z); o.w = gelu_tanh(a.w); return o; }
DI void rope8(float4& lo, float4& hi, const float4& plo, const float4& phi, const float* cs, const float* sn, int c) {
    const float4 c0 = *(const float4*)(cs + (c & 15)), c1 = *(const float4*)(cs + (c & 15) + 4);
    const float4 s0 = *(const float4*)(sn + (c & 15)), s1 = *(const float4*)(sn + (c & 15) + 4);
    const float sg = c < 16 ? -1.f : 1.f;
    lo.x = lo.x * c0.x + sg * plo.x * s0.x; lo.y = lo.y * c0.y + sg * plo.y * s0.y; lo.z = lo.z * c0.z + sg * plo.z * s0.z; lo.w = lo.w * c0.w + sg * plo.w * s0.w;
    hi.x = hi.x * c1.x + sg * phi.x * s1.x; hi.y = hi.y * c1.y + sg * phi.y * s1.y; hi.z = hi.z * c1.z + sg * phi.z * s1.z; hi.w = hi.w * c1.w + sg * phi.w * s1.w;
}

DI void ph_in(KP p, int l, const float* xin, char* smem) {
    for_tiles(512 * 12, [&](int t) __attribute__((always_inline)) {
        int rt, ct; tile_rc(t, 12, rt, ct);
        f32x16 acc[2][2];
        const float rsp = rs_load(p, rt * 128);
        gemm_tile<0, true>((const bf16_t*)(p->ws + OFF_XB), DM, rt * 128, 0, TOK, (const bf16_t*)(p->ws + OFF_WIN) + ((size_t)l * INCP + ct * 128) * DM, DM, DM, smem, acc);
        rs_finish(rsp, rt * 128, smem);
        const float* stg = stage_tile(acc, (const float*)(smem + RS_OFF), smem);
        const int tt = tid(), c8 = tt & 15, nb = ct * 128 + c8 * 8;
        if (nb < INC) {
#pragma unroll
            for (int i = 0; i < 8; ++i) {
                const int row = (tt >> 4) + 16 * i, tok = rt * 128 + row;
                float4 lo = *(const float4*)(stg + row * 132 + c8 * 8), hi = *(const float4*)(stg + row * 132 + c8 * 8 + 4);
                if (nb < 256) *(uint4*)((bf16_t*)(p->ws + OFF_HQ) + (size_t)tok * 256 + nb) = pack8(lo, hi);
                else if (nb < 384) *(uint4*)((bf16_t*)(p->ws + OFF_HKV) + (size_t)tok * 128 + (nb - 256)) = pack8(lo, hi);
                else if (nb < 416) {
                    const int c = nb - 384, pc = c8 * 8 + (c < 16 ? 16 : -16);
                    const float4 plo = *(const float4*)(stg + row * 132 + pc), phi = *(const float4*)(stg + row * 132 + pc + 4);
                    rope8(lo, hi, plo, phi, (const float*)(p->ws + OFF_COS) + (size_t)tok * 16, (const float*)(p->ws + OFF_SIN) + (size_t)tok * 16, c);
                    const uint4 ov = pack8(lo, hi);
                    const int b = tok >> 13, sx = tok & 8191;
                    bf16_t* dst = (bf16_t*)(p->ws + OFF_K) + (((size_t)(b * 8)) * SEQ + sx) * 96 + 64 + c;
#pragma unroll
                    for (int hd = 0; hd < 8; ++hd) *(uint4*)(dst + (size_t)hd * SEQ * 96) = ov;
                } else if (nb < 928) *(uint4*)((bf16_t*)(p->ws + OFF_U) + (size_t)tok * 512 + (nb - 416)) = pack8(gelu4(lo), gelu4(hi));
                else *(uint4*)((bf16_t*)(p->ws + OFF_V) + (size_t)tok * 512 + (nb - 928)) = pack8(gelu4(lo), gelu4(hi));
            }
        }
    });
}
DI void ph_qkv(KP p, int l, char* smem) {
    for_tiles(512 * 14, [&](int t) __attribute__((always_inline)) {
        int rt, ct; tile_rc(t, 14, rt, ct);
        f32x16 acc[2][2];
        if (ct < 6) {
            gemm_tile<1>((const bf16_t*)(p->ws + OFF_HQ), QL, rt * 128, 0, TOK, (const bf16_t*)(p->ws + OFF_WUQ) + ((size_t)l * 768 + ct * 128) * QL, QL, QL, smem, acc);
            const float* stg = stage_tile(acc, (const float*)(smem + RS_OFF), smem);
            const int tt = tid(), c8 = tt & 15, n8 = ct * 128 + c8 * 8, head = n8 / 96, w0 = n8 - head * 96;
            const float qs = 0.10206207261596575f * LOG2E;
#pragma unroll
            for (int i = 0; i < 8; ++i) {
                const int row = (tt >> 4) + 16 * i, tok = rt * 128 + row;
                float4 lo = *(const float4*)(stg + row * 132 + c8 * 8), hi = *(const float4*)(stg + row * 132 + c8 * 8 + 4);
                if (w0 >= 64) {
                    const int c = w0 - 64, pc = c8 * 8 + (c < 16 ? 16 : -16);
                    const float4 plo = *(const float4*)(stg + row * 132 + pc), phi = *(const float4*)(stg + row * 132 + pc + 4);
                    rope8(lo, hi, plo, phi, (const float*)(p->ws + OFF_COS) + (size_t)tok * 16, (const float*)(p->ws + OFF_SIN) + (size_t)tok * 16, c);
                }
                lo.x *= qs; lo.y *= qs; lo.z *= qs; lo.w *= qs; hi.x *= qs; hi.y *= qs; hi.z *= qs; hi.w *= qs;
                const int b = tok >> 13, sx = tok & 8191;
                *(uint4*)((bf16_t*)(p->ws + OFF_Q) + (((size_t)(b * 8 + head)) * SEQ + sx) * 96 + w0) = pack8(lo, hi);
            }
        } else {
            const int c2 = ct - 6;
            gemm_tile<1>((const bf16_t*)(p->ws + OFF_HKV), KVL, rt * 128, 0, TOK, (const bf16_t*)(p->ws + OFF_WUKV) + ((size_t)l * 1024 + c2 * 128) * KVL, KVL, KVL, smem, acc);
            const float* stg = stage_tile(acc, (const float*)(smem + RS_OFF), smem);
            const int tt = tid(), tok0 = rt * 128, b = tok0 >> 13, s0 = tok0 & 8191;
            {
                const int c8 = tt & 7;
#pragma unroll
                for (int i = 0; i < 4; ++i) {
                    const int row = (tt >> 3) + 32 * i;
                    const float4 lo = *(const float4*)(stg + row * 132 + c8 * 8), hi = *(const float4*)(stg + row * 132 + c8 * 8 + 4);
                    *(uint4*)((bf16_t*)(p->ws + OFF_K) + (((size_t)(b * 8 + c2)) * SEQ + s0 + row) * 96 + c8 * 8) = pack8(lo, hi);
                }
            }
            {
                const int tc = tt & 15;
#pragma unroll
                for (int i = 0; i < 4; ++i) {
                    const int d = (tt >> 4) + 16 * i;
                    const float* sp = stg + (tc * 8) * 132 + 64 + d;
                    uint4 ov;
                    ov.x = pack2(sp[0], sp[132]); ov.y = pack2(sp[2 * 132], sp[3 * 132]); ov.z = pack2(sp[4 * 132], sp[5 * 132]); ov.w = pack2(sp[6 * 132], sp[7 * 132]);
                    *(uint4*)((bf16_t*)(p->ws + OFF_VT) + (((size_t)(b * 8 + c2)) * 64 + d) * SEQ + s0 + tc * 8) = ov;
                }
            }
        }
    });
}
DI void ph_mix(KP p, int l, char* smem) {
    for_tiles(512, [&](int t) __attribute__((always_inline)) { mla_item(p, t, smem); });
    for_tiles(512, [&](int t) __attribute__((always_inline)) { gmlp_item(p, l, t, smem); });
}
DI void ph_res(KP p, const bf16_t* A, int K, const bf16_t* Wt, const float* xin, char* smem, bool dry) {
    for_tiles(512 * 8, [&](int t) __attribute__((always_inline)) {
        int rt, ct; tile_rc(t, 8, rt, ct);
        f32x16 acc[2][2];
        gemm_tile<0>(A, K, rt * 128, 0, TOK, Wt + (size_t)ct * 128 * K, K, K, smem, acc);
        if (dry) return;
        const int tt = tid(), lane = tt & 63, w = __builtin_amdgcn_readfirstlane(tt >> 6), wm = w >> 1, wn = w & 1, l32 = lane & 31, h = lane >> 5;
        float* stg = (float*)smem;
#pragma unroll
        for (int i = 0; i < 2; ++i)
#pragma unroll
            for (int j = 0; j < 2; ++j)
#pragma unroll
                for (int r = 0; r < 16; ++r) stg[(wm * 64 + i * 32 + crow(r, h)) * 132 + wn * 64 + j * 32 + l32] = acc[i][j][r];
        __syncthreads();
        bf16_t* xb = (bf16_t*)(p->ws + OFF_XB) + (size_t)(rt * 128) * DM + ct * 128;
        float* part = (float*)(p->ws + OFF_RSC) + (size_t)(rt * 128) * 16 + ct * 2;
        const int c8 = tt & 15;
#pragma unroll
        for (int i = 0; i < 8; ++i) {
            const int row = (tt >> 4) + 16 * i;
            const float4 lo = *(const float4*)(stg + row * 132 + c8 * 8), hi = *(const float4*)(stg + row * 132 + c8 * 8 + 4);
            uint4* gp = (uint4*)(xb + (size_t)row * DM + c8 * 8);
            const uint4 xv = *gp;
            uint4 nv;
            nv.x = pack2h(hlo(xv.x) + lo.x, hhi(xv.x) + lo.y); nv.y = pack2h(hlo(xv.y) + lo.z, hhi(xv.y) + lo.w);
            nv.z = pack2h(hlo(xv.z) + hi.x, hhi(xv.z) + hi.y); nv.w = pack2h(hlo(xv.w) + hi.z, hhi(xv.w) + hi.w);
            *gp = nv;
            float s0 = hlo(nv.x), s1 = hhi(nv.x), s2 = hlo(nv.y), s3 = hhi(nv.y), s4 = hlo(nv.z), s5 = hhi(nv.z), s6 = hlo(nv.w), s7 = hhi(nv.w);
            float sq = s0 * s0 + s1 * s1 + s2 * s2 + s3 * s3 + s4 * s4 + s5 * s5 + s6 * s6 + s7 * s7;
            sq += __shfl_xor(sq, 1); sq += __shfl_xor(sq, 2); sq += __shfl_xor(sq, 4); sq += __shfl_xor(sq, 8);
            if (c8 == 0) { float2 pv; pv.x = sq; pv.y = 0.f; *(float2*)(part + (size_t)row * 16) = pv; }
        }
    });
}
DI void ph_qm(KP p, int l, char* smem) {
    for_tiles(512 * 8, [&](int t) __attribute__((always_inline)) {
        int rt, ct; tile_rc(t, 8, rt, ct);
        f32x16 acc[2][2];
        const float rsp = rs_load(p, rt * 128);
        gemm_tile<0, true>((const bf16_t*)(p->ws + OFF_XB), DM, rt * 128, 0, TOK, (const bf16_t*)(p->ws + OFF_WMQ) + ((size_t)l * DM + ct * 128) * DM, DM, DM, smem, acc);
        rs_finish(rsp, rt * 128, smem);
        const float* stg = stage_tile(acc, (const float*)(smem + RS_OFF), smem);
        const int tt = tid(), c8 = tt & 15;
        const float qs = 0.0625f * LOG2E;
#pragma unroll
        for (int i = 0; i < 8; ++i) {
            const int row = (tt >> 4) + 16 * i;
            float4 lo = *(const float4*)(stg + row * 132 + c8 * 8), hi = *(const float4*)(stg + row * 132 + c8 * 8 + 4);
            lo.x *= qs; lo.y *= qs; lo.z *= qs; lo.w *= qs; hi.x *= qs; hi.y *= qs; hi.z *= qs; hi.w *= qs;
            *(uint4*)((bf16_t*)(p->ws + OFF_QM) + (size_t)(rt * 128 + row) * DM + ct * 128 + c8 * 8) = pack8(lo, hi);
        }
    });
}
DI void ph_memattn(KP p, int l, char* smem) {
    for_tiles(NBATCH * 128 * 4, [&](int t) __attribute__((always_inline)) { memattn_item(p, l, t, smem); });
}
typedef float f32p __attribute__((ext_vector_type(2)));
DI void ph_up(KP p, int l, char* smem) {
    for_tiles(NBATCH * 66 * 44, [&](int t) __attribute__((always_inline)) {
        int rt, ct; tile_rc(t, 44, rt, ct);
        const int b = rt / 66, rl = rt - b * 66, s0 = rl * 126;
        const float* cw = p->conv_w + (size_t)l * 3 * 2 * DFF; const float* cb = p->conv_b + (size_t)l * 2 * DFF;
        const int cp2 = (tid() & 31) * 2, c = ct * 64 + cp2, c2 = DFF + c;
        const f32p g0 = *(const f32p*)(cw + c), g1 = *(const f32p*)(cw + 2 * DFF + c), g2 = *(const f32p*)(cw + 4 * DFF + c), gb = *(const f32p*)(cb + c);
        const f32p u0 = *(const f32p*)(cw + c2), u1 = *(const f32p*)(cw + 2 * DFF + c2), u2 = *(const f32p*)(cw + 4 * DFF + c2), ub = *(const f32p*)(cb + c2);
        f32x16 acc[2][2];
        const float rsp = rs_load(p, b * SEQ + s0 - 1);
        if (rl == 0 || rl == 65) gemm_tile<0, true, true>((const bf16_t*)(p->ws + OFF_XB), DM, b * SEQ + s0 - 1, b * SEQ, (b + 1) * SEQ, (const bf16_t*)(p->ws + OFF_WUP) + ((size_t)l * 2 * DFF + ct * 128) * DM, DM, DM, smem, acc);
        else gemm_tile<0, true, false>((const bf16_t*)(p->ws + OFF_XB), DM, b * SEQ + s0 - 1, b * SEQ, (b + 1) * SEQ, (const bf16_t*)(p->ws + OFF_WUP) + ((size_t)l * 2 * DFF + ct * 128) * DM, DM, DM, smem, acc);
        rs_finish(rsp, b * SEQ + s0 - 1, smem);
        const float* rs = (const float*)(smem + RS_OFF);
        float* stg = (float*)smem;
        const int tt = tid(), lane = tt & 63, w = __builtin_amdgcn_readfirstlane(tt >> 6), wm = w >> 1, wn = w & 1, l32 = lane & 31, h = lane >> 5;
#pragma unroll
        for (int i = 0; i < 2; ++i)
#pragma unroll
            for (int j = 0; j < 2; ++j)
#pragma unroll
                for (int r = 0; r < 16; ++r) {
                    const int row = wm * 64 + i * 32 + crow(r, h), col = wn * 64 + j * 32 + l32;
                    stg[row * 130 + col] = acc[i][j][r] * rs[row];
                }
        __syncthreads();
        bf16_t* act = (bf16_t*)(p->ws + OFF_ACT);
        const int rmax = min(126, SEQ - s0);
        const int rbeg = w * 32 + h * 16, rend = min(rbeg + 16, rmax);
        if (rbeg < rend) {
            const float* sg = stg + rbeg * 130 + cp2;
            unsigned* arow = (unsigned*)(act + ((size_t)b * SEQ + s0 + rbeg) * DFF + c);
            f32p ga = *(const f32p*)sg, gm = *(const f32p*)(sg + 130), ua = *(const f32p*)(sg + 64), um = *(const f32p*)(sg + 130 + 64);
#pragma unroll 4
            for (int r = rbeg; r < rend; ++r) {
                sg += 130;
                const f32p gn = *(const f32p*)(sg + 130), un = *(const f32p*)(sg + 130 + 64);
                const f32p g = g0 * ga + g1 * gm + g2 * gn + gb;
                const f32p up = u0 * ua + u1 * um + u2 * un + ub;
                const f32p e = g * (-LOG2E);
                f32p den; den.x = 1.f + ex2(e.x); den.y = 1.f + ex2(e.y);
                f32p sig; sig.x = __builtin_amdgcn_rcpf(den.x); sig.y = __builtin_amdgcn_rcpf(den.y);
                const f32p o = g * sig * up;
                *arow = pack2(o.x, o.y);
                arow += DFF / 2;
                ga = gm; gm = gn; ua = um; um = un;
            }
        }
    });
}
DI void ph_final(KP p) {
    const int lane = tid() & 63, wv = blockIdx.x * 4 + (tid() >> 6), nw = gridDim.x * 4;
    const bf16_t* xbp = (const bf16_t*)(p->ws + OFF_XB);
    const float* rsc = (const float*)(p->ws + OFF_RSC);
    for (int row = wv; row < TOK; row += nw) {
        const uint4* xr = (const uint4*)(xbp + (size_t)row * DM);
        float4* orow = (float4*)(p->out + (size_t)row * DM);
        float ps = lane < 16 ? rsc[(size_t)row * 16 + lane] : 0.f;
        ps += __shfl_xor(ps, 1); ps += __shfl_xor(ps, 2); ps += __shfl_xor(ps, 4); ps += __shfl_xor(ps, 8);
        const float sc = rsqrtf(__shfl(ps, 0) * (1.f / DM) + EPS);
#pragma unroll
        for (int i = 0; i < 2; ++i) {
            const uint4 v = xr[lane + 64 * i];
            const float4 g0 = ((const float4*)p->final_norm_g)[2 * (lane + 64 * i)], g1 = ((const float4*)p->final_norm_g)[2 * (lane + 64 * i) + 1];
            float4 o0, o1;
            o0.x = hlo(v.x) * sc * g0.x; o0.y = hhi(v.x) * sc * g0.y; o0.z = hlo(v.y) * sc * g0.z; o0.w = hhi(v.y) * sc * g0.w;
            o1.x = hlo(v.z) * sc * g1.x; o1.y = hhi(v.z) * sc * g1.y; o1.z = hlo(v.w) * sc * g1.z; o1.w = hhi(v.w) * sc * g1.w;
            orow[2 * (lane + 64 * i)] = o0; orow[2 * (lane + 64 * i) + 1] = o1;
        }
    }
}

#define XB_TMO      128
#define XB_XCNT(j)  (256  + 64 * (j))
#define XB_XSUB(j)  (1280 + 64 * (j))
#define XB_XGEN(j)  (2304 + 64 * (j))
#define XB_TOP      3328
#define XB_TOPGEN   3392
#define XCD_BAR_WORDS 3456
#define XB_SPIN_CAP (1u << 22)
#define LAS __attribute__((address_space(3)))
static_assert(XCD_BAR_WORDS * 4 <= BAR_BYTES, "barrier words");
DI unsigned xb_ld(unsigned* p) { return __hip_atomic_load(p, __ATOMIC_RELAXED, __HIP_MEMORY_SCOPE_AGENT); }
DI unsigned xb_add(unsigned* p, unsigned v) { return __hip_atomic_fetch_add(p, v, __ATOMIC_RELAXED, __HIP_MEMORY_SCOPE_AGENT); }
DI unsigned xb_xcc_id() { return (unsigned)__builtin_amdgcn_s_getreg((3 << 11) | 20) & 0xFu; }
#define XB_SPIN(cond, bar) do { unsigned _sp = 0; while (cond) { __builtin_amdgcn_s_sleep(1); \
    if ((++_sp & 255u) == 0u) { if (xb_ld(&(bar)[XB_TMO])) break; if (_sp > XB_SPIN_CAP) { atomicAdd(&(bar)[XB_TMO], 1u); break; } } } } while (0)
struct XcdBarrier { unsigned* bar; unsigned x; volatile LAS unsigned* st; };
DI XcdBarrier xcd_barrier_post(unsigned* bar, volatile LAS unsigned* st) {
    XcdBarrier b; b.bar = bar; b.x = xb_xcc_id(); b.st = st;
    if (threadIdx.x == 0) (void)xb_add(&bar[XB_XCNT(b.x)], 1u);
    return b;
}
DI void xcd_barrier_complete(unsigned* bar, unsigned x, unsigned& nloc, unsigned& nx) {
    const unsigned G = gridDim.x * gridDim.y * gridDim.z;
    unsigned sum, cnt, mine, sp = 0u;
    for (;;) {
        sum = 0u; cnt = 0u; mine = 0u;
#pragma unroll
        for (unsigned j = 0; j < 16; ++j) { const unsigned c = xb_ld(&bar[XB_XCNT(j)]); sum += c; cnt += (c > 0u) ? 1u : 0u; mine = (j == x) ? c : mine; }
        if (sum == G) break;
        __builtin_amdgcn_s_sleep(1);
        if ((++sp & 255u) == 0u) { if (xb_ld(&bar[XB_TMO])) break; if (sp > XB_SPIN_CAP) { atomicAdd(&bar[XB_TMO], 1u); break; } }
    }
    nloc = mine > 0u ? mine : 1u; nx = cnt > 0u ? cnt : 1u;
}
DI void xcd_barrier(const XcdBarrier& b) {
    asm volatile("s_waitcnt vmcnt(0)" ::: "memory");
    __syncthreads();
    if (threadIdx.x == 0) {
        unsigned* bar = b.bar;
        __builtin_amdgcn_s_waitcnt(0);
        unsigned nloc = b.st[0], nx = b.st[1];
        if (nloc == 0u) { xcd_barrier_complete(bar, b.x, nloc, nx); b.st[0] = nloc; b.st[1] = nx; }
        const unsigned old = xb_add(&bar[XB_XSUB(b.x)], 1u);
        const unsigned gen = old / nloc;
        if (old + 1u == (gen + 1u) * nloc) {
            __builtin_amdgcn_fence(__ATOMIC_RELEASE, "agent");
            asm volatile("s_waitcnt vmcnt(0)" ::: "memory");
            const unsigned og = xb_add(&bar[XB_TOP], 1u);
            const unsigned tg = og / nx;
            if (og + 1u == (tg + 1u) * nx) xb_add(&bar[XB_TOPGEN], 1u);
            else XB_SPIN(xb_ld(&bar[XB_TOPGEN]) == tg, bar);
            __builtin_amdgcn_fence(__ATOMIC_ACQUIRE, "agent");
            xb_add(&bar[XB_XGEN(b.x)], 1u);
            asm volatile("s_waitcnt vmcnt(0)" ::: "memory");
        } else {
            XB_SPIN(xb_ld(&bar[XB_XGEN(b.x)]) == gen, bar);
            __builtin_amdgcn_fence(__ATOMIC_ACQUIRE, "agent");
            asm volatile("s_waitcnt vmcnt(0)" ::: "memory");
        }
    }
    __syncthreads();
}

constexpr int NPHASE = 2 + 9 * DEPTH + 1;
__global__ void __launch_bounds__(256, 2) mk(Params p_unused, int lo, int hi) {
    extern __shared__ __attribute__((aligned(16))) char smem[];
    cg::grid_group grid = cg::this_grid();
    volatile LAS unsigned* xst = (volatile LAS unsigned*)(smem + RS_OFF + 512);
    if (threadIdx.x == 0) { xst[0] = 0u; xst[1] = 0u; xst[2] = 0u; xst[3] = 0u; }
    __syncthreads();
    const XcdBarrier xbar = xcd_barrier_post((unsigned*)(kparams()->ws + OFF_BAR), xst);
    for (int ph = lo; ph < hi; ++ph) {
        KP p = kparams();
        if (ph == 0) phase_setup(p, smem);
        else if (ph == 1) ph_memkv(p, smem);
        else if (ph == NPHASE - 1) ph_final(p);
        else {
            const int l = (ph - 2) / 9, s = (ph - 2) % 9;
            const float* xin = l == 0 ? p->x : p->out;
            const int reps = ((REPMASK >> s) & 1) ? 2 : 1;
            for (int rep = 0; rep < reps; ++rep) {
                const bool dry = rep + 1 < reps;
                switch (s) {
                    case 0: ph_in(p, l, xin, smem); break;
                    case 1: ph_qkv(p, l, smem); break;
                    case 2: ph_mix(p, l, smem); break;
                    case 3: ph_res(p, (const bf16_t*)(p->ws + OFF_OMIX), DM, (const bf16_t*)(p->ws + OFF_WOUT) + (size_t)l * DM * DM, xin, smem, dry); break;
                    case 4: ph_qm(p, l, smem); break;
                    case 5: ph_memattn(p, l, smem); break;
                    case 6: ph_res(p, (const bf16_t*)(p->ws + OFF_OMEM), DM, (const bf16_t*)(p->ws + OFF_WMO) + (size_t)l * DM * DM, p->out, smem, dry); break;
                    case 7: ph_up(p, l, smem); break;
                    case 8: ph_res(p, (const bf16_t*)(p->ws + OFF_ACT), DFF, (const bf16_t*)(p->ws + OFF_WDN) + (size_t)l * DM * DFF, p->out, smem, dry); break;
                }
                if (dry) xcd_barrier(xbar);
            }
        }
        if (ph + 1 < hi) { if (ph == 0) grid.sync(); else if (ph != 1) xcd_barrier(xbar); }
    }
}

extern "C" void kernel_launch(void* const* d_in, const int* in_sizes, int n_in, void* d_out, int out_size, void* d_ws, size_t ws_size, hipStream_t stream) {
    static int grid_blocks = 0;
    if (!grid_blocks) {
        int dev = 0, cus = 0, per_cu = 0;
        hipGetDevice(&dev);
        hipDeviceGetAttribute(&cus, hipDeviceAttributeMultiprocessorCount, dev);
        hipFuncSetAttribute((const void*)mk, hipFuncAttributeMaxDynamicSharedMemorySize, LDS_BYTES);
        hipOccupancyMaxActiveBlocksPerMultiprocessor(&per_cu, (const void*)mk, 256, LDS_BYTES);
        if (per_cu < 1) per_cu = 1;
        if (per_cu > 2) per_cu = 2;
        grid_blocks = cus * per_cu;
        if (ws_size < OFF_END) fprintf(stderr, "kernel_launch: workspace too small: %zu < %zu\n", ws_size, (size_t)OFF_END);
    }
    Params p{};
    const float** fp = (const float**)&p;
    p.x = (const float*)d_in[0]; p.mem = (const float*)d_in[1]; p.pos = (const int*)d_in[2];
    p.norm_mix_g = (const float*)d_in[3]; p.w_in = (const float*)d_in[4]; p.q_norm_g = (const float*)d_in[5]; p.w_uq = (const float*)d_in[6];
    p.kv_norm_g = (const float*)d_in[7]; p.w_ukv = (const float*)d_in[8]; p.sg_ln_g = (const float*)d_in[9]; p.sg_ln_b = (const float*)d_in[10];
    p.sg_w_s = (const float*)d_in[11]; p.sg_b_s = (const float*)d_in[12]; p.out_norm_mla_g = (const float*)d_in[13]; p.out_norm_sg_g = (const float*)d_in[14];
    p.w_out = (const float*)d_in[15]; p.norm_mem_g = (const float*)d_in[16]; p.mem_norm_g = (const float*)d_in[17]; p.w_mq = (const float*)d_in[18];
    p.w_mkv = (const float*)d_in[19]; p.w_mo = (const float*)d_in[20]; p.norm_ffn_g = (const float*)d_in[21]; p.w_up = (const float*)d_in[22];
    p.conv_w = (const float*)d_in[23]; p.conv_b = (const float*)d_in[24]; p.w_down = (const float*)d_in[25]; p.final_norm_g = (const float*)d_in[26];
    p.out = (float*)d_out; p.ws = (char*)d_ws;
    (void)fp;
    (void)hipMemsetAsync((char*)d_ws + OFF_BAR, 0, BAR_BYTES, stream);
#if COOP
    int lo = 0, hi = NPHASE;
    void* args[] = {&p, &lo, &hi};
    hipError_t e = hipLaunchCooperativeKernel((const void*)mk, dim3(grid_blocks), dim3(256), args, LDS_BYTES, stream);
    if (e != hipSuccess) fprintf(stderr, "cooperative launch failed: %s (grid %d)\n", hipGetErrorString(e), grid_blocks);
#else
    for (int ph = 0; ph < NPHASE; ++ph) hipLaunchKernelGGL(mk, dim3(grid_blocks), dim3(256), LDS_BYTES, stream, p, ph, ph + 1);
#endif
}
```

```cpp
#include <hip/hip_runtime.h>
#include <hip/hip_cooperative_groups.h>
#include <stdint.h>
#include <stdio.h>
namespace cg = cooperative_groups;

#ifndef PHMASK
#define PHMASK 0xFFFF
#endif
#ifndef REPMASK
#define REPMASK 0
#endif
#ifndef COOP
#define COOP 1
#endif

typedef unsigned short bf16_t;
typedef __attribute__((ext_vector_type(8))) short bf16x8;
typedef __attribute__((ext_vector_type(16))) float f32x16;
typedef __attribute__((ext_vector_type(4))) unsigned u32x4;
#define DI __device__ __forceinline__
#define MFMA(a, b, c) __builtin_amdgcn_mfma_f32_32x32x16_bf16((a), (b), (c), 0, 0, 0)

constexpr int NBATCH = 8, SEQ = 8192, TOK = NBATCH * SEQ, DM = 1024, DEPTH = 4;
constexpr int NMEM = 256, QL = 256, KVL = 128, ROPE = 32, NOPE = 64, VD = 64, NH = 8;
constexpr int SGW = 512, INC = 1440, INCP = 1536, DFF = 2816;
constexpr float EPS = 1e-6f;
constexpr float LOG2E = 1.4426950408889634f;

constexpr size_t al256(size_t x) { return (x + 255) & ~(size_t)255; }
constexpr size_t SZ_WIN = (size_t)DEPTH * INCP * DM * 2;
constexpr size_t SZ_WUQ = (size_t)DEPTH * 768 * QL * 2;
constexpr size_t SZ_WUKV = (size_t)DEPTH * 1024 * KVL * 2;
constexpr size_t SZ_WS = (size_t)DEPTH * 8 * 128 * 128 * 2;
constexpr size_t SZ_W1K = (size_t)DEPTH * DM * DM * 2;
constexpr size_t SZ_WMKV = (size_t)DEPTH * 2048 * DM * 2;
constexpr size_t SZ_WUP = (size_t)DEPTH * 2 * DFF * DM * 2;
constexpr size_t SZ_WDN = (size_t)DEPTH * DM * DFF * 2;
constexpr size_t OFF_WIN = 0;
constexpr size_t OFF_WUQ = OFF_WIN + SZ_WIN;
constexpr size_t OFF_WUKV = OFF_WUQ + SZ_WUQ;
constexpr size_t OFF_WSG = OFF_WUKV + SZ_WUKV;
constexpr size_t OFF_WOUT = OFF_WSG + SZ_WS;
constexpr size_t OFF_WMQ = OFF_WOUT + SZ_W1K;
constexpr size_t OFF_WMKV = OFF_WMQ + SZ_W1K;
constexpr size_t OFF_WMO = OFF_WMKV + SZ_WMKV;
constexpr size_t OFF_WUP = OFF_WMO + SZ_W1K;
constexpr size_t OFF_WDN = OFF_WUP + SZ_WUP;
constexpr size_t OFF_COS = OFF_WDN + SZ_WDN;
constexpr size_t OFF_SIN = OFF_COS + (size_t)TOK * 16 * 4;
constexpr size_t OFF_KMEM = OFF_SIN + (size_t)TOK * 16 * 4;
constexpr size_t SZ_KMEM = (size_t)DEPTH * NBATCH * 4 * 256 * 256 * 2;
constexpr size_t OFF_VMEM = OFF_KMEM + SZ_KMEM;
constexpr size_t OFF_ACT0 = OFF_VMEM + SZ_KMEM;
constexpr size_t OFF_Q = OFF_ACT0;
constexpr size_t OFF_K = OFF_Q + (size_t)TOK * 8 * 96 * 2;
constexpr size_t OFF_VT = OFF_K + (size_t)TOK * 8 * 96 * 2;
constexpr size_t OFF_U = OFF_VT + (size_t)TOK * 512 * 2;
constexpr size_t OFF_V = OFF_U + (size_t)TOK * 512 * 2;
constexpr size_t OFF_OMIX = OFF_V + (size_t)TOK * 512 * 2;
constexpr size_t OFF_HQ = OFF_OMIX + (size_t)TOK * 1024 * 2;
constexpr size_t OFF_HKV = OFF_HQ + (size_t)TOK * 256 * 2;
constexpr size_t OFF_XB = OFF_HKV + (size_t)TOK * 128 * 2;
constexpr size_t OFF_MEMB = OFF_XB + (size_t)TOK * DM * 2;
constexpr size_t OFF_RSC = OFF_MEMB + (size_t)NBATCH * NMEM * DM * 2;
constexpr size_t OFF_BAR = OFF_RSC + (size_t)TOK * 16 * 4;
constexpr size_t BAR_BYTES = 16384;
constexpr size_t OFF_END = OFF_BAR + BAR_BYTES;
constexpr size_t OFF_QM = OFF_Q;
constexpr size_t OFF_OMEM = OFF_OMIX;
constexpr size_t OFF_ACT = OFF_ACT0;
static_assert(OFF_ACT + (size_t)TOK * DFF * 2 <= OFF_XB, "act alias");
static_assert(OFF_END <= (size_t)1000 * 1024 * 1024, "ws budget");

struct Params {
    const float *x, *mem; const int* pos;
    const float *norm_mix_g, *w_in, *q_norm_g, *w_uq, *kv_norm_g, *w_ukv, *sg_ln_g, *sg_ln_b, *sg_w_s, *sg_b_s,
        *out_norm_mla_g, *out_norm_sg_g, *w_out, *norm_mem_g, *mem_norm_g, *w_mq, *w_mkv, *w_mo, *norm_ffn_g, *w_up,
        *conv_w, *conv_b, *w_down, *final_norm_g;
    float* out; char* ws;
};

typedef const __attribute__((address_space(4))) Params* KP;
DI KP kparams() { KP k = (KP)__builtin_amdgcn_kernarg_segment_ptr(); asm volatile("" : "+s"(k)); return k; }
typedef __bf16 bf16v2_t __attribute__((ext_vector_type(2)));
typedef float f32v2_t __attribute__((ext_vector_type(2)));
DI unsigned pack2(float a, float b) { f32v2_t v = {a, b}; return __builtin_bit_cast(unsigned, __builtin_convertvector(v, bf16v2_t)); }
DI bf16_t f2bf(float f) { return (bf16_t)(pack2(f, f) & 0xffffu); }
typedef _Float16 f16x8 __attribute__((ext_vector_type(8)));
typedef _Float16 f16v2_t __attribute__((ext_vector_type(2)));
DI unsigned pack2h(float a, float b) { f16v2_t v = {(_Float16)a, (_Float16)b}; return __builtin_bit_cast(unsigned, v); }
DI bf16_t f2h(float f) { return __builtin_bit_cast(unsigned short, (_Float16)f); }
DI float h2f(bf16_t u) { return (float)__builtin_bit_cast(_Float16, u); }
DI float hlo(unsigned u) { return h2f((bf16_t)(u & 0xffffu)); }
DI float hhi(unsigned u) { return h2f((bf16_t)(u >> 16)); }
#define MFMA_H(a, b, c) __builtin_amdgcn_mfma_f32_32x32x16_f16(__builtin_bit_cast(f16x8, (a)), __builtin_bit_cast(f16x8, (b)), (c), 0, 0, 0)
DI float bf2f(bf16_t b) { return __uint_as_float((unsigned)b << 16); }
DI float bflo(unsigned u) { return __uint_as_float(u << 16); }
DI float bfhi(unsigned u) { return __uint_as_float(u & 0xffff0000u); }
DI float ex2(float x) { return __builtin_amdgcn_exp2f(x); }
DI float gelu_tanh(float x) { float y = 0.7978845608028654f * (x + 0.044715f * x * x * x); return x * __builtin_amdgcn_rcpf(1.f + ex2(-2.f * LOG2E * y)); }
DI float silu(float x) { return x * __builtin_amdgcn_rcpf(1.f + ex2(-LOG2E * x)); }
DI int tid() { int t = threadIdx.x; asm volatile("" : "+v"(t)); return t; }
DI int crow(int r, int h) { return (r & 3) + 8 * (r >> 2) + 4 * h; }
DI int swap23(int r) { return (r & ~12) | ((r & 4) << 1) | ((r & 8) >> 1); }

template <class F> DI void for_tiles(int ntiles, F f) {
    const int G = gridDim.x, b = blockIdx.x;
    const bool sw = (G & 7) == 0;
    const int tpx = (ntiles + 7) >> 3;
    const int start = sw ? (b >> 3) : b, step = sw ? (G >> 3) : G, lim = sw ? tpx : ntiles, base = sw ? (b & 7) * tpx : 0;
    for (int i = start; i < lim; i += step) {
        const int t = base + i;
        if (t < ntiles) f(t);
    }
}

constexpr int LK = 72;
constexpr int GEMM_LDS = 4 * 128 * LK * 2;
constexpr int RS_OFF = GEMM_LDS;
constexpr int LDS_BYTES = GEMM_LDS + 1024;

template <int AMODE, bool F16 = false, bool MASK = false>
DI void gemm_tile(const bf16_t* __restrict__ Ab, int lda, int row0, int rlo, int rhi,
                  const bf16_t* __restrict__ Bt, int ldb, int K, char* smem, f32x16 (&acc)[2][2]) {
    const int t = tid(), lane = t & 63, w = __builtin_amdgcn_readfirstlane(t >> 6), wm = w >> 1, wn = w & 1, l32 = lane & 31, h = lane >> 5;
    bf16_t* As = (bf16_t*)smem;
    bf16_t* Bs = As + 2 * 128 * LK;
    float* rs = (float*)(smem + RS_OFF);
#pragma unroll
    for (int i = 0; i < 2; ++i)
#pragma unroll
        for (int j = 0; j < 2; ++j)
#pragma unroll
            for (int r = 0; r < 16; ++r) acc[i][j][r] = 0.f;

    uint4 p0a0, p0a1, p0a2, p0a3, p0b0, p0b1, p0b2, p0b3, p1a0, p1a1, p1a2, p1a3, p1b0, p1b1, p1b2, p1b3;
    float ss0 = 0.f, ss1 = 0.f, ss2 = 0.f, ss3 = 0.f;
    const int gr0 = row0 + (t >> 3);
    const bool rv0 = gr0 >= rlo && gr0 < rhi, rv1 = gr0 + 32 >= rlo && gr0 + 32 < rhi, rv2 = gr0 + 64 >= rlo && gr0 + 64 < rhi, rv3 = gr0 + 96 >= rlo && gr0 + 96 < rhi;
    const int nk = K >> 6;
    const int rhm = rhi - 1;
    const unsigned aoff0 = (unsigned)min(max(gr0, rlo), rhm) * (unsigned)lda + 8u * (t & 7);
    const unsigned aoff1 = (unsigned)min(max(gr0 + 32, rlo), rhm) * (unsigned)lda + 8u * (t & 7);
    const unsigned aoff2 = (unsigned)min(max(gr0 + 64, rlo), rhm) * (unsigned)lda + 8u * (t & 7);
    const unsigned aoff3 = (unsigned)min(max(gr0 + 96, rlo), rhm) * (unsigned)lda + 8u * (t & 7);
    const unsigned btoff = (unsigned)((t >> 3) * ldb + 8 * (t & 7));

    __syncthreads();

#define LD1(S, j, k0)                                                                                         \
    {                                                                                                         \
        S##a##j = *(const uint4*)(Ab + (k0) + aoff##j);          \
        S##b##j = *(const uint4*)(Bt + (size_t)(32 * j) * ldb + (k0) + btoff);                                \
    }
#define LOADS(S, k0) { LD1(S, 0, k0) LD1(S, 1, k0) LD1(S, 2, k0) LD1(S, 3, k0) }
#define ST1(S, j, buf)                                                                                        \
    {                                                                                                         \
        uint4 v = S##a##j;                                                                                    \
        if constexpr (MASK) { if (!rv##j) v = make_uint4(0, 0, 0, 0); }     \
        if (AMODE == 1) {                                                                                     \
            float a0 = bflo(v.x), a1 = bfhi(v.x), a2 = bflo(v.y), a3 = bfhi(v.y), a4 = bflo(v.z), a5 = bfhi(v.z), a6 = bflo(v.w), a7 = bfhi(v.w); \
            ss##j += a0 * a0 + a1 * a1 + a2 * a2 + a3 * a3 + a4 * a4 + a5 * a5 + a6 * a6 + a7 * a7;          \
        }                                                                                                     \
        *(uint4*)(As + (buf) * 128 * LK + ((t >> 3) + 32 * j) * LK + 8 * (t & 7)) = v;                        \
        *(uint4*)(Bs + (buf) * 128 * LK + ((t >> 3) + 32 * j) * LK + 8 * (t & 7)) = S##b##j;                  \
    }
#define STORES(S, buf) { ST1(S, 0, buf) ST1(S, 1, buf) ST1(S, 2, buf) ST1(S, 3, buf) }
#define FRAGS(ks, A0, A1, B0, B1) { A0 = *(const bf16x8*)(a_s + (ks) * 16); A1 = *(const bf16x8*)(a_s + 32 * LK + (ks) * 16); B0 = *(const bf16x8*)(b_s + (ks) * 16); B1 = *(const bf16x8*)(b_s + 32 * LK + (ks) * 16); }
#define MMAS(A0, A1, B0, B1) { __builtin_amdgcn_s_setprio(1); if constexpr (F16) { acc[0][0] = MFMA_H(A0, B0, acc[0][0]); acc[0][1] = MFMA_H(A0, B1, acc[0][1]); acc[1][0] = MFMA_H(A1, B0, acc[1][0]); acc[1][1] = MFMA_H(A1, B1, acc[1][1]); } else { acc[0][0] = MFMA(A0, B0, acc[0][0]); acc[0][1] = MFMA(A0, B1, acc[0][1]); acc[1][0] = MFMA(A1, B0, acc[1][0]); acc[1][1] = MFMA(A1, B1, acc[1][1]); } __builtin_amdgcn_s_setprio(0); }
#define COMPUTE(buf)                                                                                          \
    {                                                                                                         \
        const bf16_t* a_s = As + (buf) * 128 * LK + (wm * 64 + l32) * LK + h * 8;                             \
        const bf16_t* b_s = Bs + (buf) * 128 * LK + (wn * 64 + l32) * LK + h * 8;                             \
        bf16x8 xa0, xa1, xb0, xb1, ya0, ya1, yb0, yb1;                                                        \
        FRAGS(0, xa0, xa1, xb0, xb1)                                                                          \
        FRAGS(1, ya0, ya1, yb0, yb1)                                                                          \
        MMAS(xa0, xa1, xb0, xb1)                                                                              \
        FRAGS(2, xa0, xa1, xb0, xb1)                                                                          \
        MMAS(ya0, ya1, yb0, yb1)                                                                              \
        FRAGS(3, ya0, ya1, yb0, yb1)                                                                          \
        MMAS(xa0, xa1, xb0, xb1)                                                                              \
        MMAS(ya0, ya1, yb0, yb1)                                                                              \
    }

    const int klast = (nk - 1) * 64;
    LOADS(p0, 0);
    LOADS(p1, 64);
    STORES(p0, 0);
    LOADS(p0, min(128, klast));
    __syncthreads();
    for (int kt = 0; kt < nk; kt += 2) {
        COMPUTE(0);
        STORES(p1, 1);
        LOADS(p1, min((kt + 3) * 64, klast));
        __syncthreads();
        COMPUTE(1);
        if (kt + 2 < nk) STORES(p0, 0);
        LOADS(p0, min((kt + 4) * 64, klast));
        __syncthreads();
    }
#undef LOADS
#undef STORES
#undef COMPUTE
#undef FRAGS
#undef MMAS
#undef LD1
#undef ST1
    if (AMODE == 1) {
#define RS1(j) { float s = ss##j; s += __shfl_xor(s, 1); s += __shfl_xor(s, 2); s += __shfl_xor(s, 4); if ((t & 7) == 0) rs[(t >> 3) + 32 * j] = rsqrtf(s / (float)K + EPS); }
        RS1(0) RS1(1) RS1(2) RS1(3)
#undef RS1
        __syncthreads();
    }
}

DI float rs_load(KP p, int row0) {
    const int t = tid(), r = row0 + (t >> 1);
    float sum = 0.f;
    if (r >= 0 && r < TOK) {
        const float4* ps = (const float4*)((const float*)(p->ws + OFF_RSC) + (size_t)r * 16 + (t & 1) * 8);
        const float4 a = ps[0], b = ps[1];
        sum = (a.x + a.y) + (a.z + a.w) + (b.x + b.y) + (b.z + b.w);
    }
    return sum;
}
DI void rs_finish(float sum, int row0, char* smem) {
    const int t = tid(), r = row0 + (t >> 1);
    sum += __shfl_xor(sum, 1);
    if ((t & 1) == 0) ((float*)(smem + RS_OFF))[t >> 1] = (r >= 0 && r < TOK) ? rsqrtf(sum * (1.f / DM) + EPS) : 0.f;
    __syncthreads();
}

DI void tile_rc(int t, int NT, int& rt, int& ct) { const int g = t / (8 * NT), rem = t - g * 8 * NT; ct = rem >> 3; rt = g * 8 + (rem & 7); }

template <class E> DI void run_epi(const f32x16 (&acc)[2][2], const E& e) {
    const int w = __builtin_amdgcn_readfirstlane(tid() >> 6), wm = w >> 1, wn = w & 1;
#pragma unroll
    for (int i = 0; i < 2; ++i)
#pragma unroll
        for (int j = 0; j < 2; ++j) e(wm * 64 + i * 32, wn * 64 + j * 32, acc[i][j]);
}

DI int up_perm(int n) { return n < DFF ? (n >> 6) * 128 + (n & 63) : ((n - DFF) >> 6) * 128 + 64 + ((n - DFF) & 63); }

DI void conv_tile(const float* __restrict__ src, int K, int N, const float* g1, const float* g2, int ksplit,
                  bf16_t* __restrict__ dst, int rowmap, int tile, float* lds, int mode, bool f16 = false) {
    const int ntn = N >> 5, tk = tile / ntn, tn = tile - tk * ntn, k0 = tk * 32, n0 = tn * 32;
    const int tx = tid() & 31, ty = tid() >> 5;
    if (mode == 0) {
#pragma unroll
        for (int i = 0; i < 4; ++i) {
            int k = k0 + ty + 8 * i;
            float v = src[(size_t)k * N + n0 + tx];
            float g = g1 ? (k < ksplit ? g1[k] : g2[k - ksplit]) : 1.f;
            lds[(ty + 8 * i) * 33 + tx] = v * g;
        }
    } else {
#pragma unroll
        for (int i = 0; i < 4; ++i) {
            int n = n0 + ty + 8 * i;
            int nn = rowmap ? up_perm(n) : n;
            const float wv = lds[tx * 33 + ty + 8 * i];
            dst[(size_t)nn * K + k0 + tx] = f16 ? f2h(wv) : f2bf(wv);
        }
    }
}

__device__ void phase_setup(KP p, char* smem) {
    float* lds = (float*)smem;
    char* ws = p->ws;
    constexpr int PER_LAYER = 1440 + 192 + 128 + 1024 + 1024 + 2048 + 1024 + 5632 + 2816;
    auto job = [&](int t, float* ldsq, int mode) __attribute__((always_inline)) {
        int l = t / PER_LAYER, r = t - l * PER_LAYER;
        if (r < 1440) conv_tile(p->w_in + (size_t)l * DM * INC, DM, INC, p->norm_mix_g + l * DM, nullptr, DM, (bf16_t*)(ws + OFF_WIN) + (size_t)l * INCP * DM, 0, r, ldsq, mode, true);
        else if ((r -= 1440) < 192) conv_tile(p->w_uq + (size_t)l * QL * 768, QL, 768, p->q_norm_g + l * QL, nullptr, QL, (bf16_t*)(ws + OFF_WUQ) + (size_t)l * 768 * QL, 0, r, ldsq, mode);
        else if ((r -= 192) < 128) conv_tile(p->w_ukv + (size_t)l * KVL * 1024, KVL, 1024, p->kv_norm_g + l * KVL, nullptr, KVL, (bf16_t*)(ws + OFF_WUKV) + (size_t)l * 1024 * KVL, 0, r, ldsq, mode);
        else if ((r -= 128) < 1024) conv_tile(p->w_out + (size_t)l * DM * DM, DM, DM, p->out_norm_mla_g + l * 512, p->out_norm_sg_g + l * 512, 512, (bf16_t*)(ws + OFF_WOUT) + (size_t)l * DM * DM, 0, r, ldsq, mode);
        else if ((r -= 1024) < 1024) conv_tile(p->w_mq + (size_t)l * DM * DM, DM, DM, p->norm_mem_g + l * DM, nullptr, DM, (bf16_t*)(ws + OFF_WMQ) + (size_t)l * DM * DM, 0, r, ldsq, mode, true);
        else if ((r -= 1024) < 2048) conv_tile(p->w_mkv + (size_t)l * DM * 2048, DM, 2048, p->mem_norm_g + l * DM, nullptr, DM, (bf16_t*)(ws + OFF_WMKV) + (size_t)l * 2048 * DM, 0, r, ldsq, mode);
        else if ((r -= 2048) < 1024) conv_tile(p->w_mo + (size_t)l * DM * DM, DM, DM, nullptr, nullptr, DM, (bf16_t*)(ws + OFF_WMO) + (size_t)l * DM * DM, 0, r, ldsq, mode);
        else if ((r -= 1024) < 5632) conv_tile(p->w_up + (size_t)l * DM * 2 * DFF, DM, 2 * DFF, p->norm_ffn_g + l * DM, nullptr, DM, (bf16_t*)(ws + OFF_WUP) + (size_t)l * 2 * DFF * DM, 1, r, ldsq, mode, true);
        else { r -= 5632; conv_tile(p->w_down + (size_t)l * DFF * DM, DFF, DM, nullptr, nullptr, DFF, (bf16_t*)(ws + OFF_WDN) + (size_t)l * DM * DFF, 0, r, ldsq, mode); }
    };
    constexpr int NJOB = PER_LAYER * DEPTH, TPB = 4;
    for (int t0 = blockIdx.x; t0 < NJOB; t0 += TPB * gridDim.x) {
#pragma unroll
        for (int u = 0; u < TPB; ++u) { const int t = t0 + u * gridDim.x; if (t < NJOB) job(t, lds + u * 32 * 33, 0); }
        __syncthreads();
#pragma unroll
        for (int u = 0; u < TPB; ++u) { const int t = t0 + u * gridDim.x; if (t < NJOB) job(t, lds + u * 32 * 33, 1); }
        __syncthreads();
    }
    const size_t gt = (size_t)blockIdx.x * 256 + tid(), gn = (size_t)gridDim.x * 256;
    bf16_t* wsg = (bf16_t*)(ws + OFF_WSG);
    for (size_t i = gt; i < (size_t)DEPTH * 8 * 128 * 128; i += gn) wsg[i] = f2bf(p->sg_w_s[i]);
    for (size_t i = gt; i < (size_t)DEPTH * 96 * DM; i += gn) {
        size_t l = i / (96 * DM), r = i - l * (96 * DM);
        ((bf16_t*)(ws + OFF_WIN))[(l * INCP + INC) * DM + r] = 0;
    }
    {
        {
            const int lane = tid() & 63, wv = blockIdx.x * 4 + (tid() >> 6), nw = gridDim.x * 4;
            float* rsc = (float*)(ws + OFF_RSC);
            for (int row = wv; row < TOK; row += nw) {
                const float4* xs = (const float4*)(p->x + (size_t)row * DM); uint2* xd = (uint2*)(ws + OFF_XB) + (size_t)row * (DM / 4);
                float sacc = 0.f;
#pragma unroll
                for (int i = 0; i < 4; ++i) { float4 v = xs[lane + 64 * i]; sacc += v.x * v.x + v.y * v.y + v.z * v.z + v.w * v.w; uint2 o; o.x = pack2h(v.x, v.y); o.y = pack2h(v.z, v.w); xd[lane + 64 * i] = o; }
#pragma unroll
                for (int o = 1; o < 64; o <<= 1) sacc += __shfl_xor(sacc, o);
                if (lane < 16) rsc[(size_t)row * 16 + lane] = lane == 0 ? sacc : 0.f;
            }
        }
        const float4* ms = (const float4*)p->mem; uint2* md = (uint2*)(ws + OFF_MEMB);
        for (size_t i = gt; i < (size_t)NBATCH * NMEM * DM / 4; i += gn) { float4 v = ms[i]; uint2 o; o.x = pack2(v.x, v.y); o.y = pack2(v.z, v.w); md[i] = o; }
    }
    float* cs = (float*)(ws + OFF_COS); float* sn = (float*)(ws + OFF_SIN);
    for (size_t i = gt; i < (size_t)TOK * 16; i += gn) {
        int tok = (int)(i >> 4), f = (int)(i & 15);
        const float inv = ex2(-(float)f * 0.83048202372184058f);
        const float ang = (float)p->pos[tok] * inv;
        const float c_hi = 0.15915494309189535f, c_lo = 6.4206383e-9f;
        const float rh = ang * c_hi;
        const float re = fmaf(ang, c_hi, -rh) + ang * c_lo;
        float rf = (rh - floorf(rh)) + re;
        cs[i] = __builtin_amdgcn_cosf(rf);
        sn[i] = __builtin_amdgcn_sinf(rf);
    }
}

struct EpiMemKV {
    bf16_t* km; bf16_t* vm; const float* rs; int row0, col0;
    DI void operator()(int rb, int cb, const f32x16& a) const {
        const int lane = tid() & 63, c = lane & 31, h = lane >> 5;
        const int n0 = col0 + cb;
        if (n0 < 1024) {
            const int head = n0 >> 8, d = (n0 & 255) + c;
#pragma unroll
            for (int r = 0; r < 16; ++r) {
                int row = rb + crow(r, h), gr = row0 + row, b = gr >> 8, key = gr & 255;
                km[(((size_t)(b * 4 + head)) * 256 + key) * 256 + d] = f2bf(a[r] * rs[row]);
            }
        } else {
            const int head = (n0 - 1024) >> 8, d = ((n0 - 1024) & 255) + c;
#pragma unroll
            for (int g = 0; g < 4; ++g) {
                int row = rb + 8 * g + 4 * h, gr = row0 + row, b = gr >> 8, key = gr & 255;
                uint2 pk;
                pk.x = pack2(a[4 * g] * rs[row], a[4 * g + 1] * rs[row + 1]);
                pk.y = pack2(a[4 * g + 2] * rs[row + 2], a[4 * g + 3] * rs[row + 3]);
                *(uint2*)(vm + (((size_t)(b * 4 + head)) * 256 + d) * 256 + key) = pk;
            }
        }
    }
};

struct EpiIn {
    bf16_t *hq, *hkv, *u, *v, *kb; const float *cs, *sn, *rs; int row0, col0;
    DI void operator()(int rb, int cb, const f32x16& a) const {
        const int lane = tid() & 63, c = lane & 31, h = lane >> 5;
        const int nb = col0 + cb;
        if (nb >= INC) return;
        if (nb == 384) {
#pragma unroll
            for (int r = 0; r < 16; ++r) {
                const int row = rb + crow(r, h), tok = row0 + row;
                const float val = a[r] * rs[row];
                float pt = __shfl_xor(val, 16);
                float co = cs[tok * 16 + (c & 15)], si = sn[tok * 16 + (c & 15)];
                float o = (c < 16) ? val * co - pt * si : val * co + pt * si;
                bf16_t ob = f2bf(o);
                const int b = tok >> 13, s = tok & 8191;
                bf16_t* dst = kb + (((size_t)(b * 8)) * SEQ + s) * 96 + 64 + c;
                for (int hd = 0; hd < 8; ++hd) dst[(size_t)hd * SEQ * 96] = ob;
            }
            return;
        }
        bf16_t* dst; int pitch, off; bool act;
        if (nb < 256) { dst = hq; pitch = 256; off = nb; act = false; }
        else if (nb < 384) { dst = hkv; pitch = 128; off = nb - 256; act = false; }
        else if (nb < 928) { dst = u; pitch = 512; off = nb - 416; act = true; }
        else { dst = v; pitch = 512; off = nb - 928; act = true; }
        dst += (size_t)(row0 + rb + 4 * h) * pitch + off + c;
#pragma unroll
        for (int r = 0; r < 16; ++r) {
            const int rr = (r & 3) + 8 * (r >> 2);
            float val = a[r] * rs[rb + rr + 4 * h];
            if (act) val = gelu_tanh(val);
            dst[(size_t)rr * pitch] = f2bf(val);
        }
    }
};

struct EpiQ {
    bf16_t* q; const float *cs, *sn, *rs; int row0, col0;
    DI void operator()(int rb, int cb, const f32x16& a) const {
        const int lane = tid() & 63, c = lane & 31, h = lane >> 5;
        const int n0 = col0 + cb, head = n0 / 96, w0 = n0 - head * 96;
        const float qs = 0.10206207261596575f * LOG2E;
#pragma unroll
        for (int r = 0; r < 16; ++r) {
            const int row = rb + crow(r, h), tok = row0 + row;
            float val = a[r] * rs[row] * qs;
            if (w0 == 64) {
                float pt = __shfl_xor(val, 16);
                float co = cs[tok * 16 + (c & 15)], si = sn[tok * 16 + (c & 15)];
                val = (c < 16) ? val * co - pt * si : val * co + pt * si;
            }
            const int b = tok >> 13, s = tok & 8191;
            q[(((size_t)(b * 8 + head)) * SEQ + s) * 96 + w0 + c] = f2bf(val);
        }
    }
};

struct EpiKV {
    bf16_t *kb, *vstage; const float* rs; int row0, col0;
    DI void operator()(int rb, int cb, const f32x16& a) const {
        const int lane = tid() & 63, c = lane & 31, h = lane >> 5;
        const int n0 = col0 + cb, head = n0 >> 7, w0 = n0 & 127;
        if (w0 < 64) {
#pragma unroll
            for (int r = 0; r < 16; ++r) {
                const int row = rb + crow(r, h), tok = row0 + row, b = tok >> 13, s = tok & 8191;
                kb[(((size_t)(b * 8 + head)) * SEQ + s) * 96 + w0 + c] = f2bf(a[r] * rs[row]);
            }
        } else {
            const int d = w0 - 64 + c;
#pragma unroll
            for (int g = 0; g < 4; ++g) {
                const int row = rb + 8 * g + 4 * h;
                uint2 pk;
                pk.x = pack2(a[4 * g] * rs[row], a[4 * g + 1] * rs[row + 1]);
                pk.y = pack2(a[4 * g + 2] * rs[row + 2], a[4 * g + 3] * rs[row + 3]);
                *(uint2*)(vstage + d * 136 + row) = pk;
            }
        }
    }
};

struct EpiRes {
    bf16_t* xb; int row0, col0; bool dry;
    DI void operator()(int rb, int cb, const f32x16& a, f32x16& sq) const {
        const int lane = tid() & 63, c = lane & 31, h = lane >> 5;
        if (dry && a[0] != 1.2345e30f) return;
        bf16_t* ptr = xb + (size_t)(row0 + rb + 4 * h) * DM + col0 + cb + c;
#pragma unroll
        for (int r = 0; r < 16; ++r) {
            const int rr = (r & 3) + 8 * (r >> 2);
            const bf16_t nb = f2h(h2f(ptr[(size_t)rr * DM]) + a[r]);
            ptr[(size_t)rr * DM] = nb;
            const float nv = h2f(nb);
            sq[r] += nv * nv;
        }
    }
};

struct EpiQm {
    bf16_t* qm; const float* rs; int row0, col0;
    DI void operator()(int rb, int cb, const f32x16& a) const {
        const int lane = tid() & 63, c = lane & 31, h = lane >> 5;
#pragma unroll
        for (int r = 0; r < 16; ++r) {
            const int row = rb + crow(r, h);
            qm[(size_t)(row0 + row) * DM + col0 + cb + c] = f2bf(a[r] * rs[row] * (0.0625f * LOG2E));
        }
    }
};

template <int DQK, int DV, int NBUF, bool QREG, int QW, int LDQ, int LDK, int LDV, int LDO>
DI void flash_item(const bf16_t* __restrict__ Qp, const bf16_t* __restrict__ Kp, const bf16_t* __restrict__ Vtp, int nkt,
                   bf16_t* __restrict__ Op, char* smem, float& ssq) {
    constexpr int KP = DQK + 8;
    constexpr int VP = 72;
    constexpr int CPR = DQK / 8;
    constexpr int KCH = 64 * CPR / 256;
    constexpr int VCH = DV * 8 / 256;
    constexpr int NKS = DQK / 16, NMT = DV / 32 / QW;
    constexpr bool KROWS = (256 % CPR) == 0;
    static_assert(KROWS || LDK == DQK, "K tile addressing");
    static_assert(KCH <= 8 && VCH <= 8, "staging regs");
    static_assert(NBUF == 2 ? (KCH <= 4 && VCH <= 2) : (KCH == 8 && VCH == 8), "staging");
    bf16_t* Ks = (bf16_t*)smem;
    bf16_t* Vs = Ks + NBUF * 64 * KP;
    const int t = tid(), lane = t & 63, w = __builtin_amdgcn_readfirstlane(t >> 6), l32 = lane & 31, h = lane >> 5;
    const int q = (w / QW) * 32 + l32, dv0 = (w % QW) * (DV / QW);
    const unsigned ktoff = KROWS ? (unsigned)((t / CPR) * LDK + (t % CPR) * 8) : (unsigned)(t * 8);
    const unsigned vtoff = (unsigned)((t >> 3) * LDV + (t & 7) * 8);

    bf16x8 qf[QREG ? NKS : 1];
    if constexpr (QREG) {
#pragma unroll
        for (int ks = 0; ks < NKS; ++ks) qf[ks] = *(const bf16x8*)(Qp + (size_t)q * LDQ + ks * 16 + 8 * h);
    }
    f32x16 o[NMT];
#pragma unroll
    for (int mt = 0; mt < NMT; ++mt)
#pragma unroll
        for (int r = 0; r < 16; ++r) o[mt][r] = 0.f;
    float m = -INFINITY, lsum = 0.f;

    uint4 rk0, rk1, rk2, rk3, rk4, rk5, rk6, rk7, rv0, rv1;
    (void)rk0; (void)rk1; (void)rk2; (void)rk3; (void)rk4; (void)rk5; (void)rk6; (void)rk7; (void)rv0; (void)rv1;
#define LKJ(kt, i, R) { const bf16_t* kb_ = KROWS ? Kp + (size_t)((kt) * 64 + (i) * (256 / CPR)) * LDK : Kp + (size_t)(kt) * 64 * DQK + (i) * 2048; R = *(const uint4*)(kb_ + ktoff); }
#define SKJ(buf, i, R) { int c = t + 256 * (i), row = c / CPR, cc = c - row * CPR; *(uint4*)(Ks + (buf) * 64 * KP + swap23(row) * KP + cc * 8) = R; }
#define LVJ(kt, i, R) { const bf16_t* vb_ = Vtp + (size_t)(i) * 32 * LDV + (kt) * 64; R = *(const uint4*)(vb_ + vtoff); }
#define SVJ(buf, i, R) { int c = t + 256 * (i), d = c >> 3, cc = c & 7; *(uint4*)(Vs + (buf) * DV * VP + d * VP + cc * 8) = R; }
#define ATT_LOAD(kt) { LKJ(kt, 0, rk0) if constexpr (KCH > 1) LKJ(kt, 1, rk1) if constexpr (KCH > 2) LKJ(kt, 2, rk2) if constexpr (KCH > 3) LKJ(kt, 3, rk3) LVJ(kt, 0, rv0) if constexpr (VCH > 1) LVJ(kt, 1, rv1) }
#define ATT_STORE(buf) { SKJ(buf, 0, rk0) if constexpr (KCH > 1) SKJ(buf, 1, rk1) if constexpr (KCH > 2) SKJ(buf, 2, rk2) if constexpr (KCH > 3) SKJ(buf, 3, rk3) SVJ(buf, 0, rv0) if constexpr (VCH > 1) SVJ(buf, 1, rv1) }

    __syncthreads();
    if constexpr (NBUF == 2) ATT_LOAD(0);
    for (int kt = 0; kt < nkt; ++kt) {
        const int buf = (NBUF == 2) ? (kt & 1) : 0;
        if constexpr (NBUF == 1) {
            __syncthreads();
            LKJ(kt, 0, rk0) LKJ(kt, 1, rk1) LKJ(kt, 2, rk2) LKJ(kt, 3, rk3)
            LKJ(kt, 4, rk4) LKJ(kt, 5, rk5) LKJ(kt, 6, rk6) LKJ(kt, 7, rk7)
            SKJ(0, 0, rk0) SKJ(0, 1, rk1) SKJ(0, 2, rk2) SKJ(0, 3, rk3)
            asm volatile("" ::: "memory");
            LVJ(kt, 0, rk0) LVJ(kt, 1, rk1) LVJ(kt, 2, rk2) LVJ(kt, 3, rk3)
            SKJ(0, 4, rk4) SKJ(0, 5, rk5) SKJ(0, 6, rk6) SKJ(0, 7, rk7)
            asm volatile("" ::: "memory");
            LVJ(kt, 4, rk4) LVJ(kt, 5, rk5) LVJ(kt, 6, rk6) LVJ(kt, 7, rk7)
            SVJ(0, 0, rk0) SVJ(0, 1, rk1) SVJ(0, 2, rk2) SVJ(0, 3, rk3)
            asm volatile("" ::: "memory");
            SVJ(0, 4, rk4) SVJ(0, 5, rk5) SVJ(0, 6, rk6) SVJ(0, 7, rk7)
        } else { ATT_STORE(buf); }
        __syncthreads();
        if constexpr (NBUF == 2) { if (kt + 1 < nkt) ATT_LOAD(kt + 1); }

        const bf16_t* kb = Ks + buf * 64 * KP + l32 * KP + 8 * h;
        f32x16 s0, s1;
#pragma unroll
        for (int r = 0; r < 16; ++r) { s0[r] = 0.f; s1[r] = 0.f; }
#pragma unroll
        for (int ks = 0; ks < NKS; ++ks) {
            bf16x8 qq;
            if constexpr (QREG) qq = qf[ks]; else qq = *(const bf16x8*)(Qp + (size_t)q * LDQ + ks * 16 + 8 * h);
            bf16x8 k0 = *(const bf16x8*)(kb + ks * 16);
            bf16x8 k1 = *(const bf16x8*)(kb + 32 * KP + ks * 16);
            s0 = MFMA(k0, qq, s0);
            s1 = MFMA(k1, qq, s1);
        }
        float mx = s0[0];
#pragma unroll
        for (int r = 1; r < 16; ++r) mx = fmaxf(mx, s0[r]);
#pragma unroll
        for (int r = 0; r < 16; ++r) mx = fmaxf(mx, s1[r]);
        mx = fmaxf(mx, __shfl_xor(mx, 32));
        const float mn = fmaxf(m, mx);
        const float alpha = ex2(m - mn);
        m = mn;
        float psum = 0.f;
#pragma unroll
        for (int r = 0; r < 16; ++r) { s0[r] = ex2(s0[r] - mn); psum += s0[r]; }
#pragma unroll
        for (int r = 0; r < 16; ++r) { s1[r] = ex2(s1[r] - mn); psum += s1[r]; }
        lsum = lsum * alpha + psum;
        if (__builtin_amdgcn_ballot_w64(alpha != 1.f) != 0ull) {
#pragma unroll
            for (int mt = 0; mt < NMT; ++mt)
#pragma unroll
                for (int r = 0; r < 16; ++r) o[mt][r] *= alpha;
        }
        const bf16_t* vb = Vs + buf * DV * VP + (dv0 + l32) * VP + 8 * h;
#pragma unroll
        for (int t2 = 0; t2 < 2; ++t2)
#pragma unroll
            for (int s2 = 0; s2 < 2; ++s2) {
                u32x4 pu;
#pragma unroll
                for (int j = 0; j < 4; ++j)
                    pu[j] = t2 ? pack2(s1[8 * s2 + 2 * j], s1[8 * s2 + 2 * j + 1]) : pack2(s0[8 * s2 + 2 * j], s0[8 * s2 + 2 * j + 1]);
                const bf16x8 pfv = __builtin_bit_cast(bf16x8, pu);
#pragma unroll
                for (int mt = 0; mt < NMT; ++mt) {
                    bf16x8 vv = *(const bf16x8*)(vb + mt * 32 * VP + t2 * 32 + s2 * 16);
                    o[mt] = MFMA(vv, pfv, o[mt]);
                }
            }
    }
#undef ATT_LOAD
#undef ATT_STORE
#undef LKJ
#undef SKJ
#undef LVJ
#undef SVJ
    const float inv = 1.f / (lsum + __shfl_xor(lsum, 32));
#pragma unroll
    for (int mt = 0; mt < NMT; ++mt)
#pragma unroll
        for (int g = 0; g < 4; ++g) {
            float v0 = o[mt][4 * g] * inv, v1 = o[mt][4 * g + 1] * inv, v2 = o[mt][4 * g + 2] * inv, v3 = o[mt][4 * g + 3] * inv;
            uint2 pk; pk.x = pack2(v0, v1); pk.y = pack2(v2, v3);
            float r0 = bflo(pk.x), r1 = bfhi(pk.x), r2 = bflo(pk.y), r3 = bfhi(pk.y);
            ssq += r0 * r0 + r1 * r1 + r2 * r2 + r3 * r3;
            *(uint2*)(Op + (size_t)q * LDO + dv0 + mt * 32 + 8 * g + 4 * h) = pk;
        }
}

DI void flash_mla2(const bf16_t* __restrict__ Qp, const bf16_t* __restrict__ Kp, const bf16_t* __restrict__ Vtp,
                   bf16_t* __restrict__ Op, char* smem, float& ssq) {
    constexpr int DQK = 96, DV = 64, LDQ = 96, LDV = SEQ, LDO = DM, NKT = SEQ / 64;
    constexpr int KP = DQK + 8, VP = 72, CPR = DQK / 8, NKS = DQK / 16, NMT = DV / 32;
    bf16_t* Ks = (bf16_t*)smem;
    bf16_t* Vs = Ks + 2 * 64 * KP;
    const int t = tid(), lane = t & 63, w = __builtin_amdgcn_readfirstlane(t >> 6), l32 = lane & 31, h = lane >> 5;
    const int q = w * 32 + l32;
    const unsigned ktoff = (unsigned)(t * 8);
    const unsigned vtoff = (unsigned)((t >> 3) * LDV + (t & 7) * 8);
    bf16x8 qf[NKS];
#pragma unroll
    for (int ks = 0; ks < NKS; ++ks) qf[ks] = *(const bf16x8*)(Qp + (size_t)q * LDQ + ks * 16 + 8 * h);
    f32x16 o[NMT];
#pragma unroll
    for (int mt = 0; mt < NMT; ++mt)
#pragma unroll
        for (int r = 0; r < 16; ++r) o[mt][r] = 0.f;
    float m = 0.f, lsum = 0.f;
    uint4 ak0, ak1, ak2, av0, av1, bk0, bk1, bk2, bv0, bv1;
#define M2_LOAD(S, kt) { const bf16_t* kb_ = Kp + (size_t)(kt) * 64 * DQK; S##k0 = *(const uint4*)(kb_ + ktoff); S##k1 = *(const uint4*)(kb_ + 2048 + ktoff); S##k2 = *(const uint4*)(kb_ + 4096 + ktoff); \
        const bf16_t* vb_ = Vtp + (kt) * 64; S##v0 = *(const uint4*)(vb_ + vtoff); S##v1 = *(const uint4*)(vb_ + (size_t)32 * LDV + vtoff); }
#define M2_SK(i, R, buf) { int c = t + 256 * (i), row = c / CPR, cc = c - row * CPR; *(uint4*)(Ks + (buf) * 64 * KP + swap23(row) * KP + cc * 8) = R; }
#define M2_SV(i, R, buf) { int c = t + 256 * (i), d = c >> 3, cc = c & 7; *(uint4*)(Vs + (buf) * DV * VP + d * VP + cc * 8) = R; }
#define M2_STORE(S, buf) { M2_SK(0, S##k0, buf) M2_SK(1, S##k1, buf) M2_SK(2, S##k2, buf) M2_SV(0, S##v0, buf) M2_SV(1, S##v1, buf) }
#define M2_COMPUTE(buf) { \
        if (__builtin_amdgcn_ballot_w64(alpha != 1.f) != 0ull) { \
            _Pragma("unroll") for (int mt = 0; mt < NMT; ++mt) _Pragma("unroll") for (int r = 0; r < 16; ++r) o[mt][r] *= alpha; } \
        lsum *= alpha; \
        const bf16_t* kb = Ks + (buf) * 64 * KP + l32 * KP + 8 * h; \
        f32x16 s0, s1; \
        const float nm = -m; \
        _Pragma("unroll") for (int r = 0; r < 16; ++r) { s0[r] = nm; s1[r] = nm; } \
        _Pragma("unroll") for (int ks = 0; ks < NKS; ++ks) { bf16x8 k0 = *(const bf16x8*)(kb + ks * 16); bf16x8 k1 = *(const bf16x8*)(kb + 32 * KP + ks * 16); s0 = MFMA(k0, qf[ks], s0); s1 = MFMA(k1, qf[ks], s1); } \
        float mx = s0[0]; \
        _Pragma("unroll") for (int r = 1; r < 16; ++r) mx = fmaxf(mx, s0[r]); \
        _Pragma("unroll") for (int r = 0; r < 16; ++r) mx = fmaxf(mx, s1[r]); \
        mx = fmaxf(mx, __shfl_xor(mx, 32)); \
        float psum = 0.f; \
        _Pragma("unroll") for (int r = 0; r < 16; ++r) { s0[r] = ex2(s0[r]); psum += s0[r]; } \
        _Pragma("unroll") for (int r = 0; r < 16; ++r) { s1[r] = ex2(s1[r]); psum += s1[r]; } \
        lsum += psum; \
        const float dgrow = fmaxf(mx, 0.f); alpha = ex2(-dgrow); m += dgrow; \
        const bf16_t* vb = Vs + (buf) * DV * VP + l32 * VP + 8 * h; \
        _Pragma("unroll") for (int s2 = 0; s2 < 2; ++s2) { \
            u32x4 pu0, pu1; \
            _Pragma("unroll") for (int j = 0; j < 4; ++j) { pu0[j] = pack2(s0[8 * s2 + 2 * j], s0[8 * s2 + 2 * j + 1]); pu1[j] = pack2(s1[8 * s2 + 2 * j], s1[8 * s2 + 2 * j + 1]); } \
            const bf16x8 pf0 = __builtin_bit_cast(bf16x8, pu0), pf1 = __builtin_bit_cast(bf16x8, pu1); \
            _Pragma("unroll") for (int mt = 0; mt < NMT; ++mt) { \
                bf16x8 v0 = *(const bf16x8*)(vb + mt * 32 * VP + s2 * 16); bf16x8 v1 = *(const bf16x8*)(vb + mt * 32 * VP + 32 + s2 * 16); \
                o[mt] = MFMA(v0, pf0, o[mt]); o[mt] = MFMA(v1, pf1, o[mt]); } } }

    float alpha = 1.f;
    __syncthreads();
    M2_LOAD(a, 0);
    M2_LOAD(b, 1);
    {
        M2_STORE(a, 0);
        __syncthreads();
        const bf16_t* kb = Ks + l32 * KP + 8 * h;
        f32x16 s0, s1;
#pragma unroll
        for (int r = 0; r < 16; ++r) { s0[r] = 0.f; s1[r] = 0.f; }
#pragma unroll
        for (int ks = 0; ks < NKS; ++ks) { bf16x8 k0 = *(const bf16x8*)(kb + ks * 16); bf16x8 k1 = *(const bf16x8*)(kb + 32 * KP + ks * 16); s0 = MFMA(k0, qf[ks], s0); s1 = MFMA(k1, qf[ks], s1); }
        float mx = s0[0];
#pragma unroll
        for (int r = 1; r < 16; ++r) mx = fmaxf(mx, s0[r]);
#pragma unroll
        for (int r = 0; r < 16; ++r) mx = fmaxf(mx, s1[r]);
        m = fmaxf(mx, __shfl_xor(mx, 32));
        __syncthreads();
    }
    for (int kt = 0; kt < NKT; kt += 2) {
        M2_STORE(a, 0);
        __syncthreads();
        M2_LOAD(a, min(kt + 2, NKT - 1));
        M2_COMPUTE(0);
        M2_STORE(b, 1);
        __syncthreads();
        M2_LOAD(b, min(kt + 3, NKT - 1));
        M2_COMPUTE(1);
    }
#undef M2_LOAD
#undef M2_SK
#undef M2_SV
#undef M2_STORE
#undef M2_COMPUTE
    const float inv = 1.f / (lsum + __shfl_xor(lsum, 32));
#pragma unroll
    for (int mt = 0; mt < NMT; ++mt)
#pragma unroll
        for (int g = 0; g < 4; ++g) {
            float v0 = o[mt][4 * g] * inv, v1 = o[mt][4 * g + 1] * inv, v2 = o[mt][4 * g + 2] * inv, v3 = o[mt][4 * g + 3] * inv;
            uint2 pk; pk.x = pack2(v0, v1); pk.y = pack2(v2, v3);
            float r0 = bflo(pk.x), r1 = bfhi(pk.x), r2 = bflo(pk.y), r3 = bfhi(pk.y);
            ssq += r0 * r0 + r1 * r1 + r2 * r2 + r3 * r3;
            *(uint2*)(Op + (size_t)q * LDO + mt * 32 + 8 * g + 4 * h) = pk;
        }
}

DI void mla_item(KP p, int item, char* smem) {
    const int b = item >> 6, qb = item & 63;
    const bf16_t* Q = (const bf16_t*)(p->ws + OFF_Q);
    const bf16_t* K = (const bf16_t*)(p->ws + OFF_K);
    const bf16_t* Vt = (const bf16_t*)(p->ws + OFF_VT);
    bf16_t* om = (bf16_t*)(p->ws + OFF_OMIX) + ((size_t)b * SEQ + qb * 128) * DM;
    float ssq = 0.f;
    for (int hd = 0; hd < 8; ++hd) {
        const size_t bh = (size_t)(b * 8 + hd);
        flash_mla2(Q + (bh * SEQ + qb * 128) * 96, K + bh * SEQ * 96, Vt + bh * 64 * SEQ, om + hd * 64, smem, ssq);
    }
    ssq += __shfl_xor(ssq, 32);
    const float sc = rsqrtf(ssq * (1.f / 512.f) + EPS);
    const int lane = tid() & 63, w = tid() >> 6, q = w * 32 + (lane & 31), h = lane >> 5;
    for (int i = 0; i < 64; ++i) {
        uint2* ptr = (uint2*)(om + (size_t)q * DM + (i >> 3) * 64 + ((i >> 2) & 1) * 32 + (i & 3) * 8 + 4 * h);
        uint2 v = *ptr;
        v.x = pack2(bflo(v.x) * sc, bfhi(v.x) * sc);
        v.y = pack2(bflo(v.y) * sc, bfhi(v.y) * sc);
        *ptr = v;
    }
}

DI void memattn_item(KP p, int l, int item, char* smem) {
    const int head = item & 3, qt = (item >> 2) & 127, b = item >> 9;
    const bf16_t* qm = (const bf16_t*)(p->ws + OFF_QM) + ((size_t)b * SEQ + qt * 64) * DM + head * 256;
    const bf16_t* km = (const bf16_t*)(p->ws + OFF_KMEM) + ((size_t)((l * NBATCH + b) * 4 + head)) * 256 * 256;
    const bf16_t* vm = (const bf16_t*)(p->ws + OFF_VMEM) + ((size_t)((l * NBATCH + b) * 4 + head)) * 256 * 256;
    bf16_t* om = (bf16_t*)(p->ws + OFF_OMEM) + ((size_t)b * SEQ + qt * 64) * DM + head * 256;
    float dummy = 0.f;
    flash_item<256, 256, 1, true, 2, DM, 256, 256, DM>(qm, km, vm, 4, om, smem, dummy);
}

DI void gmlp_item(KP p, int l, int ci, char* smem) {
    constexpr int AP = 136;
    bf16_t* As = (bf16_t*)smem;
    bf16_t* Bs = As + 128 * AP;
    float* st = (float*)(Bs + 64 * AP);
    const int t = tid(), lane = t & 63, w = __builtin_amdgcn_readfirstlane(t >> 6), l32 = lane & 31, h = lane >> 5;
    const int tok0 = ci * 128;
    const bf16_t* vbuf = (const bf16_t*)(p->ws + OFF_V) + (size_t)tok0 * 512;
    const bf16_t* ubuf = (const bf16_t*)(p->ws + OFF_U) + (size_t)(tok0 + w * 32) * 512;
    bf16_t* om = (bf16_t*)(p->ws + OFF_OMIX) + (size_t)(tok0 + w * 32) * DM + 512;
    const bf16_t* wsg = (const bf16_t*)(p->ws + OFF_WSG) + (size_t)l * 8 * 128 * 128;
    const float* lng = p->sg_ln_g + l * 512; const float* lnb = p->sg_ln_b + l * 512;
    const float* bs = p->sg_b_s + l * 8 * 128 + w * 32;
    __syncthreads();
    {
        const int row = t >> 1, half = t & 1;
        const uint4* src = (const uint4*)(vbuf + (size_t)row * 512 + half * 256);
        float s = 0.f, s2 = 0.f;
#pragma unroll 4
        for (int i = 0; i < 32; ++i) {
            uint4 qv = src[i];
            float a0 = bflo(qv.x), a1 = bfhi(qv.x), a2 = bflo(qv.y), a3 = bfhi(qv.y), a4 = bflo(qv.z), a5 = bfhi(qv.z), a6 = bflo(qv.w), a7 = bfhi(qv.w);
            s += a0 + a1 + a2 + a3 + a4 + a5 + a6 + a7;
            s2 += a0 * a0 + a1 * a1 + a2 * a2 + a3 * a3 + a4 * a4 + a5 * a5 + a6 * a6 + a7 * a7;
        }
        s += __shfl_xor(s, 1); s2 += __shfl_xor(s2, 1);
        const float mean = s * (1.f / 512.f);
        const float var = fmaxf(s2 * (1.f / 512.f) - mean * mean, 0.f);
        if (half == 0) { st[2 * row] = mean; st[2 * row + 1] = rsqrtf(var + EPS); }
    }
    __syncthreads();
    float rq0 = 0.f, rq1 = 0.f, rq2 = 0.f, rq3 = 0.f;
    const bf16_t* ub0 = (const bf16_t*)(p->ws + OFF_U) + (size_t)tok0 * 512;
    bf16_t* om0 = (bf16_t*)(p->ws + OFF_OMIX) + (size_t)tok0 * DM + 512;
    const unsigned wtoff = (unsigned)((t >> 4) * 128 + (t & 15) * 8);
    const unsigned vtoff = (unsigned)((t >> 3) * 512 + (t & 7) * 8);
    const unsigned eoff_u = (unsigned)(4 * h * 512 + l32), eoff_o = (unsigned)(4 * h * DM + l32);
    for (int hd = 0; hd < 8; ++hd) {
        const bf16_t* wh = wsg + (size_t)hd * 128 * 128;
#pragma unroll
        for (int i = 0; i < 8; ++i)
            *(uint4*)(As + ((t >> 4) + 16 * i) * AP + (t & 15) * 8) = *(const uint4*)(wh + i * 16 * 128 + wtoff);
#pragma unroll
        for (int i = 0; i < 4; ++i) {
            const int j = (t >> 3) + 32 * i, c8 = t & 7;
            uint4 qv = *(const uint4*)(vbuf + (size_t)i * 32 * 512 + hd * 64 + vtoff);
            const float mean = st[2 * j], rstd = st[2 * j + 1];
            const int ch = hd * 64 + c8 * 8;
            const float4 g0 = *(const float4*)(lng + ch), g1 = *(const float4*)(lng + ch + 4);
            const float4 b0 = *(const float4*)(lnb + ch), b1 = *(const float4*)(lnb + ch + 4);
            bf16_t* bd = Bs + (c8 * 8) * AP + j;
            bd[0 * AP] = f2bf((bflo(qv.x) - mean) * rstd * g0.x + b0.x);
            bd[1 * AP] = f2bf((bfhi(qv.x) - mean) * rstd * g0.y + b0.y);
            bd[2 * AP] = f2bf((bflo(qv.y) - mean) * rstd * g0.z + b0.z);
            bd[3 * AP] = f2bf((bfhi(qv.y) - mean) * rstd * g0.w + b0.w);
            bd[4 * AP] = f2bf((bflo(qv.z) - mean) * rstd * g1.x + b1.x);
            bd[5 * AP] = f2bf((bfhi(qv.z) - mean) * rstd * g1.y + b1.y);
            bd[6 * AP] = f2bf((bflo(qv.w) - mean) * rstd * g1.z + b1.z);
            bd[7 * AP] = f2bf((bfhi(qv.w) - mean) * rstd * g1.w + b1.w);
        }
        __syncthreads();
        f32x16 acc[2];
#pragma unroll
        for (int r = 0; r < 16; ++r) { acc[0][r] = 0.f; acc[1][r] = 0.f; }
        const bf16_t* a_s = As + (w * 32 + l32) * AP + 8 * h;
        const bf16_t* b_s = Bs + l32 * AP + 8 * h;
#pragma unroll
        for (int ks = 0; ks < 8; ++ks) {
            bf16x8 a = *(const bf16x8*)(a_s + ks * 16);
            bf16x8 b0 = *(const bf16x8*)(b_s + ks * 16);
            bf16x8 b1 = *(const bf16x8*)(b_s + 32 * AP + ks * 16);
            acc[0] = MFMA(a, b0, acc[0]);
            acc[1] = MFMA(a, b1, acc[1]);
        }
        __syncthreads();
        float* stgf = (float*)As;
#pragma unroll
        for (int j2 = 0; j2 < 2; ++j2)
#pragma unroll
            for (int r = 0; r < 16; ++r) {
                const int rr = (r & 3) + 8 * (r >> 2);
                stgf[(w * 32 + rr + 4 * h) * 68 + j2 * 32 + l32] = acc[j2][r] + (bs + hd * 128 + rr)[4 * h];
            }
        __syncthreads();
#pragma unroll
        for (int i = 0; i < 4; ++i) {
            const int row = (t >> 3) + 32 * i, c8 = t & 7;
            const float4 lo = *(const float4*)(stgf + row * 68 + c8 * 8), hi = *(const float4*)(stgf + row * 68 + c8 * 8 + 4);
            const uint4 uv = *(const uint4*)(ub0 + (size_t)row * 512 + hd * 64 + c8 * 8);
            uint4 ov;
            ov.x = pack2(bflo(uv.x) * lo.x, bfhi(uv.x) * lo.y); ov.y = pack2(bflo(uv.y) * lo.z, bfhi(uv.y) * lo.w);
            ov.z = pack2(bflo(uv.z) * hi.x, bfhi(uv.z) * hi.y); ov.w = pack2(bflo(uv.w) * hi.z, bfhi(uv.w) * hi.w);
            *(uint4*)(om0 + (size_t)row * DM + hd * 64 + c8 * 8) = ov;
            const float q0 = bflo(ov.x), q1 = bfhi(ov.x), q2 = bflo(ov.y), q3 = bfhi(ov.y), q4 = bflo(ov.z), q5 = bfhi(ov.z), q6 = bflo(ov.w), q7 = bfhi(ov.w);
            const float sqp = q0 * q0 + q1 * q1 + q2 * q2 + q3 * q3 + q4 * q4 + q5 * q5 + q6 * q6 + q7 * q7;
            if (i == 0) rq0 += sqp; else if (i == 1) rq1 += sqp; else if (i == 2) rq2 += sqp; else rq3 += sqp;
        }
        __syncthreads();
    }
#define GM_FIN(RQ, i) { float s_ = RQ; s_ += __shfl_xor(s_, 1); s_ += __shfl_xor(s_, 2); s_ += __shfl_xor(s_, 4); const float sc_ = rsqrtf(s_ * (1.f / 512.f) + EPS); \
        const int row = (t >> 3) + 32 * (i), c8 = t & 7; \
        for (int hd = 0; hd < 8; ++hd) { uint4* ptr = (uint4*)(om0 + (size_t)row * DM + hd * 64 + c8 * 8); uint4 v = *ptr; \
            v.x = pack2(bflo(v.x) * sc_, bfhi(v.x) * sc_); v.y = pack2(bflo(v.y) * sc_, bfhi(v.y) * sc_); v.z = pack2(bflo(v.z) * sc_, bfhi(v.z) * sc_); v.w = pack2(bflo(v.w) * sc_, bfhi(v.w) * sc_); *ptr = v; } }
    GM_FIN(rq0, 0) GM_FIN(rq1, 1) GM_FIN(rq2, 2) GM_FIN(rq3, 3)
#undef GM_FIN
}

DI void ph_memkv(KP p, char* smem) {
    for_tiles(DEPTH * 16 * 16, [&](int t) __attribute__((always_inline)) {
        const int l = t >> 8, rt = (t >> 4) & 15, ct = t & 15;
        f32x16 acc[2][2];
        gemm_tile<1>((const bf16_t*)(p->ws + OFF_MEMB), DM, rt * 128, 0, NBATCH * NMEM, (const bf16_t*)(p->ws + OFF_WMKV) + ((size_t)l * 2048 + ct * 128) * DM, DM, DM, smem, acc);
        EpiMemKV e{(bf16_t*)(p->ws + OFF_KMEM) + (size_t)l * NBATCH * 4 * 256 * 256, (bf16_t*)(p->ws + OFF_VMEM) + (size_t)l * NBATCH * 4 * 256 * 256,
                   (const float*)(smem + RS_OFF), rt * 128, ct * 128};
        run_epi(acc, e);
    });
}
DI float* stage_tile(const f32x16 (&acc)[2][2], const float* rs, char* smem) {
    const int tt = tid(), lane = tt & 63, w = __builtin_amdgcn_readfirstlane(tt >> 6), wm = w >> 1, wn = w & 1, l32 = lane & 31, h = lane >> 5;
    float* stg = (float*)smem;
#pragma unroll
    for (int i = 0; i < 2; ++i)
#pragma unroll
        for (int j = 0; j < 2; ++j)
#pragma unroll
            for (int r = 0; r < 16; ++r) {
                const int row = wm * 64 + i * 32 + crow(r, h);
                stg[row * 132 + wn * 64 + j * 32 + l32] = rs ? acc[i][j][r] * rs[row] : acc[i][j][r];
            }
    __syncthreads();
    return stg;
}
DI void st_nt16(void* p, const uint4& v) { u32x4 t = {v.x, v.y, v.z, v.w}; __builtin_nontemporal_store(t, (u32x4*)p); }
DI void st_nt4(unsigned* p, unsigned v) { __builtin_nontemporal_store(v, p); }
DI uint4 pack8(const float4& a, const float4& b) { uint4 o; o.x = pack2(a.x, a.y); o.y = pack2(a.z, a.w); o.z = pack2(b.x, b.y); o.w = pack2(b.z, b.w); return o; }
DI float4 gelu4(const float4& a) { float4 o; o.x = gelu_tanh(a.x); o.y = gelu_tanh(a.y); o.z = gelu_tanh(a.z); o.w = gelu_tanh(a.w); return o; }
DI void rope8(float4& lo, float4& hi, const float4& plo, const float4& phi, const float* cs, const float* sn, int c) {
    const float4 c0 = *(const float4*)(cs + (c & 15)), c1 = *(const float4*)(cs + (c & 15) + 4);
    const float4 s0 = *(const float4*)(sn + (c & 15)), s1 = *(const float4*)(sn + (c & 15) + 4);
    const float sg = c < 16 ? -1.f : 1.f;
    lo.x = lo.x * c0.x + sg * plo.x * s0.x; lo.y = lo.y * c0.y + sg * plo.y * s0.y; lo.z = lo.z * c0.z + sg * plo.z * s0.z; lo.w = lo.w * c0.w + sg * plo.w * s0.w;
    hi.x = hi.x * c1.x + sg * phi.x * s1.x; hi.y = hi.y * c1.y + sg * phi.y * s1.y; hi.z = hi.z * c1.z + sg * phi.z * s1.z; hi.w = hi.w * c1.w + sg * phi.w * s1.w;
}

DI void ph_in(KP p, int l, const float* xin, char* smem) {
    for_tiles(512 * 12, [&](int t) __attribute__((always_inline)) {
        int rt, ct; tile_rc(t, 12, rt, ct);
        f32x16 acc[2][2];
        const float rsp = rs_load(p, rt * 128);
        gemm_tile<0, true>((const bf16_t*)(p->ws + OFF_XB), DM, rt * 128, 0, TOK, (const bf16_t*)(p->ws + OFF_WIN) + ((size_t)l * INCP + ct * 128) * DM, DM, DM, smem, acc);
        rs_finish(rsp, rt * 128, smem);
        const float* stg = stage_tile(acc, (const float*)(smem + RS_OFF), smem);
        const int tt = tid(), c8 = tt & 15, nb = ct * 128 + c8 * 8;
        if (nb < INC) {
#pragma unroll
            for (int i = 0; i < 8; ++i) {
                const int row = (tt >> 4) + 16 * i, tok = rt * 128 + row;
                float4 lo = *(const float4*)(stg + row * 132 + c8 * 8), hi = *(const float4*)(stg + row * 132 + c8 * 8 + 4);
                if (nb < 256) st_nt16((bf16_t*)(p->ws + OFF_HQ) + (size_t)tok * 256 + nb, pack8(lo, hi));
                else if (nb < 384) st_nt16((bf16_t*)(p->ws + OFF_HKV) + (size_t)tok * 128 + (nb - 256), pack8(lo, hi));
                else if (nb < 416) {
                    const int c = nb - 384, pc = c8 * 8 + (c < 16 ? 16 : -16);
                    const float4 plo = *(const float4*)(stg + row * 132 + pc), phi = *(const float4*)(stg + row * 132 + pc + 4);
                    rope8(lo, hi, plo, phi, (const float*)(p->ws + OFF_COS) + (size_t)tok * 16, (const float*)(p->ws + OFF_SIN) + (size_t)tok * 16, c);
                    const uint4 ov = pack8(lo, hi);
                    const int b = tok >> 13, sx = tok & 8191;
                    bf16_t* dst = (bf16_t*)(p->ws + OFF_K) + (((size_t)(b * 8)) * SEQ + sx) * 96 + 64 + c;
#pragma unroll
                    for (int hd = 0; hd < 8; ++hd) st_nt16(dst + (size_t)hd * SEQ * 96, ov);
                } else if (nb < 928) st_nt16((bf16_t*)(p->ws + OFF_U) + (size_t)tok * 512 + (nb - 416), pack8(gelu4(lo), gelu4(hi)));
                else st_nt16((bf16_t*)(p->ws + OFF_V) + (size_t)tok * 512 + (nb - 928), pack8(gelu4(lo), gelu4(hi)));
            }
        }
    });
}
DI void ph_qkv(KP p, int l, char* smem) {
    for_tiles(512 * 14, [&](int t) __attribute__((always_inline)) {
        int rt, ct; tile_rc(t, 14, rt, ct);
        f32x16 acc[2][2];
        if (ct < 6) {
            gemm_tile<1>((const bf16_t*)(p->ws + OFF_HQ), QL, rt * 128, 0, TOK, (const bf16_t*)(p->ws + OFF_WUQ) + ((size_t)l * 768 + ct * 128) * QL, QL, QL, smem, acc);
            const float* stg = stage_tile(acc, (const float*)(smem + RS_OFF), smem);
            const int tt = tid(), c8 = tt & 15, n8 = ct * 128 + c8 * 8, head = n8 / 96, w0 = n8 - head * 96;
            const float qs = 0.10206207261596575f * LOG2E;
#pragma unroll
            for (int i = 0; i < 8; ++i) {
                const int row = (tt >> 4) + 16 * i, tok = rt * 128 + row;
                float4 lo = *(const float4*)(stg + row * 132 + c8 * 8), hi = *(const float4*)(stg + row * 132 + c8 * 8 + 4);
                if (w0 >= 64) {
                    const int c = w0 - 64, pc = c8 * 8 + (c < 16 ? 16 : -16);
                    const float4 plo = *(const float4*)(stg + row * 132 + pc), phi = *(const float4*)(stg + row * 132 + pc + 4);
                    rope8(lo, hi, plo, phi, (const float*)(p->ws + OFF_COS) + (size_t)tok * 16, (const float*)(p->ws + OFF_SIN) + (size_t)tok * 16, c);
                }
                lo.x *= qs; lo.y *= qs; lo.z *= qs; lo.w *= qs; hi.x *= qs; hi.y *= qs; hi.z *= qs; hi.w *= qs;
                const int b = tok >> 13, sx = tok & 8191;
                st_nt16((bf16_t*)(p->ws + OFF_Q) + (((size_t)(b * 8 + head)) * SEQ + sx) * 96 + w0, pack8(lo, hi));
            }
        } else {
            const int c2 = ct - 6;
            gemm_tile<1>((const bf16_t*)(p->ws + OFF_HKV), KVL, rt * 128, 0, TOK, (const bf16_t*)(p->ws + OFF_WUKV) + ((size_t)l * 1024 + c2 * 128) * KVL, KVL, KVL, smem, acc);
            const float* stg = stage_tile(acc, (const float*)(smem + RS_OFF), smem);
            const int tt = tid(), tok0 = rt * 128, b = tok0 >> 13, s0 = tok0 & 8191;
            {
                const int c8 = tt & 7;
#pragma unroll
                for (int i = 0; i < 4; ++i) {
                    const int row = (tt >> 3) + 32 * i;
                    const float4 lo = *(const float4*)(stg + row * 132 + c8 * 8), hi = *(const float4*)(stg + row * 132 + c8 * 8 + 4);
                    st_nt16((bf16_t*)(p->ws + OFF_K) + (((size_t)(b * 8 + c2)) * SEQ + s0 + row) * 96 + c8 * 8, pack8(lo, hi));
                }
            }
            {
                const int tc = tt & 15;
#pragma unroll
                for (int i = 0; i < 4; ++i) {
                    const int d = (tt >> 4) + 16 * i;
                    const float* sp = stg + (tc * 8) * 132 + 64 + d;
                    uint4 ov;
                    ov.x = pack2(sp[0], sp[132]); ov.y = pack2(sp[2 * 132], sp[3 * 132]); ov.z = pack2(sp[4 * 132], sp[5 * 132]); ov.w = pack2(sp[6 * 132], sp[7 * 132]);
                    st_nt16((bf16_t*)(p->ws + OFF_VT) + (((size_t)(b * 8 + c2)) * 64 + d) * SEQ + s0 + tc * 8, ov);
                }
            }
        }
    });
}
DI void ph_mix(KP p, int l, char* smem) {
    for_tiles(512, [&](int t) __attribute__((always_inline)) { mla_item(p, t, smem); });
    for_tiles(512, [&](int t) __attribute__((always_inline)) { gmlp_item(p, l, t, smem); });
}
DI void ph_res(KP p, const bf16_t* A, int K, const bf16_t* Wt, const float* xin, char* smem, bool dry) {
    for_tiles(512 * 8, [&](int t) __attribute__((always_inline)) {
        int rt, ct; tile_rc(t, 8, rt, ct);
        f32x16 acc[2][2];
        gemm_tile<0>(A, K, rt * 128, 0, TOK, Wt + (size_t)ct * 128 * K, K, K, smem, acc);
        if (dry) return;
        const int tt = tid(), lane = tt & 63, w = __builtin_amdgcn_readfirstlane(tt >> 6), wm = w >> 1, wn = w & 1, l32 = lane & 31, h = lane >> 5;
        float* stg = (float*)smem;
#pragma unroll
        for (int i = 0; i < 2; ++i)
#pragma unroll
            for (int j = 0; j < 2; ++j)
#pragma unroll
                for (int r = 0; r < 16; ++r) stg[(wm * 64 + i * 32 + crow(r, h)) * 132 + wn * 64 + j * 32 + l32] = acc[i][j][r];
        __syncthreads();
        bf16_t* xb = (bf16_t*)(p->ws + OFF_XB) + (size_t)(rt * 128) * DM + ct * 128;
        float* part = (float*)(p->ws + OFF_RSC) + (size_t)(rt * 128) * 16 + ct * 2;
        const int c8 = tt & 15;
#pragma unroll
        for (int i = 0; i < 8; ++i) {
            const int row = (tt >> 4) + 16 * i;
            const float4 lo = *(const float4*)(stg + row * 132 + c8 * 8), hi = *(const float4*)(stg + row * 132 + c8 * 8 + 4);
            uint4* gp = (uint4*)(xb + (size_t)row * DM + c8 * 8);
            const uint4 xv = *gp;
            uint4 nv;
            nv.x = pack2h(hlo(xv.x) + lo.x, hhi(xv.x) + lo.y); nv.y = pack2h(hlo(xv.y) + lo.z, hhi(xv.y) + lo.w);
            nv.z = pack2h(hlo(xv.z) + hi.x, hhi(xv.z) + hi.y); nv.w = pack2h(hlo(xv.w) + hi.z, hhi(xv.w) + hi.w);
            *gp = nv;
            float s0 = hlo(nv.x), s1 = hhi(nv.x), s2 = hlo(nv.y), s3 = hhi(nv.y), s4 = hlo(nv.z), s5 = hhi(nv.z), s6 = hlo(nv.w), s7 = hhi(nv.w);
            float sq = s0 * s0 + s1 * s1 + s2 * s2 + s3 * s3 + s4 * s4 + s5 * s5 + s6 * s6 + s7 * s7;
            sq += __shfl_xor(sq, 1); sq += __shfl_xor(sq, 2); sq += __shfl_xor(sq, 4); sq += __shfl_xor(sq, 8);
            if (c8 == 0) { float2 pv; pv.x = sq; pv.y = 0.f; *(float2*)(part + (size_t)row * 16) = pv; }
        }
    });
}
DI void ph_qm(KP p, int l, char* smem) {
    for_tiles(512 * 8, [&](int t) __attribute__((always_inline)) {
        int rt, ct; tile_rc(t, 8, rt, ct);
        f32x16 acc[2][2];
        const float rsp = rs_load(p, rt * 128);
        gemm_tile<0, true>((const bf16_t*)(p->ws + OFF_XB), DM, rt * 128, 0, TOK, (const bf16_t*)(p->ws + OFF_WMQ) + ((size_t)l * DM + ct * 128) * DM, DM, DM, smem, acc);
        rs_finish(rsp, rt * 128, smem);
        const float* stg = stage_tile(acc, (const float*)(smem + RS_OFF), smem);
        const int tt = tid(), c8 = tt & 15;
        const float qs = 0.0625f * LOG2E;
#pragma unroll
        for (int i = 0; i < 8; ++i) {
            const int row = (tt >> 4) + 16 * i;
            float4 lo = *(const float4*)(stg + row * 132 + c8 * 8), hi = *(const float4*)(stg + row * 132 + c8 * 8 + 4);
            lo.x *= qs; lo.y *= qs; lo.z *= qs; lo.w *= qs; hi.x *= qs; hi.y *= qs; hi.z *= qs; hi.w *= qs;
            st_nt16((bf16_t*)(p->ws + OFF_QM) + (size_t)(rt * 128 + row) * DM + ct * 128 + c8 * 8, pack8(lo, hi));
        }
    });
}
DI void ph_memattn(KP p, int l, char* smem) {
    for_tiles(NBATCH * 128 * 4, [&](int t) __attribute__((always_inline)) { memattn_item(p, l, t, smem); });
}
typedef float f32p __attribute__((ext_vector_type(2)));
DI void ph_up(KP p, int l, char* smem) {
    for_tiles(NBATCH * 66 * 44, [&](int t) __attribute__((always_inline)) {
        int rt, ct; tile_rc(t, 44, rt, ct);
        const int b = rt / 66, rl = rt - b * 66, s0 = rl * 126;
        const float* cw = p->conv_w + (size_t)l * 3 * 2 * DFF; const float* cb = p->conv_b + (size_t)l * 2 * DFF;
        const int cp2 = (tid() & 31) * 2, c = ct * 64 + cp2, c2 = DFF + c;
        const f32p g0 = *(const f32p*)(cw + c), g1 = *(const f32p*)(cw + 2 * DFF + c), g2 = *(const f32p*)(cw + 4 * DFF + c), gb = *(const f32p*)(cb + c);
        const f32p u0 = *(const f32p*)(cw + c2), u1 = *(const f32p*)(cw + 2 * DFF + c2), u2 = *(const f32p*)(cw + 4 * DFF + c2), ub = *(const f32p*)(cb + c2);
        f32x16 acc[2][2];
        const float rsp = rs_load(p, b * SEQ + s0 - 1);
        if (rl == 0 || rl == 65) gemm_tile<0, true, true>((const bf16_t*)(p->ws + OFF_XB), DM, b * SEQ + s0 - 1, b * SEQ, (b + 1) * SEQ, (const bf16_t*)(p->ws + OFF_WUP) + ((size_t)l * 2 * DFF + ct * 128) * DM, DM, DM, smem, acc);
        else gemm_tile<0, true, false>((const bf16_t*)(p->ws + OFF_XB), DM, b * SEQ + s0 - 1, b * SEQ, (b + 1) * SEQ, (const bf16_t*)(p->ws + OFF_WUP) + ((size_t)l * 2 * DFF + ct * 128) * DM, DM, DM, smem, acc);
        rs_finish(rsp, b * SEQ + s0 - 1, smem);
        const float* rs = (const float*)(smem + RS_OFF);
        float* stg = (float*)smem;
        const int tt = tid(), lane = tt & 63, w = __builtin_amdgcn_readfirstlane(tt >> 6), wm = w >> 1, wn = w & 1, l32 = lane & 31, h = lane >> 5;
#pragma unroll
        for (int i = 0; i < 2; ++i)
#pragma unroll
            for (int j = 0; j < 2; ++j)
#pragma unroll
                for (int r = 0; r < 16; ++r) {
                    const int row = wm * 64 + i * 32 + crow(r, h), col = wn * 64 + j * 32 + l32;
                    stg[row * 130 + col] = acc[i][j][r] * rs[row];
                }
        __syncthreads();
        bf16_t* act = (bf16_t*)(p->ws + OFF_ACT);
        const int rmax = min(126, SEQ - s0);
        const int rbeg = w * 32 + h * 16, rend = min(rbeg + 16, rmax);
        if (rbeg < rend) {
            const float* sg = stg + rbeg * 130 + cp2;
            unsigned* arow = (unsigned*)(act + ((size_t)b * SEQ + s0 + rbeg) * DFF + c);
            f32p ga = *(const f32p*)sg, gm = *(const f32p*)(sg + 130), ua = *(const f32p*)(sg + 64), um = *(const f32p*)(sg + 130 + 64);
#pragma unroll 4
            for (int r = rbeg; r < rend; ++r) {
                sg += 130;
                const f32p gn = *(const f32p*)(sg + 130), un = *(const f32p*)(sg + 130 + 64);
                const f32p g = g0 * ga + g1 * gm + g2 * gn + gb;
                const f32p up = u0 * ua + u1 * um + u2 * un + ub;
                const f32p e = g * (-LOG2E);
                f32p den; den.x = 1.f + ex2(e.x); den.y = 1.f + ex2(e.y);
                f32p sig; sig.x = __builtin_amdgcn_rcpf(den.x); sig.y = __builtin_amdgcn_rcpf(den.y);
                const f32p o = g * sig * up;
                st_nt4(arow, pack2(o.x, o.y));
                arow += DFF / 2;
                ga = gm; gm = gn; ua = um; um = un;
            }
        }
    });
}
DI void ph_final(KP p) {
    const int lane = tid() & 63, wv = blockIdx.x * 4 + (tid() >> 6), nw = gridDim.x * 4;
    const bf16_t* xbp = (const bf16_t*)(p->ws + OFF_XB);
    const float* rsc = (const float*)(p->ws + OFF_RSC);
    for (int row = wv; row < TOK; row += nw) {
        const uint4* xr = (const uint4*)(xbp + (size_t)row * DM);
        float4* orow = (float4*)(p->out + (size_t)row * DM);
        float ps = lane < 16 ? rsc[(size_t)row * 16 + lane] : 0.f;
        ps += __shfl_xor(ps, 1); ps += __shfl_xor(ps, 2); ps += __shfl_xor(ps, 4); ps += __shfl_xor(ps, 8);
        const float sc = rsqrtf(__shfl(ps, 0) * (1.f / DM) + EPS);
#pragma unroll
        for (int i = 0; i < 2; ++i) {
            const uint4 v = xr[lane + 64 * i];
            const float4 g0 = ((const float4*)p->final_norm_g)[2 * (lane + 64 * i)], g1 = ((const float4*)p->final_norm_g)[2 * (lane + 64 * i) + 1];
            float4 o0, o1;
            o0.x = hlo(v.x) * sc * g0.x; o0.y = hhi(v.x) * sc * g0.y; o0.z = hlo(v.y) * sc * g0.z; o0.w = hhi(v.y) * sc * g0.w;
            o1.x = hlo(v.z) * sc * g1.x; o1.y = hhi(v.z) * sc * g1.y; o1.z = hlo(v.w) * sc * g1.z; o1.w = hhi(v.w) * sc * g1.w;
            orow[2 * (lane + 64 * i)] = o0; orow[2 * (lane + 64 * i) + 1] = o1;
        }
    }
}

#define XB_TMO      128
#define XB_XCNT(j)  (256  + 64 * (j))
#define XB_XSUB(j)  (1280 + 64 * (j))
#define XB_XGEN(j)  (2304 + 64 * (j))
#define XB_TOP      3328
#define XB_TOPGEN   3392
#define XCD_BAR_WORDS 3456
#define XB_SPIN_CAP (1u << 22)
#define LAS __attribute__((address_space(3)))
static_assert(XCD_BAR_WORDS * 4 <= BAR_BYTES, "barrier words");
DI unsigned xb_ld(unsigned* p) { return __hip_atomic_load(p, __ATOMIC_RELAXED, __HIP_MEMORY_SCOPE_AGENT); }
DI unsigned xb_add(unsigned* p, unsigned v) { return __hip_atomic_fetch_add(p, v, __ATOMIC_RELAXED, __HIP_MEMORY_SCOPE_AGENT); }
DI unsigned xb_xcc_id() { return (unsigned)__builtin_amdgcn_s_getreg((3 << 11) | 20) & 0xFu; }
#define XB_SPIN(cond, bar) do { unsigned _sp = 0; while (cond) { __builtin_amdgcn_s_sleep(1); \
    if ((++_sp & 255u) == 0u) { if (xb_ld(&(bar)[XB_TMO])) break; if (_sp > XB_SPIN_CAP) { atomicAdd(&(bar)[XB_TMO], 1u); break; } } } } while (0)
struct XcdBarrier { unsigned* bar; unsigned x; volatile LAS unsigned* st; };
DI XcdBarrier xcd_barrier_post(unsigned* bar, volatile LAS unsigned* st) {
    XcdBarrier b; b.bar = bar; b.x = xb_xcc_id(); b.st = st;
    if (threadIdx.x == 0) (void)xb_add(&bar[XB_XCNT(b.x)], 1u);
    return b;
}
DI void xcd_barrier_complete(unsigned* bar, unsigned x, unsigned& nloc, unsigned& nx) {
    const unsigned G = gridDim.x * gridDim.y * gridDim.z;
    unsigned sum, cnt, mine, sp = 0u;
    for (;;) {
        sum = 0u; cnt = 0u; mine = 0u;
#pragma unroll
        for (unsigned j = 0; j < 16; ++j) { const unsigned c = xb_ld(&bar[XB_XCNT(j)]); sum += c; cnt += (c > 0u) ? 1u : 0u; mine = (j == x) ? c : mine; }
        if (sum == G) break;
        __builtin_amdgcn_s_sleep(1);
        if ((++sp & 255u) == 0u) { if (xb_ld(&bar[XB_TMO])) break; if (sp > XB_SPIN_CAP) { atomicAdd(&bar[XB_TMO], 1u); break; } }
    }
    nloc = mine > 0u ? mine : 1u; nx = cnt > 0u ? cnt : 1u;
}
DI void xcd_barrier(const XcdBarrier& b) {
    asm volatile("s_waitcnt vmcnt(0)" ::: "memory");
    __syncthreads();
    if (threadIdx.x == 0) {
        unsigned* bar = b.bar;
        __builtin_amdgcn_s_waitcnt(0);
        unsigned nloc = b.st[0], nx = b.st[1];
        if (nloc == 0u) { xcd_barrier_complete(bar, b.x, nloc, nx); b.st[0] = nloc; b.st[1] = nx; }
        const unsigned old = xb_add(&bar[XB_XSUB(b.x)], 1u);
        const unsigned gen = old / nloc;
        if (old + 1u == (gen + 1u) * nloc) {
            __builtin_amdgcn_fence(__ATOMIC_RELEASE, "agent");
            asm volatile("s_waitcnt vmcnt(0)" ::: "memory");
            const unsigned og = xb_add(&bar[XB_TOP], 1u);
            const unsigned tg = og / nx;
            if (og + 1u == (tg + 1u) * nx) xb_add(&bar[XB_TOPGEN], 1u);
            else XB_SPIN(xb_ld(&bar[XB_TOPGEN]) == tg, bar);
            __builtin_amdgcn_fence(__ATOMIC_ACQUIRE, "agent");
            xb_add(&bar[XB_XGEN(b.x)], 1u);
            asm volatile("s_waitcnt vmcnt(0)" ::: "memory");
        } else {
            XB_SPIN(xb_ld(&bar[XB_XGEN(b.x)]) == gen, bar);
            __builtin_amdgcn_fence(__ATOMIC_ACQUIRE, "agent");
            asm volatile("s_waitcnt vmcnt(0)" ::: "memory");
        }
    }
    __syncthreads();
}

constexpr int NPHASE = 2 + 9 * DEPTH + 1;
__global__ void __launch_bounds__(256, 2) mk(Params p_unused, int lo, int hi) {
    extern __shared__ __attribute__((aligned(16))) char smem[];
    cg::grid_group grid = cg::this_grid();
    volatile LAS unsigned* xst = (volatile LAS unsigned*)(smem + RS_OFF + 512);
    if (threadIdx.x == 0) { xst[0] = 0u; xst[1] = 0u; xst[2] = 0u; xst[3] = 0u; }
    __syncthreads();
    const XcdBarrier xbar = xcd_barrier_post((unsigned*)(kparams()->ws + OFF_BAR), xst);
    for (int ph = lo; ph < hi; ++ph) {
        KP p = kparams();
        if (ph == 0) phase_setup(p, smem);
        else if (ph == 1) ph_memkv(p, smem);
        else if (ph == NPHASE - 1) ph_final(p);
        else {
            const int l = (ph - 2) / 9, s = (ph - 2) % 9;
            const float* xin = l == 0 ? p->x : p->out;
            const int reps = ((REPMASK >> s) & 1) ? 2 : 1;
            for (int rep = 0; rep < reps; ++rep) {
                const bool dry = rep + 1 < reps;
                switch (s) {
                    case 0: ph_in(p, l, xin, smem); break;
                    case 1: ph_qkv(p, l, smem); break;
                    case 2: ph_mix(p, l, smem); break;
                    case 3: ph_res(p, (const bf16_t*)(p->ws + OFF_OMIX), DM, (const bf16_t*)(p->ws + OFF_WOUT) + (size_t)l * DM * DM, xin, smem, dry); break;
                    case 4: ph_qm(p, l, smem); break;
                    case 5: ph_memattn(p, l, smem); break;
                    case 6: ph_res(p, (const bf16_t*)(p->ws + OFF_OMEM), DM, (const bf16_t*)(p->ws + OFF_WMO) + (size_t)l * DM * DM, p->out, smem, dry); break;
                    case 7: ph_up(p, l, smem); break;
                    case 8: ph_res(p, (const bf16_t*)(p->ws + OFF_ACT), DFF, (const bf16_t*)(p->ws + OFF_WDN) + (size_t)l * DM * DFF, p->out, smem, dry); break;
                }
                if (dry) xcd_barrier(xbar);
            }
        }
        if (ph + 1 < hi) { if (ph == 0) grid.sync(); else if (ph != 1) xcd_barrier(xbar); }
    }
}

extern "C" void kernel_launch(void* const* d_in, const int* in_sizes, int n_in, void* d_out, int out_size, void* d_ws, size_t ws_size, hipStream_t stream) {
    static int grid_blocks = 0;
    if (!grid_blocks) {
        int dev = 0, cus = 0, per_cu = 0;
        hipGetDevice(&dev);
        hipDeviceGetAttribute(&cus, hipDeviceAttributeMultiprocessorCount, dev);
        hipFuncSetAttribute((const void*)mk, hipFuncAttributeMaxDynamicSharedMemorySize, LDS_BYTES);
        hipOccupancyMaxActiveBlocksPerMultiprocessor(&per_cu, (const void*)mk, 256, LDS_BYTES);
        if (per_cu < 1) per_cu = 1;
        if (per_cu > 2) per_cu = 2;
        grid_blocks = cus * per_cu;
        if (ws_size < OFF_END) fprintf(stderr, "kernel_launch: workspace too small: %zu < %zu\n", ws_size, (size_t)OFF_END);
    }
    Params p{};
    const float** fp = (const float**)&p;
    p.x = (const float*)d_in[0]; p.mem = (const float*)d_in[1]; p.pos = (const int*)d_in[2];
    p.norm_mix_g = (const float*)d_in[3]; p.w_in = (const float*)d_in[4]; p.q_norm_g = (const float*)d_in[5]; p.w_uq = (const float*)d_in[6];
    p.kv_norm_g = (const float*)d_in[7]; p.w_ukv = (const float*)d_in[8]; p.sg_ln_g = (const float*)d_in[9]; p.sg_ln_b = (const float*)d_in[10];
    p.sg_w_s = (const float*)d_in[11]; p.sg_b_s = (const float*)d_in[12]; p.out_norm_mla_g = (const float*)d_in[13]; p.out_norm_sg_g = (const float*)d_in[14];
    p.w_out = (const float*)d_in[15]; p.norm_mem_g = (const float*)d_in[16]; p.mem_norm_g = (const float*)d_in[17]; p.w_mq = (const float*)d_in[18];
    p.w_mkv = (const float*)d_in[19]; p.w_mo = (const float*)d_in[20]; p.norm_ffn_g = (const float*)d_in[21]; p.w_up = (const float*)d_in[22];
    p.conv_w = (const float*)d_in[23]; p.conv_b = (const float*)d_in[24]; p.w_down = (const float*)d_in[25]; p.final_norm_g = (const float*)d_in[26];
    p.out = (float*)d_out; p.ws = (char*)d_ws;
    (void)fp;
    (void)hipMemsetAsync((char*)d_ws + OFF_BAR, 0, BAR_BYTES, stream);
#if COOP
    int lo = 0, hi = NPHASE;
    void* args[] = {&p, &lo, &hi};
    hipError_t e = hipLaunchCooperativeKernel((const void*)mk, dim3(grid_blocks), dim3(256), args, LDS_BYTES, stream);
    if (e != hipSuccess) fprintf(stderr, "cooperative launch failed: %s (grid %d)\n", hipGetErrorString(e), grid_blocks);
#else
    for (int ph = 0; ph < NPHASE; ++ph) hipLaunchKernelGGL(mk, dim3(grid_blocks), dim3(256), LDS_BYTES, stream, p, ph, ph + 1);
#endif
}
```

```cpp
#include <hip/hip_runtime.h>
#include <hip/hip_cooperative_groups.h>
#include <stdint.h>
#include <stdio.h>
namespace cg = cooperative_groups;

#ifndef PHMASK
#define PHMASK 0xFFFF
#endif
#ifndef REPMASK
#define REPMASK 0
#endif
#ifndef COOP
#define COOP 1
#endif

typedef unsigned short bf16_t;
typedef __attribute__((ext_vector_type(8))) short bf16x8;
typedef __attribute__((ext_vector_type(16))) float f32x16;
typedef __attribute__((ext_vector_type(4))) unsigned u32x4;
#define DI __device__ __forceinline__
#define MFMA(a, b, c) __builtin_amdgcn_mfma_f32_32x32x16_bf16((a), (b), (c), 0, 0, 0)

constexpr int NBATCH = 8, SEQ = 8192, TOK = NBATCH * SEQ, DM = 1024, DEPTH = 4;
constexpr int NMEM = 256, QL = 256, KVL = 128, ROPE = 32, NOPE = 64, VD = 64, NH = 8;
constexpr int SGW = 512, INC = 1440, INCP = 1536, DFF = 2816;
constexpr float EPS = 1e-6f;
constexpr float LOG2E = 1.4426950408889634f;

constexpr size_t al256(size_t x) { return (x + 255) & ~(size_t)255; }
constexpr size_t SZ_WIN = (size_t)DEPTH * INCP * DM * 2;
constexpr size_t SZ_WUQ = (size_t)DEPTH * 768 * QL * 2;
constexpr size_t SZ_WUKV = (size_t)DEPTH * 1024 * KVL * 2;
constexpr size_t SZ_WS = (size_t)DEPTH * 8 * 128 * 128 * 2;
constexpr size_t SZ_W1K = (size_t)DEPTH * DM * DM * 2;
constexpr size_t SZ_WMKV = (size_t)DEPTH * 2048 * DM * 2;
constexpr size_t SZ_WUP = (size_t)DEPTH * 2 * DFF * DM * 2;
constexpr size_t SZ_WDN = (size_t)DEPTH * DM * DFF * 2;
constexpr size_t OFF_WIN = 0;
constexpr size_t OFF_WUQ = OFF_WIN + SZ_WIN;
constexpr size_t OFF_WUKV = OFF_WUQ + SZ_WUQ;
constexpr size_t OFF_WSG = OFF_WUKV + SZ_WUKV;
constexpr size_t OFF_WOUT = OFF_WSG + SZ_WS;
constexpr size_t OFF_WMQ = OFF_WOUT + SZ_W1K;
constexpr size_t OFF_WMKV = OFF_WMQ + SZ_W1K;
constexpr size_t OFF_WMO = OFF_WMKV + SZ_WMKV;
constexpr size_t OFF_WUP = OFF_WMO + SZ_W1K;
constexpr size_t OFF_WDN = OFF_WUP + SZ_WUP;
constexpr size_t OFF_COS = OFF_WDN + SZ_WDN;
constexpr size_t OFF_SIN = OFF_COS + (size_t)TOK * 16 * 4;
constexpr size_t OFF_KMEM = OFF_SIN + (size_t)TOK * 16 * 4;
constexpr size_t SZ_KMEM = (size_t)DEPTH * NBATCH * 4 * 256 * 256 * 2;
constexpr size_t OFF_VMEM = OFF_KMEM + SZ_KMEM;
constexpr size_t OFF_ACT0 = OFF_VMEM + SZ_KMEM;
constexpr size_t OFF_Q = OFF_ACT0;
constexpr size_t OFF_K = OFF_Q + (size_t)TOK * 8 * 96 * 2;
constexpr size_t OFF_VT = OFF_K + (size_t)TOK * 8 * 96 * 2;
constexpr size_t OFF_U = OFF_VT + (size_t)TOK * 512 * 2;
constexpr size_t OFF_V = OFF_U + (size_t)TOK * 512 * 2;
constexpr size_t OFF_OMIX = OFF_V + (size_t)TOK * 512 * 2;
constexpr size_t OFF_HQ = OFF_OMIX + (size_t)TOK * 1024 * 2;
constexpr size_t OFF_HKV = OFF_HQ + (size_t)TOK * 256 * 2;
constexpr size_t OFF_XB = OFF_HKV + (size_t)TOK * 128 * 2;
constexpr size_t OFF_MEMB = OFF_XB + (size_t)TOK * DM * 2;
constexpr size_t OFF_RSC = OFF_MEMB + (size_t)NBATCH * NMEM * DM * 2;
constexpr size_t OFF_BAR = OFF_RSC + (size_t)TOK * 16 * 4;
constexpr size_t BAR_BYTES = 16384;
constexpr size_t OFF_END = OFF_BAR + BAR_BYTES;
constexpr size_t OFF_QM = OFF_Q;
constexpr size_t OFF_OMEM = OFF_OMIX;
constexpr size_t OFF_ACT = OFF_ACT0;
static_assert(OFF_ACT + (size_t)TOK * DFF * 2 <= OFF_XB, "act alias");
static_assert(OFF_END <= (size_t)1000 * 1024 * 1024, "ws budget");

struct Params {
    const float *x, *mem; const int* pos;
    const float *norm_mix_g, *w_in, *q_norm_g, *w_uq, *kv_norm_g, *w_ukv, *sg_ln_g, *sg_ln_b, *sg_w_s, *sg_b_s,
        *out_norm_mla_g, *out_norm_sg_g, *w_out, *norm_mem_g, *mem_norm_g, *w_mq, *w_mkv, *w_mo, *norm_ffn_g, *w_up,
        *conv_w, *conv_b, *w_down, *final_norm_g;
    float* out; char* ws;
};

typedef const __attribute__((address_space(4))) Params* KP;
DI KP kparams() { KP k = (KP)__builtin_amdgcn_kernarg_segment_ptr(); asm volatile("" : "+s"(k)); return k; }
typedef __bf16 bf16v2_t __attribute__((ext_vector_type(2)));
typedef float f32v2_t __attribute__((ext_vector_type(2)));
DI unsigned pack2(float a, float b) { f32v2_t v = {a, b}; return __builtin_bit_cast(unsigned, __builtin_convertvector(v, bf16v2_t)); }
DI bf16_t f2bf(float f) { return (bf16_t)(pack2(f, f) & 0xffffu); }
typedef _Float16 f16x8 __attribute__((ext_vector_type(8)));
typedef _Float16 f16v2_t __attribute__((ext_vector_type(2)));
DI unsigned pack2h(float a, float b) { f16v2_t v = {(_Float16)a, (_Float16)b}; return __builtin_bit_cast(unsigned, v); }
DI bf16_t f2h(float f) { return __builtin_bit_cast(unsigned short, (_Float16)f); }
DI float h2f(bf16_t u) { return (float)__builtin_bit_cast(_Float16, u); }
DI float hlo(unsigned u) { return h2f((bf16_t)(u & 0xffffu)); }
DI float hhi(unsigned u) { return h2f((bf16_t)(u >> 16)); }
#define MFMA_H(a, b, c) __builtin_amdgcn_mfma_f32_32x32x16_f16(__builtin_bit_cast(f16x8, (a)), __builtin_bit_cast(f16x8, (b)), (c), 0, 0, 0)
DI float bf2f(bf16_t b) { return __uint_as_float((unsigned)b << 16); }
DI float bflo(unsigned u) { return __uint_as_float(u << 16); }
DI float bfhi(unsigned u) { return __uint_as_float(u & 0xffff0000u); }
DI float ex2(float x) { return __builtin_amdgcn_exp2f(x); }
DI float gelu_tanh(float x) { float y = 0.7978845608028654f * (x + 0.044715f * x * x * x); return x * __builtin_amdgcn_rcpf(1.f + ex2(-2.f * LOG2E * y)); }
DI float silu(float x) { return x * __builtin_amdgcn_rcpf(1.f + ex2(-LOG2E * x)); }
DI int tid() { int t = threadIdx.x; asm volatile("" : "+v"(t)); return t; }
DI int crow(int r, int h) { return (r & 3) + 8 * (r >> 2) + 4 * h; }
DI void st_nt16(void* p, const uint4& v) { u32x4 t = {v.x, v.y, v.z, v.w}; __builtin_nontemporal_store(t, (u32x4*)p); }
DI void st_nt4(unsigned* p, unsigned v) { __builtin_nontemporal_store(v, p); }
DI uint4 ld_nt16(const void* p) { const u32x4 t = __builtin_nontemporal_load((const u32x4*)p); return make_uint4(t[0], t[1], t[2], t[3]); }
DI int swap23(int r) { return (r & ~12) | ((r & 4) << 1) | ((r & 8) >> 1); }

template <class F> DI void for_tiles(int ntiles, F f) {
    const int G = gridDim.x, b = blockIdx.x;
    const bool sw = (G & 7) == 0;
    const int tpx = (ntiles + 7) >> 3;
    const int start = sw ? (b >> 3) : b, step = sw ? (G >> 3) : G, lim = sw ? tpx : ntiles, base = sw ? (b & 7) * tpx : 0;
    for (int i = start; i < lim; i += step) {
        const int t = base + i;
        if (t < ntiles) f(t);
    }
}

constexpr int LK = 72;
constexpr int GEMM_LDS = 4 * 128 * LK * 2;
constexpr int RS_OFF = GEMM_LDS;
constexpr int LDS_BYTES = GEMM_LDS + 1024;

template <int AMODE, bool F16 = false, bool MASK = false>
DI void gemm_tile(const bf16_t* __restrict__ Ab, int lda, int row0, int rlo, int rhi,
                  const bf16_t* __restrict__ Bt, int ldb, int K, char* smem, f32x16 (&acc)[2][2]) {
    const int t = tid(), lane = t & 63, w = __builtin_amdgcn_readfirstlane(t >> 6), wm = w >> 1, wn = w & 1, l32 = lane & 31, h = lane >> 5;
    bf16_t* As = (bf16_t*)smem;
    bf16_t* Bs = As + 2 * 128 * LK;
    float* rs = (float*)(smem + RS_OFF);
#pragma unroll
    for (int i = 0; i < 2; ++i)
#pragma unroll
        for (int j = 0; j < 2; ++j)
#pragma unroll
            for (int r = 0; r < 16; ++r) acc[i][j][r] = 0.f;

    uint4 p0a0, p0a1, p0a2, p0a3, p0b0, p0b1, p0b2, p0b3, p1a0, p1a1, p1a2, p1a3, p1b0, p1b1, p1b2, p1b3;
    float ss0 = 0.f, ss1 = 0.f, ss2 = 0.f, ss3 = 0.f;
    const int gr0 = row0 + (t >> 3);
    const bool rv0 = gr0 >= rlo && gr0 < rhi, rv1 = gr0 + 32 >= rlo && gr0 + 32 < rhi, rv2 = gr0 + 64 >= rlo && gr0 + 64 < rhi, rv3 = gr0 + 96 >= rlo && gr0 + 96 < rhi;
    const int nk = K >> 6;
    const int rhm = rhi - 1;
    const unsigned aoff0 = (unsigned)min(max(gr0, rlo), rhm) * (unsigned)lda + 8u * (t & 7);
    const unsigned aoff1 = (unsigned)min(max(gr0 + 32, rlo), rhm) * (unsigned)lda + 8u * (t & 7);
    const unsigned aoff2 = (unsigned)min(max(gr0 + 64, rlo), rhm) * (unsigned)lda + 8u * (t & 7);
    const unsigned aoff3 = (unsigned)min(max(gr0 + 96, rlo), rhm) * (unsigned)lda + 8u * (t & 7);
    const unsigned btoff = (unsigned)((t >> 3) * ldb + 8 * (t & 7));

    __syncthreads();

#define LD1(S, j, k0)                                                                                         \
    {                                                                                                         \
        S##a##j = *(const uint4*)(Ab + (k0) + aoff##j);          \
        S##b##j = *(const uint4*)(Bt + (size_t)(32 * j) * ldb + (k0) + btoff);                                \
    }
#define LOADS(S, k0) { LD1(S, 0, k0) LD1(S, 1, k0) LD1(S, 2, k0) LD1(S, 3, k0) }
#define ST1(S, j, buf)                                                                                        \
    {                                                                                                         \
        uint4 v = S##a##j;                                                                                    \
        if constexpr (MASK) { if (!rv##j) v = make_uint4(0, 0, 0, 0); }     \
        if (AMODE == 1) {                                                                                     \
            float a0 = bflo(v.x), a1 = bfhi(v.x), a2 = bflo(v.y), a3 = bfhi(v.y), a4 = bflo(v.z), a5 = bfhi(v.z), a6 = bflo(v.w), a7 = bfhi(v.w); \
            ss##j += a0 * a0 + a1 * a1 + a2 * a2 + a3 * a3 + a4 * a4 + a5 * a5 + a6 * a6 + a7 * a7;          \
        }                                                                                                     \
        *(uint4*)(As + (buf) * 128 * LK + ((t >> 3) + 32 * j) * LK + 8 * (t & 7)) = v;                        \
        *(uint4*)(Bs + (buf) * 128 * LK + ((t >> 3) + 32 * j) * LK + 8 * (t & 7)) = S##b##j;                  \
    }
#define STORES(S, buf) { ST1(S, 0, buf) ST1(S, 1, buf) ST1(S, 2, buf) ST1(S, 3, buf) }
#define FRAGS(ks, A0, A1, B0, B1) { A0 = *(const bf16x8*)(a_s + (ks) * 16); A1 = *(const bf16x8*)(a_s + 32 * LK + (ks) * 16); B0 = *(const bf16x8*)(b_s + (ks) * 16); B1 = *(const bf16x8*)(b_s + 32 * LK + (ks) * 16); }
#define MMAS(A0, A1, B0, B1) { __builtin_amdgcn_s_setprio(1); if constexpr (F16) { acc[0][0] = MFMA_H(A0, B0, acc[0][0]); acc[0][1] = MFMA_H(A0, B1, acc[0][1]); acc[1][0] = MFMA_H(A1, B0, acc[1][0]); acc[1][1] = MFMA_H(A1, B1, acc[1][1]); } else { acc[0][0] = MFMA(A0, B0, acc[0][0]); acc[0][1] = MFMA(A0, B1, acc[0][1]); acc[1][0] = MFMA(A1, B0, acc[1][0]); acc[1][1] = MFMA(A1, B1, acc[1][1]); } __builtin_amdgcn_s_setprio(0); }
#define COMPUTE(buf)                                                                                          \
    {                                                                                                         \
        const bf16_t* a_s = As + (buf) * 128 * LK + (wm * 64 + l32) * LK + h * 8;                             \
        const bf16_t* b_s = Bs + (buf) * 128 * LK + (wn * 64 + l32) * LK + h * 8;                             \
        bf16x8 xa0, xa1, xb0, xb1, ya0, ya1, yb0, yb1;                                                        \
        FRAGS(0, xa0, xa1, xb0, xb1)                                                                          \
        FRAGS(1, ya0, ya1, yb0, yb1)                                                                          \
        MMAS(xa0, xa1, xb0, xb1)                                                                              \
        FRAGS(2, xa0, xa1, xb0, xb1)                                                                          \
        MMAS(ya0, ya1, yb0, yb1)                                                                              \
        FRAGS(3, ya0, ya1, yb0, yb1)                                                                          \
        MMAS(xa0, xa1, xb0, xb1)                                                                              \
        MMAS(ya0, ya1, yb0, yb1)                                                                              \
    }

    const int klast = (nk - 1) * 64;
    LOADS(p0, 0);
    LOADS(p1, 64);
    STORES(p0, 0);
    LOADS(p0, min(128, klast));
    __syncthreads();
    for (int kt = 0; kt < nk; kt += 2) {
        COMPUTE(0);
        STORES(p1, 1);
        LOADS(p1, min((kt + 3) * 64, klast));
        __syncthreads();
        COMPUTE(1);
        if (kt + 2 < nk) STORES(p0, 0);
        LOADS(p0, min((kt + 4) * 64, klast));
        __syncthreads();
    }
#undef LOADS
#undef STORES
#undef COMPUTE
#undef FRAGS
#undef MMAS
#undef LD1
#undef ST1
    if (AMODE == 1) {
#define RS1(j) { float s = ss##j; s += __shfl_xor(s, 1); s += __shfl_xor(s, 2); s += __shfl_xor(s, 4); if ((t & 7) == 0) rs[(t >> 3) + 32 * j] = rsqrtf(s / (float)K + EPS); }
        RS1(0) RS1(1) RS1(2) RS1(3)
#undef RS1
        __syncthreads();
    }
}

DI float rs_load(KP p, int row0) {
    const int t = tid(), r = row0 + (t >> 1);
    float sum = 0.f;
    if (r >= 0 && r < TOK) {
        const float4* ps = (const float4*)((const float*)(p->ws + OFF_RSC) + (size_t)r * 16 + (t & 1) * 8);
        const float4 a = ps[0], b = ps[1];
        sum = (a.x + a.y) + (a.z + a.w) + (b.x + b.y) + (b.z + b.w);
    }
    return sum;
}
DI void rs_finish(float sum, int row0, char* smem) {
    const int t = tid(), r = row0 + (t >> 1);
    sum += __shfl_xor(sum, 1);
    if ((t & 1) == 0) ((float*)(smem + RS_OFF))[t >> 1] = (r >= 0 && r < TOK) ? rsqrtf(sum * (1.f / DM) + EPS) : 0.f;
    __syncthreads();
}

DI void tile_rc(int t, int NT, int& rt, int& ct) { const int g = t / (8 * NT), rem = t - g * 8 * NT; ct = rem >> 3; rt = g * 8 + (rem & 7); }

template <class E> DI void run_epi(const f32x16 (&acc)[2][2], const E& e) {
    const int w = __builtin_amdgcn_readfirstlane(tid() >> 6), wm = w >> 1, wn = w & 1;
#pragma unroll
    for (int i = 0; i < 2; ++i)
#pragma unroll
        for (int j = 0; j < 2; ++j) e(wm * 64 + i * 32, wn * 64 + j * 32, acc[i][j]);
}

DI int up_perm(int n) { return n < DFF ? (n >> 6) * 128 + (n & 63) : ((n - DFF) >> 6) * 128 + 64 + ((n - DFF) & 63); }

DI void conv_tile(const float* __restrict__ src, int K, int N, const float* g1, const float* g2, int ksplit,
                  bf16_t* __restrict__ dst, int rowmap, int tile, float* lds, int mode, bool f16 = false) {
    const int ntn = N >> 5, tk = tile / ntn, tn = tile - tk * ntn, k0 = tk * 32, n0 = tn * 32;
    const int tx = tid() & 31, ty = tid() >> 5;
    if (mode == 0) {
#pragma unroll
        for (int i = 0; i < 4; ++i) {
            int k = k0 + ty + 8 * i;
            float v = src[(size_t)k * N + n0 + tx];
            float g = g1 ? (k < ksplit ? g1[k] : g2[k - ksplit]) : 1.f;
            lds[(ty + 8 * i) * 33 + tx] = v * g;
        }
    } else {
#pragma unroll
        for (int i = 0; i < 4; ++i) {
            int n = n0 + ty + 8 * i;
            int nn = rowmap ? up_perm(n) : n;
            const float wv = lds[tx * 33 + ty + 8 * i];
            dst[(size_t)nn * K + k0 + tx] = f16 ? f2h(wv) : f2bf(wv);
        }
    }
}

__device__ void phase_setup(KP p, char* smem) {
    float* lds = (float*)smem;
    char* ws = p->ws;
    constexpr int PER_LAYER = 1440 + 192 + 128 + 1024 + 1024 + 2048 + 1024 + 5632 + 2816;
    auto job = [&](int t, float* ldsq, int mode) __attribute__((always_inline)) {
        int l = t / PER_LAYER, r = t - l * PER_LAYER;
        if (r < 1440) conv_tile(p->w_in + (size_t)l * DM * INC, DM, INC, p->norm_mix_g + l * DM, nullptr, DM, (bf16_t*)(ws + OFF_WIN) + (size_t)l * INCP * DM, 0, r, ldsq, mode, true);
        else if ((r -= 1440) < 192) conv_tile(p->w_uq + (size_t)l * QL * 768, QL, 768, p->q_norm_g + l * QL, nullptr, QL, (bf16_t*)(ws + OFF_WUQ) + (size_t)l * 768 * QL, 0, r, ldsq, mode);
        else if ((r -= 192) < 128) conv_tile(p->w_ukv + (size_t)l * KVL * 1024, KVL, 1024, p->kv_norm_g + l * KVL, nullptr, KVL, (bf16_t*)(ws + OFF_WUKV) + (size_t)l * 1024 * KVL, 0, r, ldsq, mode);
        else if ((r -= 128) < 1024) conv_tile(p->w_out + (size_t)l * DM * DM, DM, DM, p->out_norm_mla_g + l * 512, p->out_norm_sg_g + l * 512, 512, (bf16_t*)(ws + OFF_WOUT) + (size_t)l * DM * DM, 0, r, ldsq, mode);
        else if ((r -= 1024) < 1024) conv_tile(p->w_mq + (size_t)l * DM * DM, DM, DM, p->norm_mem_g + l * DM, nullptr, DM, (bf16_t*)(ws + OFF_WMQ) + (size_t)l * DM * DM, 0, r, ldsq, mode, true);
        else if ((r -= 1024) < 2048) conv_tile(p->w_mkv + (size_t)l * DM * 2048, DM, 2048, p->mem_norm_g + l * DM, nullptr, DM, (bf16_t*)(ws + OFF_WMKV) + (size_t)l * 2048 * DM, 0, r, ldsq, mode);
        else if ((r -= 2048) < 1024) conv_tile(p->w_mo + (size_t)l * DM * DM, DM, DM, nullptr, nullptr, DM, (bf16_t*)(ws + OFF_WMO) + (size_t)l * DM * DM, 0, r, ldsq, mode);
        else if ((r -= 1024) < 5632) conv_tile(p->w_up + (size_t)l * DM * 2 * DFF, DM, 2 * DFF, p->norm_ffn_g + l * DM, nullptr, DM, (bf16_t*)(ws + OFF_WUP) + (size_t)l * 2 * DFF * DM, 1, r, ldsq, mode, true);
        else { r -= 5632; conv_tile(p->w_down + (size_t)l * DFF * DM, DFF, DM, nullptr, nullptr, DFF, (bf16_t*)(ws + OFF_WDN) + (size_t)l * DM * DFF, 0, r, ldsq, mode); }
    };
    constexpr int NJOB = PER_LAYER * DEPTH, TPB = 4;
    for (int t0 = blockIdx.x; t0 < NJOB; t0 += TPB * gridDim.x) {
#pragma unroll
        for (int u = 0; u < TPB; ++u) { const int t = t0 + u * gridDim.x; if (t < NJOB) job(t, lds + u * 32 * 33, 0); }
        __syncthreads();
#pragma unroll
        for (int u = 0; u < TPB; ++u) { const int t = t0 + u * gridDim.x; if (t < NJOB) job(t, lds + u * 32 * 33, 1); }
        __syncthreads();
    }
    const size_t gt = (size_t)blockIdx.x * 256 + tid(), gn = (size_t)gridDim.x * 256;
    bf16_t* wsg = (bf16_t*)(ws + OFF_WSG);
    for (size_t i = gt; i < (size_t)DEPTH * 8 * 128 * 128; i += gn) wsg[i] = f2bf(p->sg_w_s[i]);
    for (size_t i = gt; i < (size_t)DEPTH * 96 * DM; i += gn) {
        size_t l = i / (96 * DM), r = i - l * (96 * DM);
        ((bf16_t*)(ws + OFF_WIN))[(l * INCP + INC) * DM + r] = 0;
    }
    {
        {
            const int lane = tid() & 63, wv = blockIdx.x * 4 + (tid() >> 6), nw = gridDim.x * 4;
            float* rsc = (float*)(ws + OFF_RSC);
            for (int row = wv; row < TOK; row += nw) {
                const float4* xs = (const float4*)(p->x + (size_t)row * DM); uint2* xd = (uint2*)(ws + OFF_XB) + (size_t)row * (DM / 4);
                float sacc = 0.f;
#pragma unroll
                for (int i = 0; i < 4; ++i) { float4 v = xs[lane + 64 * i]; sacc += v.x * v.x + v.y * v.y + v.z * v.z + v.w * v.w; uint2 o; o.x = pack2h(v.x, v.y); o.y = pack2h(v.z, v.w); xd[lane + 64 * i] = o; }
#pragma unroll
                for (int o = 1; o < 64; o <<= 1) sacc += __shfl_xor(sacc, o);
                if (lane < 16) rsc[(size_t)row * 16 + lane] = lane == 0 ? sacc : 0.f;
            }
        }
        const float4* ms = (const float4*)p->mem; uint2* md = (uint2*)(ws + OFF_MEMB);
        for (size_t i = gt; i < (size_t)NBATCH * NMEM * DM / 4; i += gn) { float4 v = ms[i]; uint2 o; o.x = pack2(v.x, v.y); o.y = pack2(v.z, v.w); md[i] = o; }
    }
    float* cs = (float*)(ws + OFF_COS); float* sn = (float*)(ws + OFF_SIN);
    for (size_t i = gt; i < (size_t)TOK * 16; i += gn) {
        int tok = (int)(i >> 4), f = (int)(i & 15);
        const float inv = ex2(-(float)f * 0.83048202372184058f);
        const float ang = (float)p->pos[tok] * inv;
        const float c_hi = 0.15915494309189535f, c_lo = 6.4206383e-9f;
        const float rh = ang * c_hi;
        const float re = fmaf(ang, c_hi, -rh) + ang * c_lo;
        float rf = (rh - floorf(rh)) + re;
        cs[i] = __builtin_amdgcn_cosf(rf);
        sn[i] = __builtin_amdgcn_sinf(rf);
    }
}

struct EpiMemKV {
    bf16_t* km; bf16_t* vm; const float* rs; int row0, col0;
    DI void operator()(int rb, int cb, const f32x16& a) const {
        const int lane = tid() & 63, c = lane & 31, h = lane >> 5;
        const int n0 = col0 + cb;
        if (n0 < 1024) {
            const int head = n0 >> 8, d = (n0 & 255) + c;
#pragma unroll
            for (int r = 0; r < 16; ++r) {
                int row = rb + crow(r, h), gr = row0 + row, b = gr >> 8, key = gr & 255;
                km[(((size_t)(b * 4 + head)) * 256 + key) * 256 + d] = f2bf(a[r] * rs[row]);
            }
        } else {
            const int head = (n0 - 1024) >> 8, d = ((n0 - 1024) & 255) + c;
#pragma unroll
            for (int g = 0; g < 4; ++g) {
                int row = rb + 8 * g + 4 * h, gr = row0 + row, b = gr >> 8, key = gr & 255;
                uint2 pk;
                pk.x = pack2(a[4 * g] * rs[row], a[4 * g + 1] * rs[row + 1]);
                pk.y = pack2(a[4 * g + 2] * rs[row + 2], a[4 * g + 3] * rs[row + 3]);
                *(uint2*)(vm + (((size_t)(b * 4 + head)) * 256 + d) * 256 + key) = pk;
            }
        }
    }
};

struct EpiIn {
    bf16_t *hq, *hkv, *u, *v, *kb; const float *cs, *sn, *rs; int row0, col0;
    DI void operator()(int rb, int cb, const f32x16& a) const {
        const int lane = tid() & 63, c = lane & 31, h = lane >> 5;
        const int nb = col0 + cb;
        if (nb >= INC) return;
        if (nb == 384) {
#pragma unroll
            for (int r = 0; r < 16; ++r) {
                const int row = rb + crow(r, h), tok = row0 + row;
                const float val = a[r] * rs[row];
                float pt = __shfl_xor(val, 16);
                float co = cs[tok * 16 + (c & 15)], si = sn[tok * 16 + (c & 15)];
                float o = (c < 16) ? val * co - pt * si : val * co + pt * si;
                bf16_t ob = f2bf(o);
                const int b = tok >> 13, s = tok & 8191;
                bf16_t* dst = kb + (((size_t)(b * 8)) * SEQ + s) * 96 + 64 + c;
                for (int hd = 0; hd < 8; ++hd) dst[(size_t)hd * SEQ * 96] = ob;
            }
            return;
        }
        bf16_t* dst; int pitch, off; bool act;
        if (nb < 256) { dst = hq; pitch = 256; off = nb; act = false; }
        else if (nb < 384) { dst = hkv; pitch = 128; off = nb - 256; act = false; }
        else if (nb < 928) { dst = u; pitch = 512; off = nb - 416; act = true; }
        else { dst = v; pitch = 512; off = nb - 928; act = true; }
        dst += (size_t)(row0 + rb + 4 * h) * pitch + off + c;
#pragma unroll
        for (int r = 0; r < 16; ++r) {
            const int rr = (r & 3) + 8 * (r >> 2);
            float val = a[r] * rs[rb + rr + 4 * h];
            if (act) val = gelu_tanh(val);
            dst[(size_t)rr * pitch] = f2bf(val);
        }
    }
};

struct EpiQ {
    bf16_t* q; const float *cs, *sn, *rs; int row0, col0;
    DI void operator()(int rb, int cb, const f32x16& a) const {
        const int lane = tid() & 63, c = lane & 31, h = lane >> 5;
        const int n0 = col0 + cb, head = n0 / 96, w0 = n0 - head * 96;
        const float qs = 0.10206207261596575f * LOG2E;
#pragma unroll
        for (int r = 0; r < 16; ++r) {
            const int row = rb + crow(r, h), tok = row0 + row;
            float val = a[r] * rs[row] * qs;
            if (w0 == 64) {
                float pt = __shfl_xor(val, 16);
                float co = cs[tok * 16 + (c & 15)], si = sn[tok * 16 + (c & 15)];
                val = (c < 16) ? val * co - pt * si : val * co + pt * si;
            }
            const int b = tok >> 13, s = tok & 8191;
            q[(((size_t)(b * 8 + head)) * SEQ + s) * 96 + w0 + c] = f2bf(val);
        }
    }
};

struct EpiKV {
    bf16_t *kb, *vstage; const float* rs; int row0, col0;
    DI void operator()(int rb, int cb, const f32x16& a) const {
        const int lane = tid() & 63, c = lane & 31, h = lane >> 5;
        const int n0 = col0 + cb, head = n0 >> 7, w0 = n0 & 127;
        if (w0 < 64) {
#pragma unroll
            for (int r = 0; r < 16; ++r) {
                const int row = rb + crow(r, h), tok = row0 + row, b = tok >> 13, s = tok & 8191;
                kb[(((size_t)(b * 8 + head)) * SEQ + s) * 96 + w0 + c] = f2bf(a[r] * rs[row]);
            }
        } else {
            const int d = w0 - 64 + c;
#pragma unroll
            for (int g = 0; g < 4; ++g) {
                const int row = rb + 8 * g + 4 * h;
                uint2 pk;
                pk.x = pack2(a[4 * g] * rs[row], a[4 * g + 1] * rs[row + 1]);
                pk.y = pack2(a[4 * g + 2] * rs[row + 2], a[4 * g + 3] * rs[row + 3]);
                *(uint2*)(vstage + d * 136 + row) = pk;
            }
        }
    }
};

struct EpiRes {
    bf16_t* xb; int row0, col0; bool dry;
    DI void operator()(int rb, int cb, const f32x16& a, f32x16& sq) const {
        const int lane = tid() & 63, c = lane & 31, h = lane >> 5;
        if (dry && a[0] != 1.2345e30f) return;
        bf16_t* ptr = xb + (size_t)(row0 + rb + 4 * h) * DM + col0 + cb + c;
#pragma unroll
        for (int r = 0; r < 16; ++r) {
            const int rr = (r & 3) + 8 * (r >> 2);
            const bf16_t nb = f2h(h2f(ptr[(size_t)rr * DM]) + a[r]);
            ptr[(size_t)rr * DM] = nb;
            const float nv = h2f(nb);
            sq[r] += nv * nv;
        }
    }
};

struct EpiQm {
    bf16_t* qm; const float* rs; int row0, col0;
    DI void operator()(int rb, int cb, const f32x16& a) const {
        const int lane = tid() & 63, c = lane & 31, h = lane >> 5;
#pragma unroll
        for (int r = 0; r < 16; ++r) {
            const int row = rb + crow(r, h);
            qm[(size_t)(row0 + row) * DM + col0 + cb + c] = f2bf(a[r] * rs[row] * (0.0625f * LOG2E));
        }
    }
};

template <int DQK, int DV, int NBUF, bool QREG, int QW, int LDQ, int LDK, int LDV, int LDO>
DI void flash_item(const bf16_t* __restrict__ Qp, const bf16_t* __restrict__ Kp, const bf16_t* __restrict__ Vtp, int nkt,
                   bf16_t* __restrict__ Op, char* smem, float& ssq) {
    constexpr int KP = DQK + 8;
    constexpr int VP = 72;
    constexpr int CPR = DQK / 8;
    constexpr int KCH = 64 * CPR / 256;
    constexpr int VCH = DV * 8 / 256;
    constexpr int NKS = DQK / 16, NMT = DV / 32 / QW;
    constexpr bool KROWS = (256 % CPR) == 0;
    static_assert(KROWS || LDK == DQK, "K tile addressing");
    static_assert(KCH <= 8 && VCH <= 8, "staging regs");
    static_assert(NBUF == 2 ? (KCH <= 4 && VCH <= 2) : (KCH == 8 && VCH == 8), "staging");
    bf16_t* Ks = (bf16_t*)smem;
    bf16_t* Vs = Ks + NBUF * 64 * KP;
    const int t = tid(), lane = t & 63, w = __builtin_amdgcn_readfirstlane(t >> 6), l32 = lane & 31, h = lane >> 5;
    const int q = (w / QW) * 32 + l32, dv0 = (w % QW) * (DV / QW);
    const unsigned ktoff = KROWS ? (unsigned)((t / CPR) * LDK + (t % CPR) * 8) : (unsigned)(t * 8);
    const unsigned vtoff = (unsigned)((t >> 3) * LDV + (t & 7) * 8);

    bf16x8 qf[QREG ? NKS : 1];
    if constexpr (QREG) {
#pragma unroll
        for (int ks = 0; ks < NKS; ++ks) qf[ks] = *(const bf16x8*)(Qp + (size_t)q * LDQ + ks * 16 + 8 * h);
    }
    f32x16 o[NMT];
#pragma unroll
    for (int mt = 0; mt < NMT; ++mt)
#pragma unroll
        for (int r = 0; r < 16; ++r) o[mt][r] = 0.f;
    float m = -INFINITY, lsum = 0.f;

    uint4 rk0, rk1, rk2, rk3, rk4, rk5, rk6, rk7, rv0, rv1;
    (void)rk0; (void)rk1; (void)rk2; (void)rk3; (void)rk4; (void)rk5; (void)rk6; (void)rk7; (void)rv0; (void)rv1;
#define LKJ(kt, i, R) { const bf16_t* kb_ = KROWS ? Kp + (size_t)((kt) * 64 + (i) * (256 / CPR)) * LDK : Kp + (size_t)(kt) * 64 * DQK + (i) * 2048; R = *(const uint4*)(kb_ + ktoff); }
#define SKJ(buf, i, R) { int c = t + 256 * (i), row = c / CPR, cc = c - row * CPR; *(uint4*)(Ks + (buf) * 64 * KP + swap23(row) * KP + cc * 8) = R; }
#define LVJ(kt, i, R) { const bf16_t* vb_ = Vtp + (size_t)(i) * 32 * LDV + (kt) * 64; R = *(const uint4*)(vb_ + vtoff); }
#define SVJ(buf, i, R) { int c = t + 256 * (i), d = c >> 3, cc = c & 7; *(uint4*)(Vs + (buf) * DV * VP + d * VP + cc * 8) = R; }
#define ATT_LOAD(kt) { LKJ(kt, 0, rk0) if constexpr (KCH > 1) LKJ(kt, 1, rk1) if constexpr (KCH > 2) LKJ(kt, 2, rk2) if constexpr (KCH > 3) LKJ(kt, 3, rk3) LVJ(kt, 0, rv0) if constexpr (VCH > 1) LVJ(kt, 1, rv1) }
#define ATT_STORE(buf) { SKJ(buf, 0, rk0) if constexpr (KCH > 1) SKJ(buf, 1, rk1) if constexpr (KCH > 2) SKJ(buf, 2, rk2) if constexpr (KCH > 3) SKJ(buf, 3, rk3) SVJ(buf, 0, rv0) if constexpr (VCH > 1) SVJ(buf, 1, rv1) }

    __syncthreads();
    if constexpr (NBUF == 2) ATT_LOAD(0);
    for (int kt = 0; kt < nkt; ++kt) {
        const int buf = (NBUF == 2) ? (kt & 1) : 0;
        if constexpr (NBUF == 1) {
            __syncthreads();
            LKJ(kt, 0, rk0) LKJ(kt, 1, rk1) LKJ(kt, 2, rk2) LKJ(kt, 3, rk3)
            LKJ(kt, 4, rk4) LKJ(kt, 5, rk5) LKJ(kt, 6, rk6) LKJ(kt, 7, rk7)
            SKJ(0, 0, rk0) SKJ(0, 1, rk1) SKJ(0, 2, rk2) SKJ(0, 3, rk3)
            asm volatile("" ::: "memory");
            LVJ(kt, 0, rk0) LVJ(kt, 1, rk1) LVJ(kt, 2, rk2) LVJ(kt, 3, rk3)
            SKJ(0, 4, rk4) SKJ(0, 5, rk5) SKJ(0, 6, rk6) SKJ(0, 7, rk7)
            asm volatile("" ::: "memory");
            LVJ(kt, 4, rk4) LVJ(kt, 5, rk5) LVJ(kt, 6, rk6) LVJ(kt, 7, rk7)
            SVJ(0, 0, rk0) SVJ(0, 1, rk1) SVJ(0, 2, rk2) SVJ(0, 3, rk3)
            asm volatile("" ::: "memory");
            SVJ(0, 4, rk4) SVJ(0, 5, rk5) SVJ(0, 6, rk6) SVJ(0, 7, rk7)
        } else { ATT_STORE(buf); }
        __syncthreads();
        if constexpr (NBUF == 2) { if (kt + 1 < nkt) ATT_LOAD(kt + 1); }

        const bf16_t* kb = Ks + buf * 64 * KP + l32 * KP + 8 * h;
        f32x16 s0, s1;
#pragma unroll
        for (int r = 0; r < 16; ++r) { s0[r] = 0.f; s1[r] = 0.f; }
#pragma unroll
        for (int ks = 0; ks < NKS; ++ks) {
            bf16x8 qq;
            if constexpr (QREG) qq = qf[ks]; else qq = *(const bf16x8*)(Qp + (size_t)q * LDQ + ks * 16 + 8 * h);
            bf16x8 k0 = *(const bf16x8*)(kb + ks * 16);
            bf16x8 k1 = *(const bf16x8*)(kb + 32 * KP + ks * 16);
            s0 = MFMA(k0, qq, s0);
            s1 = MFMA(k1, qq, s1);
        }
        float mx = s0[0];
#pragma unroll
        for (int r = 1; r < 16; ++r) mx = fmaxf(mx, s0[r]);
#pragma unroll
        for (int r = 0; r < 16; ++r) mx = fmaxf(mx, s1[r]);
        mx = fmaxf(mx, __shfl_xor(mx, 32));
        const float mn = fmaxf(m, mx);
        const float alpha = ex2(m - mn);
        m = mn;
        float psum = 0.f;
#pragma unroll
        for (int r = 0; r < 16; ++r) { s0[r] = ex2(s0[r] - mn); psum += s0[r]; }
#pragma unroll
        for (int r = 0; r < 16; ++r) { s1[r] = ex2(s1[r] - mn); psum += s1[r]; }
        lsum = lsum * alpha + psum;
        if (__builtin_amdgcn_ballot_w64(alpha != 1.f) != 0ull) {
#pragma unroll
            for (int mt = 0; mt < NMT; ++mt)
#pragma unroll
                for (int r = 0; r < 16; ++r) o[mt][r] *= alpha;
        }
        const bf16_t* vb = Vs + buf * DV * VP + (dv0 + l32) * VP + 8 * h;
#pragma unroll
        for (int t2 = 0; t2 < 2; ++t2)
#pragma unroll
            for (int s2 = 0; s2 < 2; ++s2) {
                u32x4 pu;
#pragma unroll
                for (int j = 0; j < 4; ++j)
                    pu[j] = t2 ? pack2(s1[8 * s2 + 2 * j], s1[8 * s2 + 2 * j + 1]) : pack2(s0[8 * s2 + 2 * j], s0[8 * s2 + 2 * j + 1]);
                const bf16x8 pfv = __builtin_bit_cast(bf16x8, pu);
#pragma unroll
                for (int mt = 0; mt < NMT; ++mt) {
                    bf16x8 vv = *(const bf16x8*)(vb + mt * 32 * VP + t2 * 32 + s2 * 16);
                    o[mt] = MFMA(vv, pfv, o[mt]);
                }
            }
    }
#undef ATT_LOAD
#undef ATT_STORE
#undef LKJ
#undef SKJ
#undef LVJ
#undef SVJ
    const float inv = 1.f / (lsum + __shfl_xor(lsum, 32));
#pragma unroll
    for (int mt = 0; mt < NMT; ++mt)
#pragma unroll
        for (int g = 0; g < 4; ++g) {
            float v0 = o[mt][4 * g] * inv, v1 = o[mt][4 * g + 1] * inv, v2 = o[mt][4 * g + 2] * inv, v3 = o[mt][4 * g + 3] * inv;
            uint2 pk; pk.x = pack2(v0, v1); pk.y = pack2(v2, v3);
            float r0 = bflo(pk.x), r1 = bfhi(pk.x), r2 = bflo(pk.y), r3 = bfhi(pk.y);
            ssq += r0 * r0 + r1 * r1 + r2 * r2 + r3 * r3;
            *(uint2*)(Op + (size_t)q * LDO + dv0 + mt * 32 + 8 * g + 4 * h) = pk;
        }
}

DI void flash_mla2(const bf16_t* __restrict__ Qp, const bf16_t* __restrict__ Kp, const bf16_t* __restrict__ Vtp,
                   bf16_t* __restrict__ Op, char* smem, float& ssq) {
    constexpr int DQK = 96, DV = 64, LDQ = 96, LDV = SEQ, LDO = DM, NKT = SEQ / 64;
    constexpr int KP = DQK + 8, VP = 72, CPR = DQK / 8, NKS = DQK / 16, NMT = DV / 32;
    bf16_t* Ks = (bf16_t*)smem;
    bf16_t* Vs = Ks + 2 * 64 * KP;
    const int t = tid(), lane = t & 63, w = __builtin_amdgcn_readfirstlane(t >> 6), l32 = lane & 31, h = lane >> 5;
    const int q = w * 32 + l32;
    const unsigned ktoff = (unsigned)(t * 8);
    const unsigned vtoff = (unsigned)((t >> 3) * LDV + (t & 7) * 8);
    bf16x8 qf[NKS];
#pragma unroll
    for (int ks = 0; ks < NKS; ++ks) qf[ks] = *(const bf16x8*)(Qp + (size_t)q * LDQ + ks * 16 + 8 * h);
    f32x16 o[NMT];
#pragma unroll
    for (int mt = 0; mt < NMT; ++mt)
#pragma unroll
        for (int r = 0; r < 16; ++r) o[mt][r] = 0.f;
    float m = 0.f, lsum = 0.f;
    uint4 ak0, ak1, ak2, av0, av1, bk0, bk1, bk2, bv0, bv1;
#define M2_LOAD(S, kt) { const bf16_t* kb_ = Kp + (size_t)(kt) * 64 * DQK; S##k0 = *(const uint4*)(kb_ + ktoff); S##k1 = *(const uint4*)(kb_ + 2048 + ktoff); S##k2 = *(const uint4*)(kb_ + 4096 + ktoff); \
        const bf16_t* vb_ = Vtp + (kt) * 64; S##v0 = *(const uint4*)(vb_ + vtoff); S##v1 = *(const uint4*)(vb_ + (size_t)32 * LDV + vtoff); }
#define M2_SK(i, R, buf) { int c = t + 256 * (i), row = c / CPR, cc = c - row * CPR; *(uint4*)(Ks + (buf) * 64 * KP + swap23(row) * KP + cc * 8) = R; }
#define M2_SV(i, R, buf) { int c = t + 256 * (i), d = c >> 3, cc = c & 7; *(uint4*)(Vs + (buf) * DV * VP + d * VP + cc * 8) = R; }
#define M2_STORE(S, buf) { M2_SK(0, S##k0, buf) M2_SK(1, S##k1, buf) M2_SK(2, S##k2, buf) M2_SV(0, S##v0, buf) M2_SV(1, S##v1, buf) }
#define M2_COMPUTE(buf) { \
        if (__builtin_amdgcn_ballot_w64(alpha != 1.f) != 0ull) { \
            _Pragma("unroll") for (int mt = 0; mt < NMT; ++mt) _Pragma("unroll") for (int r = 0; r < 16; ++r) o[mt][r] *= alpha; } \
        lsum *= alpha; \
        const bf16_t* kb = Ks + (buf) * 64 * KP + l32 * KP + 8 * h; \
        f32x16 s0, s1; \
        const float nm = -m; \
        _Pragma("unroll") for (int r = 0; r < 16; ++r) { s0[r] = nm; s1[r] = nm; } \
        _Pragma("unroll") for (int ks = 0; ks < NKS; ++ks) { bf16x8 k0 = *(const bf16x8*)(kb + ks * 16); bf16x8 k1 = *(const bf16x8*)(kb + 32 * KP + ks * 16); s0 = MFMA(k0, qf[ks], s0); s1 = MFMA(k1, qf[ks], s1); } \
        float mx = s0[0]; \
        _Pragma("unroll") for (int r = 1; r < 16; ++r) mx = fmaxf(mx, s0[r]); \
        _Pragma("unroll") for (int r = 0; r < 16; ++r) mx = fmaxf(mx, s1[r]); \
        mx = fmaxf(mx, __shfl_xor(mx, 32)); \
        float psum = 0.f; \
        _Pragma("unroll") for (int r = 0; r < 16; ++r) { s0[r] = ex2(s0[r]); psum += s0[r]; } \
        _Pragma("unroll") for (int r = 0; r < 16; ++r) { s1[r] = ex2(s1[r]); psum += s1[r]; } \
        lsum += psum; \
        const float dgrow = fmaxf(mx, 0.f); alpha = ex2(-dgrow); m += dgrow; \
        const bf16_t* vb = Vs + (buf) * DV * VP + l32 * VP + 8 * h; \
        _Pragma("unroll") for (int s2 = 0; s2 < 2; ++s2) { \
            u32x4 pu0, pu1; \
            _Pragma("unroll") for (int j = 0; j < 4; ++j) { pu0[j] = pack2(s0[8 * s2 + 2 * j], s0[8 * s2 + 2 * j + 1]); pu1[j] = pack2(s1[8 * s2 + 2 * j], s1[8 * s2 + 2 * j + 1]); } \
            const bf16x8 pf0 = __builtin_bit_cast(bf16x8, pu0), pf1 = __builtin_bit_cast(bf16x8, pu1); \
            _Pragma("unroll") for (int mt = 0; mt < NMT; ++mt) { \
                bf16x8 v0 = *(const bf16x8*)(vb + mt * 32 * VP + s2 * 16); bf16x8 v1 = *(const bf16x8*)(vb + mt * 32 * VP + 32 + s2 * 16); \
                o[mt] = MFMA(v0, pf0, o[mt]); o[mt] = MFMA(v1, pf1, o[mt]); } } }

    float alpha = 1.f;
    __syncthreads();
    M2_LOAD(a, 0);
    M2_LOAD(b, 1);
    {
        M2_STORE(a, 0);
        __syncthreads();
        const bf16_t* kb = Ks + l32 * KP + 8 * h;
        f32x16 s0, s1;
#pragma unroll
        for (int r = 0; r < 16; ++r) { s0[r] = 0.f; s1[r] = 0.f; }
#pragma unroll
        for (int ks = 0; ks < NKS; ++ks) { bf16x8 k0 = *(const bf16x8*)(kb + ks * 16); bf16x8 k1 = *(const bf16x8*)(kb + 32 * KP + ks * 16); s0 = MFMA(k0, qf[ks], s0); s1 = MFMA(k1, qf[ks], s1); }
        float mx = s0[0];
#pragma unroll
        for (int r = 1; r < 16; ++r) mx = fmaxf(mx, s0[r]);
#pragma unroll
        for (int r = 0; r < 16; ++r) mx = fmaxf(mx, s1[r]);
        m = fmaxf(mx, __shfl_xor(mx, 32));
        __syncthreads();
    }
    for (int kt = 0; kt < NKT; kt += 2) {
        M2_STORE(a, 0);
        __syncthreads();
        M2_LOAD(a, min(kt + 2, NKT - 1));
        M2_COMPUTE(0);
        M2_STORE(b, 1);
        __syncthreads();
        M2_LOAD(b, min(kt + 3, NKT - 1));
        M2_COMPUTE(1);
    }
#undef M2_LOAD
#undef M2_SK
#undef M2_SV
#undef M2_STORE
#undef M2_COMPUTE
    const float inv = 1.f / (lsum + __shfl_xor(lsum, 32));
#pragma unroll
    for (int mt = 0; mt < NMT; ++mt)
#pragma unroll
        for (int g = 0; g < 4; ++g) {
            float v0 = o[mt][4 * g] * inv, v1 = o[mt][4 * g + 1] * inv, v2 = o[mt][4 * g + 2] * inv, v3 = o[mt][4 * g + 3] * inv;
            uint2 pk; pk.x = pack2(v0, v1); pk.y = pack2(v2, v3);
            float r0 = bflo(pk.x), r1 = bfhi(pk.x), r2 = bflo(pk.y), r3 = bfhi(pk.y);
            ssq += r0 * r0 + r1 * r1 + r2 * r2 + r3 * r3;
            *(uint2*)(Op + (size_t)q * LDO + mt * 32 + 8 * g + 4 * h) = pk;
        }
}

DI void mla_item(KP p, int item, char* smem) {
    const int b = item >> 6, qb = item & 63;
    const bf16_t* Q = (const bf16_t*)(p->ws + OFF_Q);
    const bf16_t* K = (const bf16_t*)(p->ws + OFF_K);
    const bf16_t* Vt = (const bf16_t*)(p->ws + OFF_VT);
    bf16_t* om = (bf16_t*)(p->ws + OFF_OMIX) + ((size_t)b * SEQ + qb * 128) * DM;
    float ssq = 0.f;
    for (int hd = 0; hd < 8; ++hd) {
        const size_t bh = (size_t)(b * 8 + hd);
        flash_mla2(Q + (bh * SEQ + qb * 128) * 96, K + bh * SEQ * 96, Vt + bh * 64 * SEQ, om + hd * 64, smem, ssq);
    }
    ssq += __shfl_xor(ssq, 32);
    const float sc = rsqrtf(ssq * (1.f / 512.f) + EPS);
    const int lane = tid() & 63, w = tid() >> 6, q = w * 32 + (lane & 31), h = lane >> 5;
    for (int i = 0; i < 64; ++i) {
        uint2* ptr = (uint2*)(om + (size_t)q * DM + (i >> 3) * 64 + ((i >> 2) & 1) * 32 + (i & 3) * 8 + 4 * h);
        uint2 v = *ptr;
        v.x = pack2(bflo(v.x) * sc, bfhi(v.x) * sc);
        v.y = pack2(bflo(v.y) * sc, bfhi(v.y) * sc);
        *ptr = v;
    }
}

DI void memattn_item(KP p, int l, int item, char* smem) {
    const int head = item & 3, qt = (item >> 2) & 127, b = item >> 9;
    const bf16_t* qm = (const bf16_t*)(p->ws + OFF_QM) + ((size_t)b * SEQ + qt * 64) * DM + head * 256;
    const bf16_t* km = (const bf16_t*)(p->ws + OFF_KMEM) + ((size_t)((l * NBATCH + b) * 4 + head)) * 256 * 256;
    const bf16_t* vm = (const bf16_t*)(p->ws + OFF_VMEM) + ((size_t)((l * NBATCH + b) * 4 + head)) * 256 * 256;
    bf16_t* om = (bf16_t*)(p->ws + OFF_OMEM) + ((size_t)b * SEQ + qt * 64) * DM + head * 256;
    float dummy = 0.f;
    flash_item<256, 256, 1, true, 2, DM, 256, 256, DM>(qm, km, vm, 4, om, smem, dummy);
}

DI void gmlp_item(KP p, int l, int ci, char* smem) {
    constexpr int AP = 136;
    bf16_t* As = (bf16_t*)smem;
    bf16_t* Bs = As + 128 * AP;
    float* st = (float*)(Bs + 64 * AP);
    const int t = tid(), lane = t & 63, w = __builtin_amdgcn_readfirstlane(t >> 6), l32 = lane & 31, h = lane >> 5;
    const int tok0 = ci * 128;
    const bf16_t* vbuf = (const bf16_t*)(p->ws + OFF_V) + (size_t)tok0 * 512;
    const bf16_t* ubuf = (const bf16_t*)(p->ws + OFF_U) + (size_t)(tok0 + w * 32) * 512;
    bf16_t* om = (bf16_t*)(p->ws + OFF_OMIX) + (size_t)(tok0 + w * 32) * DM + 512;
    const bf16_t* wsg = (const bf16_t*)(p->ws + OFF_WSG) + (size_t)l * 8 * 128 * 128;
    const float* lng = p->sg_ln_g + l * 512; const float* lnb = p->sg_ln_b + l * 512;
    const float* bs = p->sg_b_s + l * 8 * 128 + w * 32;
    __syncthreads();
    {
        const int row = t >> 1, half = t & 1;
        const uint4* src = (const uint4*)(vbuf + (size_t)row * 512 + half * 256);
        float s = 0.f, s2 = 0.f;
#pragma unroll 4
        for (int i = 0; i < 32; ++i) {
            uint4 qv = src[i];
            float a0 = bflo(qv.x), a1 = bfhi(qv.x), a2 = bflo(qv.y), a3 = bfhi(qv.y), a4 = bflo(qv.z), a5 = bfhi(qv.z), a6 = bflo(qv.w), a7 = bfhi(qv.w);
            s += a0 + a1 + a2 + a3 + a4 + a5 + a6 + a7;
            s2 += a0 * a0 + a1 * a1 + a2 * a2 + a3 * a3 + a4 * a4 + a5 * a5 + a6 * a6 + a7 * a7;
        }
        s += __shfl_xor(s, 1); s2 += __shfl_xor(s2, 1);
        const float mean = s * (1.f / 512.f);
        const float var = fmaxf(s2 * (1.f / 512.f) - mean * mean, 0.f);
        if (half == 0) { st[2 * row] = mean; st[2 * row + 1] = rsqrtf(var + EPS); }
    }
    __syncthreads();
    float rq0 = 0.f, rq1 = 0.f, rq2 = 0.f, rq3 = 0.f;
    const bf16_t* ub0 = (const bf16_t*)(p->ws + OFF_U) + (size_t)tok0 * 512;
    bf16_t* om0 = (bf16_t*)(p->ws + OFF_OMIX) + (size_t)tok0 * DM + 512;
    const unsigned wtoff = (unsigned)((t >> 4) * 128 + (t & 15) * 8);
    const unsigned vtoff = (unsigned)((t >> 3) * 512 + (t & 7) * 8);
    const unsigned eoff_u = (unsigned)(4 * h * 512 + l32), eoff_o = (unsigned)(4 * h * DM + l32);
    for (int hd = 0; hd < 8; ++hd) {
        const bf16_t* wh = wsg + (size_t)hd * 128 * 128;
#pragma unroll
        for (int i = 0; i < 8; ++i)
            *(uint4*)(As + ((t >> 4) + 16 * i) * AP + (t & 15) * 8) = *(const uint4*)(wh + i * 16 * 128 + wtoff);
#pragma unroll
        for (int i = 0; i < 4; ++i) {
            const int j = (t >> 3) + 32 * i, c8 = t & 7;
            uint4 qv = *(const uint4*)(vbuf + (size_t)i * 32 * 512 + hd * 64 + vtoff);
            const float mean = st[2 * j], rstd = st[2 * j + 1];
            const int ch = hd * 64 + c8 * 8;
            const float4 g0 = *(const float4*)(lng + ch), g1 = *(const float4*)(lng + ch + 4);
            const float4 b0 = *(const float4*)(lnb + ch), b1 = *(const float4*)(lnb + ch + 4);
            bf16_t* bd = Bs + (c8 * 8) * AP + j;
            bd[0 * AP] = f2bf((bflo(qv.x) - mean) * rstd * g0.x + b0.x);
            bd[1 * AP] = f2bf((bfhi(qv.x) - mean) * rstd * g0.y + b0.y);
            bd[2 * AP] = f2bf((bflo(qv.y) - mean) * rstd * g0.z + b0.z);
            bd[3 * AP] = f2bf((bfhi(qv.y) - mean) * rstd * g0.w + b0.w);
            bd[4 * AP] = f2bf((bflo(qv.z) - mean) * rstd * g1.x + b1.x);
            bd[5 * AP] = f2bf((bfhi(qv.z) - mean) * rstd * g1.y + b1.y);
            bd[6 * AP] = f2bf((bflo(qv.w) - mean) * rstd * g1.z + b1.z);
            bd[7 * AP] = f2bf((bfhi(qv.w) - mean) * rstd * g1.w + b1.w);
        }
        __syncthreads();
        f32x16 acc[2];
#pragma unroll
        for (int r = 0; r < 16; ++r) { acc[0][r] = 0.f; acc[1][r] = 0.f; }
        const bf16_t* a_s = As + (w * 32 + l32) * AP + 8 * h;
        const bf16_t* b_s = Bs + l32 * AP + 8 * h;
#pragma unroll
        for (int ks = 0; ks < 8; ++ks) {
            bf16x8 a = *(const bf16x8*)(a_s + ks * 16);
            bf16x8 b0 = *(const bf16x8*)(b_s + ks * 16);
            bf16x8 b1 = *(const bf16x8*)(b_s + 32 * AP + ks * 16);
            acc[0] = MFMA(a, b0, acc[0]);
            acc[1] = MFMA(a, b1, acc[1]);
        }
        __syncthreads();
        float* stgf = (float*)As;
#pragma unroll
        for (int j2 = 0; j2 < 2; ++j2)
#pragma unroll
            for (int r = 0; r < 16; ++r) {
                const int rr = (r & 3) + 8 * (r >> 2);
                stgf[(w * 32 + rr + 4 * h) * 68 + j2 * 32 + l32] = acc[j2][r] + (bs + hd * 128 + rr)[4 * h];
            }
        __syncthreads();
#pragma unroll
        for (int i = 0; i < 4; ++i) {
            const int row = (t >> 3) + 32 * i, c8 = t & 7;
            const float4 lo = *(const float4*)(stgf + row * 68 + c8 * 8), hi = *(const float4*)(stgf + row * 68 + c8 * 8 + 4);
            const uint4 uv = ld_nt16(ub0 + (size_t)row * 512 + hd * 64 + c8 * 8);
            uint4 ov;
            ov.x = pack2(bflo(uv.x) * lo.x, bfhi(uv.x) * lo.y); ov.y = pack2(bflo(uv.y) * lo.z, bfhi(uv.y) * lo.w);
            ov.z = pack2(bflo(uv.z) * hi.x, bfhi(uv.z) * hi.y); ov.w = pack2(bflo(uv.w) * hi.z, bfhi(uv.w) * hi.w);
            *(uint4*)(om0 + (size_t)row * DM + hd * 64 + c8 * 8) = ov;
            const float q0 = bflo(ov.x), q1 = bfhi(ov.x), q2 = bflo(ov.y), q3 = bfhi(ov.y), q4 = bflo(ov.z), q5 = bfhi(ov.z), q6 = bflo(ov.w), q7 = bfhi(ov.w);
            const float sqp = q0 * q0 + q1 * q1 + q2 * q2 + q3 * q3 + q4 * q4 + q5 * q5 + q6 * q6 + q7 * q7;
            if (i == 0) rq0 += sqp; else if (i == 1) rq1 += sqp; else if (i == 2) rq2 += sqp; else rq3 += sqp;
        }
        __syncthreads();
    }
#define GM_FIN(RQ, i) { float s_ = RQ; s_ += __shfl_xor(s_, 1); s_ += __shfl_xor(s_, 2); s_ += __shfl_xor(s_, 4); const float sc_ = rsqrtf(s_ * (1.f / 512.f) + EPS); \
        const int row = (t >> 3) + 32 * (i), c8 = t & 7; \
        for (int hd = 0; hd < 8; ++hd) { uint4* ptr = (uint4*)(om0 + (size_t)row * DM + hd * 64 + c8 * 8); uint4 v = *ptr; \
            v.x = pack2(bflo(v.x) * sc_, bfhi(v.x) * sc_); v.y = pack2(bflo(v.y) * sc_, bfhi(v.y) * sc_); v.z = pack2(bflo(v.z) * sc_, bfhi(v.z) * sc_); v.w = pack2(bflo(v.w) * sc_, bfhi(v.w) * sc_); *ptr = v; } }
    GM_FIN(rq0, 0) GM_FIN(rq1, 1) GM_FIN(rq2, 2) GM_FIN(rq3, 3)
#undef GM_FIN
}

DI void ph_memkv(KP p, char* smem) {
    for_tiles(DEPTH * 16 * 16, [&](int t) __attribute__((always_inline)) {
        const int l = t >> 8, rt = (t >> 4) & 15, ct = t & 15;
        f32x16 acc[2][2];
        gemm_tile<1>((const bf16_t*)(p->ws + OFF_MEMB), DM, rt * 128, 0, NBATCH * NMEM, (const bf16_t*)(p->ws + OFF_WMKV) + ((size_t)l * 2048 + ct * 128) * DM, DM, DM, smem, acc);
        EpiMemKV e{(bf16_t*)(p->ws + OFF_KMEM) + (size_t)l * NBATCH * 4 * 256 * 256, (bf16_t*)(p->ws + OFF_VMEM) + (size_t)l * NBATCH * 4 * 256 * 256,
                   (const float*)(smem + RS_OFF), rt * 128, ct * 128};
        run_epi(acc, e);
    });
}
DI float* stage_tile(const f32x16 (&acc)[2][2], const float* rs, char* smem) {
    const int tt = tid(), lane = tt & 63, w = __builtin_amdgcn_readfirstlane(tt >> 6), wm = w >> 1, wn = w & 1, l32 = lane & 31, h = lane >> 5;
    float* stg = (float*)smem;
#pragma unroll
    for (int i = 0; i < 2; ++i)
#pragma unroll
        for (int j = 0; j < 2; ++j)
#pragma unroll
            for (int r = 0; r < 16; ++r) {
                const int row = wm * 64 + i * 32 + crow(r, h);
                stg[row * 132 + wn * 64 + j * 32 + l32] = rs ? acc[i][j][r] * rs[row] : acc[i][j][r];
            }
    __syncthreads();
    return stg;
}
DI uint4 pack8(const float4& a, const float4& b) { uint4 o; o.x = pack2(a.x, a.y); o.y = pack2(a.z, a.w); o.z = pack2(b.x, b.y); o.w = pack2(b.z, b.w); return o; }
DI float4 gelu4(const float4& a) { float4 o; o.x = gelu_tanh(a.x); o.y = gelu_tanh(a.y); o.z = gelu_tanh(a.z); o.w = gelu_tanh(a.w); return o; }
DI void rope8(float4& lo, float4& hi, const float4& plo, const float4& phi, const float* cs, const float* sn, int c) {
    const float4 c0 = *(const float4*)(cs + (c & 15)), c1 = *(const float4*)(cs + (c & 15) + 4);
    const float4 s0 = *(const float4*)(sn + (c & 15)), s1 = *(const float4*)(sn + (c & 15) + 4);
    const float sg = c < 16 ? -1.f : 1.f;
    lo.x = lo.x * c0.x + sg * plo.x * s0.x; lo.y = lo.y * c0.y + sg * plo.y * s0.y; lo.z = lo.z * c0.z + sg * plo.z * s0.z; lo.w = lo.w * c0.w + sg * plo.w * s0.w;
    hi.x = hi.x * c1.x + sg * phi.x * s1.x; hi.y = hi.y * c1.y + sg * phi.y * s1.y; hi.z = hi.z * c1.z + sg * phi.z * s1.z; hi.w = hi.w * c1.w + sg * phi.w * s1.w;
}

DI void ph_in(KP p, int l, const float* xin, char* smem) {
    for_tiles(512 * 12, [&](int t) __attribute__((always_inline)) {
        int rt, ct; tile_rc(t, 12, rt, ct);
        f32x16 acc[2][2];
        const float rsp = rs_load(p, rt * 128);
        gemm_tile<0, true>((const bf16_t*)(p->ws + OFF_XB), DM, rt * 128, 0, TOK, (const bf16_t*)(p->ws + OFF_WIN) + ((size_t)l * INCP + ct * 128) * DM, DM, DM, smem, acc);
        rs_finish(rsp, rt * 128, smem);
        const float* stg = stage_tile(acc, (const float*)(smem + RS_OFF), smem);
        const int tt = tid(), c8 = tt & 15, nb = ct * 128 + c8 * 8;
        if (nb < INC) {
#pragma unroll
            for (int i = 0; i < 8; ++i) {
                const int row = (tt >> 4) + 16 * i, tok = rt * 128 + row;
                float4 lo = *(const float4*)(stg + row * 132 + c8 * 8), hi = *(const float4*)(stg + row * 132 + c8 * 8 + 4);
                if (nb < 256) st_nt16((bf16_t*)(p->ws + OFF_HQ) + (size_t)tok * 256 + nb, pack8(lo, hi));
                else if (nb < 384) st_nt16((bf16_t*)(p->ws + OFF_HKV) + (size_t)tok * 128 + (nb - 256), pack8(lo, hi));
                else if (nb < 416) {
                    const int c = nb - 384, pc = c8 * 8 + (c < 16 ? 16 : -16);
                    const float4 plo = *(const float4*)(stg + row * 132 + pc), phi = *(const float4*)(stg + row * 132 + pc + 4);
                    rope8(lo, hi, plo, phi, (const float*)(p->ws + OFF_COS) + (size_t)tok * 16, (const float*)(p->ws + OFF_SIN) + (size_t)tok * 16, c);
                    const uint4 ov = pack8(lo, hi);
                    const int b = tok >> 13, sx = tok & 8191;
                    bf16_t* dst = (bf16_t*)(p->ws + OFF_K) + (((size_t)(b * 8)) * SEQ + sx) * 96 + 64 + c;
#pragma unroll
                    for (int hd = 0; hd < 8; ++hd) st_nt16(dst + (size_t)hd * SEQ * 96, ov);
                } else if (nb < 928) st_nt16((bf16_t*)(p->ws + OFF_U) + (size_t)tok * 512 + (nb - 416), pack8(gelu4(lo), gelu4(hi)));
                else st_nt16((bf16_t*)(p->ws + OFF_V) + (size_t)tok * 512 + (nb - 928), pack8(gelu4(lo), gelu4(hi)));
            }
        }
    });
}
DI void ph_qkv(KP p, int l, char* smem) {
    for_tiles(512 * 14, [&](int t) __attribute__((always_inline)) {
        int rt, ct; tile_rc(t, 14, rt, ct);
        f32x16 acc[2][2];
        if (ct < 6) {
            gemm_tile<1>((const bf16_t*)(p->ws + OFF_HQ), QL, rt * 128, 0, TOK, (const bf16_t*)(p->ws + OFF_WUQ) + ((size_t)l * 768 + ct * 128) * QL, QL, QL, smem, acc);
            const float* stg = stage_tile(acc, (const float*)(smem + RS_OFF), smem);
            const int tt = tid(), c8 = tt & 15, n8 = ct * 128 + c8 * 8, head = n8 / 96, w0 = n8 - head * 96;
            const float qs = 0.10206207261596575f * LOG2E;
#pragma unroll
            for (int i = 0; i < 8; ++i) {
                const int row = (tt >> 4) + 16 * i, tok = rt * 128 + row;
                float4 lo = *(const float4*)(stg + row * 132 + c8 * 8), hi = *(const float4*)(stg + row * 132 + c8 * 8 + 4);
                if (w0 >= 64) {
                    const int c = w0 - 64, pc = c8 * 8 + (c < 16 ? 16 : -16);
                    const float4 plo = *(const float4*)(stg + row * 132 + pc), phi = *(const float4*)(stg + row * 132 + pc + 4);
                    rope8(lo, hi, plo, phi, (const float*)(p->ws + OFF_COS) + (size_t)tok * 16, (const float*)(p->ws + OFF_SIN) + (size_t)tok * 16, c);
                }
                lo.x *= qs; lo.y *= qs; lo.z *= qs; lo.w *= qs; hi.x *= qs; hi.y *= qs; hi.z *= qs; hi.w *= qs;
                const int b = tok >> 13, sx = tok & 8191;
                st_nt16((bf16_t*)(p->ws + OFF_Q) + (((size_t)(b * 8 + head)) * SEQ + sx) * 96 + w0, pack8(lo, hi));
            }
        } else {
            const int c2 = ct - 6;
            gemm_tile<1>((const bf16_t*)(p->ws + OFF_HKV), KVL, rt * 128, 0, TOK, (const bf16_t*)(p->ws + OFF_WUKV) + ((size_t)l * 1024 + c2 * 128) * KVL, KVL, KVL, smem, acc);
            const float* stg = stage_tile(acc, (const float*)(smem + RS_OFF), smem);
            const int tt = tid(), tok0 = rt * 128, b = tok0 >> 13, s0 = tok0 & 8191;
            {
                const int c8 = tt & 7;
#pragma unroll
                for (int i = 0; i < 4; ++i) {
                    const int row = (tt >> 3) + 32 * i;
                    const float4 lo = *(const float4*)(stg + row * 132 + c8 * 8), hi = *(const float4*)(stg + row * 132 + c8 * 8 + 4);
                    st_nt16((bf16_t*)(p->ws + OFF_K) + (((size_t)(b * 8 + c2)) * SEQ + s0 + row) * 96 + c8 * 8, pack8(lo, hi));
                }
            }
            {
                const int tc = tt & 15;
#pragma unroll
                for (int i = 0; i < 4; ++i) {
                    const int d = (tt >> 4) + 16 * i;
                    const float* sp = stg + (tc * 8) * 132 + 64 + d;
                    uint4 ov;
                    ov.x = pack2(sp[0], sp[132]); ov.y = pack2(sp[2 * 132], sp[3 * 132]); ov.z = pack2(sp[4 * 132], sp[5 * 132]); ov.w = pack2(sp[6 * 132], sp[7 * 132]);
                    st_nt16((bf16_t*)(p->ws + OFF_VT) + (((size_t)(b * 8 + c2)) * 64 + d) * SEQ + s0 + tc * 8, ov);
                }
            }
        }
    });
}
DI void ph_mix(KP p, int l, char* smem) {
    for_tiles(512, [&](int t) __attribute__((always_inline)) { mla_item(p, t, smem); });
    for_tiles(512, [&](int t) __attribute__((always_inline)) { gmlp_item(p, l, t, smem); });
}
DI void ph_res(KP p, const bf16_t* A, int K, const bf16_t* Wt, const float* xin, char* smem, bool dry) {
    for_tiles(512 * 8, [&](int t) __attribute__((always_inline)) {
        int rt, ct; tile_rc(t, 8, rt, ct);
        f32x16 acc[2][2];
        gemm_tile<0>(A, K, rt * 128, 0, TOK, Wt + (size_t)ct * 128 * K, K, K, smem, acc);
        if (dry) return;
        const int tt = tid(), lane = tt & 63, w = __builtin_amdgcn_readfirstlane(tt >> 6), wm = w >> 1, wn = w & 1, l32 = lane & 31, h = lane >> 5;
        float* stg = (float*)smem;
#pragma unroll
        for (int i = 0; i < 2; ++i)
#pragma unroll
            for (int j = 0; j < 2; ++j)
#pragma unroll
                for (int r = 0; r < 16; ++r) stg[(wm * 64 + i * 32 + crow(r, h)) * 132 + wn * 64 + j * 32 + l32] = acc[i][j][r];
        __syncthreads();
        bf16_t* xb = (bf16_t*)(p->ws + OFF_XB) + (size_t)(rt * 128) * DM + ct * 128;
        float* part = (float*)(p->ws + OFF_RSC) + (size_t)(rt * 128) * 16 + ct * 2;
        const int c8 = tt & 15;
#pragma unroll
        for (int i = 0; i < 8; ++i) {
            const int row = (tt >> 4) + 16 * i;
            const float4 lo = *(const float4*)(stg + row * 132 + c8 * 8), hi = *(const float4*)(stg + row * 132 + c8 * 8 + 4);
            uint4* gp = (uint4*)(xb + (size_t)row * DM + c8 * 8);
            const uint4 xv = ld_nt16(gp);
            uint4 nv;
            nv.x = pack2h(hlo(xv.x) + lo.x, hhi(xv.x) + lo.y); nv.y = pack2h(hlo(xv.y) + lo.z, hhi(xv.y) + lo.w);
            nv.z = pack2h(hlo(xv.z) + hi.x, hhi(xv.z) + hi.y); nv.w = pack2h(hlo(xv.w) + hi.z, hhi(xv.w) + hi.w);
            st_nt16(gp, nv);
            float s0 = hlo(nv.x), s1 = hhi(nv.x), s2 = hlo(nv.y), s3 = hhi(nv.y), s4 = hlo(nv.z), s5 = hhi(nv.z), s6 = hlo(nv.w), s7 = hhi(nv.w);
            float sq = s0 * s0 + s1 * s1 + s2 * s2 + s3 * s3 + s4 * s4 + s5 * s5 + s6 * s6 + s7 * s7;
            sq += __shfl_xor(sq, 1); sq += __shfl_xor(sq, 2); sq += __shfl_xor(sq, 4); sq += __shfl_xor(sq, 8);
            if (c8 == 0) { float2 pv; pv.x = sq; pv.y = 0.f; *(float2*)(part + (size_t)row * 16) = pv; }
        }
    });
}
DI void ph_qm(KP p, int l, char* smem) {
    for_tiles(512 * 8, [&](int t) __attribute__((always_inline)) {
        int rt, ct; tile_rc(t, 8, rt, ct);
        f32x16 acc[2][2];
        const float rsp = rs_load(p, rt * 128);
        gemm_tile<0, true>((const bf16_t*)(p->ws + OFF_XB), DM, rt * 128, 0, TOK, (const bf16_t*)(p->ws + OFF_WMQ) + ((size_t)l * DM + ct * 128) * DM, DM, DM, smem, acc);
        rs_finish(rsp, rt * 128, smem);
        const float* stg = stage_tile(acc, (const float*)(smem + RS_OFF), smem);
        const int tt = tid(), c8 = tt & 15;
        const float qs = 0.0625f * LOG2E;
#pragma unroll
        for (int i = 0; i < 8; ++i) {
            const int row = (tt >> 4) + 16 * i;
            float4 lo = *(const float4*)(stg + row * 132 + c8 * 8), hi = *(const float4*)(stg + row * 132 + c8 * 8 + 4);
            lo.x *= qs; lo.y *= qs; lo.z *= qs; lo.w *= qs; hi.x *= qs; hi.y *= qs; hi.z *= qs; hi.w *= qs;
            st_nt16((bf16_t*)(p->ws + OFF_QM) + (size_t)(rt * 128 + row) * DM + ct * 128 + c8 * 8, pack8(lo, hi));
        }
    });
}
DI void ph_memattn(KP p, int l, char* smem) {
    for_tiles(NBATCH * 128 * 4, [&](int t) __attribute__((always_inline)) { memattn_item(p, l, t, smem); });
}
typedef float f32p __attribute__((ext_vector_type(2)));
DI void ph_up(KP p, int l, char* smem) {
    for_tiles(NBATCH * 66 * 44, [&](int t) __attribute__((always_inline)) {
        int rt, ct; tile_rc(t, 44, rt, ct);
        const int b = rt / 66, rl = rt - b * 66, s0 = rl * 126;
        const float* cw = p->conv_w + (size_t)l * 3 * 2 * DFF; const float* cb = p->conv_b + (size_t)l * 2 * DFF;
        const int cp2 = (tid() & 31) * 2, c = ct * 64 + cp2, c2 = DFF + c;
        const f32p g0 = *(const f32p*)(cw + c), g1 = *(const f32p*)(cw + 2 * DFF + c), g2 = *(const f32p*)(cw + 4 * DFF + c), gb = *(const f32p*)(cb + c);
        const f32p u0 = *(const f32p*)(cw + c2), u1 = *(const f32p*)(cw + 2 * DFF + c2), u2 = *(const f32p*)(cw + 4 * DFF + c2), ub = *(const f32p*)(cb + c2);
        f32x16 acc[2][2];
        const float rsp = rs_load(p, b * SEQ + s0 - 1);
        if (rl == 0 || rl == 65) gemm_tile<0, true, true>((const bf16_t*)(p->ws + OFF_XB), DM, b * SEQ + s0 - 1, b * SEQ, (b + 1) * SEQ, (const bf16_t*)(p->ws + OFF_WUP) + ((size_t)l * 2 * DFF + ct * 128) * DM, DM, DM, smem, acc);
        else gemm_tile<0, true, false>((const bf16_t*)(p->ws + OFF_XB), DM, b * SEQ + s0 - 1, b * SEQ, (b + 1) * SEQ, (const bf16_t*)(p->ws + OFF_WUP) + ((size_t)l * 2 * DFF + ct * 128) * DM, DM, DM, smem, acc);
        rs_finish(rsp, b * SEQ + s0 - 1, smem);
        const float* rs = (const float*)(smem + RS_OFF);
        float* stg = (float*)smem;
        const int tt = tid(), lane = tt & 63, w = __builtin_amdgcn_readfirstlane(tt >> 6), wm = w >> 1, wn = w & 1, l32 = lane & 31, h = lane >> 5;
#pragma unroll
        for (int i = 0; i < 2; ++i)
#pragma unroll
            for (int j = 0; j < 2; ++j)
#pragma unroll
                for (int r = 0; r < 16; ++r) {
                    const int row = wm * 64 + i * 32 + crow(r, h), col = wn * 64 + j * 32 + l32;
                    stg[row * 130 + col] = acc[i][j][r] * rs[row];
                }
        __syncthreads();
        bf16_t* act = (bf16_t*)(p->ws + OFF_ACT);
        const int rmax = min(126, SEQ - s0);
        const int rbeg = w * 32 + h * 16, rend = min(rbeg + 16, rmax);
        if (rbeg < rend) {
            const float* sg = stg + rbeg * 130 + cp2;
            unsigned* arow = (unsigned*)(act + ((size_t)b * SEQ + s0 + rbeg) * DFF + c);
            f32p ga = *(const f32p*)sg, gm = *(const f32p*)(sg + 130), ua = *(const f32p*)(sg + 64), um = *(const f32p*)(sg + 130 + 64);
#pragma unroll 4
            for (int r = rbeg; r < rend; ++r) {
                sg += 130;
                const f32p gn = *(const f32p*)(sg + 130), un = *(const f32p*)(sg + 130 + 64);
                const f32p g = g0 * ga + g1 * gm + g2 * gn + gb;
                const f32p up = u0 * ua + u1 * um + u2 * un + ub;
                const f32p e = g * (-LOG2E);
                f32p den; den.x = 1.f + ex2(e.x); den.y = 1.f + ex2(e.y);
                f32p sig; sig.x = __builtin_amdgcn_rcpf(den.x); sig.y = __builtin_amdgcn_rcpf(den.y);
                const f32p o = g * sig * up;
                st_nt4(arow, pack2(o.x, o.y));
                arow += DFF / 2;
                ga = gm; gm = gn; ua = um; um = un;
            }
        }
    });
}
DI void ph_final(KP p) {
    const int lane = tid() & 63, wv = blockIdx.x * 4 + (tid() >> 6), nw = gridDim.x * 4;
    const bf16_t* xbp = (const bf16_t*)(p->ws + OFF_XB);
    const float* rsc = (const float*)(p->ws + OFF_RSC);
    for (int row = wv; row < TOK; row += nw) {
        const uint4* xr = (const uint4*)(xbp + (size_t)row * DM);
        float4* orow = (float4*)(p->out + (size_t)row * DM);
        float ps = lane < 16 ? rsc[(size_t)row * 16 + lane] : 0.f;
        ps += __shfl_xor(ps, 1); ps += __shfl_xor(ps, 2); ps += __shfl_xor(ps, 4); ps += __shfl_xor(ps, 8);
        const float sc = rsqrtf(__shfl(ps, 0) * (1.f / DM) + EPS);
#pragma unroll
        for (int i = 0; i < 2; ++i) {
            const uint4 v = ld_nt16(xr + lane + 64 * i);
            const float4 g0 = ((const float4*)p->final_norm_g)[2 * (lane + 64 * i)], g1 = ((const float4*)p->final_norm_g)[2 * (lane + 64 * i) + 1];
            float4 o0, o1;
            o0.x = hlo(v.x) * sc * g0.x; o0.y = hhi(v.x) * sc * g0.y; o0.z = hlo(v.y) * sc * g0.z; o0.w = hhi(v.y) * sc * g0.w;
            o1.x = hlo(v.z) * sc * g1.x; o1.y = hhi(v.z) * sc * g1.y; o1.z = hlo(v.w) * sc * g1.z; o1.w = hhi(v.w) * sc * g1.w;
            orow[2 * (lane + 64 * i)] = o0; orow[2 * (lane + 64 * i) + 1] = o1;
        }
    }
}

#define XB_TMO      128
#define XB_XCNT(j)  (256  + 64 * (j))
#define XB_XSUB(j)  (1280 + 64 * (j))
#define XB_XGEN(j)  (2304 + 64 * (j))
#define XB_TOP      3328
#define XB_TOPGEN   3392
#define XCD_BAR_WORDS 3456
#define XB_SPIN_CAP (1u << 22)
#define LAS __attribute__((address_space(3)))
static_assert(XCD_BAR_WORDS * 4 <= BAR_BYTES, "barrier words");
DI unsigned xb_ld(unsigned* p) { return __hip_atomic_load(p, __ATOMIC_RELAXED, __HIP_MEMORY_SCOPE_AGENT); }
DI unsigned xb_add(unsigned* p, unsigned v) { return __hip_atomic_fetch_add(p, v, __ATOMIC_RELAXED, __HIP_MEMORY_SCOPE_AGENT); }
DI unsigned xb_xcc_id() { return (unsigned)__builtin_amdgcn_s_getreg((3 << 11) | 20) & 0xFu; }
#define XB_SPIN(cond, bar) do { unsigned _sp = 0; while (cond) { __builtin_amdgcn_s_sleep(1); \
    if ((++_sp & 255u) == 0u) { if (xb_ld(&(bar)[XB_TMO])) break; if (_sp > XB_SPIN_CAP) { atomicAdd(&(bar)[XB_TMO], 1u); break; } } } } while (0)
struct XcdBarrier { unsigned* bar; unsigned x; volatile LAS unsigned* st; };
DI XcdBarrier xcd_barrier_post(unsigned* bar, volatile LAS unsigned* st) {
    XcdBarrier b; b.bar = bar; b.x = xb_xcc_id(); b.st = st;
    if (threadIdx.x == 0) (void)xb_add(&bar[XB_XCNT(b.x)], 1u);
    return b;
}
DI void xcd_barrier_complete(unsigned* bar, unsigned x, unsigned& nloc, unsigned& nx) {
    const unsigned G = gridDim.x * gridDim.y * gridDim.z;
    unsigned sum, cnt, mine, sp = 0u;
    for (;;) {
        sum = 0u; cnt = 0u; mine = 0u;
#pragma unroll
        for (unsigned j = 0; j < 16; ++j) { const unsigned c = xb_ld(&bar[XB_XCNT(j)]); sum += c; cnt += (c > 0u) ? 1u : 0u; mine = (j == x) ? c : mine; }
        if (sum == G) break;
        __builtin_amdgcn_s_sleep(1);
        if ((++sp & 255u) == 0u) { if (xb_ld(&bar[XB_TMO])) break; if (sp > XB_SPIN_CAP) { atomicAdd(&bar[XB_TMO], 1u); break; } }
    }
    nloc = mine > 0u ? mine : 1u; nx = cnt > 0u ? cnt : 1u;
}
DI void xcd_barrier(const XcdBarrier& b) {
    asm volatile("s_waitcnt vmcnt(0)" ::: "memory");
    __syncthreads();
    if (threadIdx.x == 0) {
        unsigned* bar = b.bar;
        __builtin_amdgcn_s_waitcnt(0);
        unsigned nloc = b.st[0], nx = b.st[1];
        if (nloc == 0u) { xcd_barrier_complete(bar, b.x, nloc, nx); b.st[0] = nloc; b.st[1] = nx; }
        const unsigned old = xb_add(&bar[XB_XSUB(b.x)], 1u);
        const unsigned gen = old / nloc;
        if (old + 1u == (gen + 1u) * nloc) {
            __builtin_amdgcn_fence(__ATOMIC_RELEASE, "agent");
            asm volatile("s_waitcnt vmcnt(0)" ::: "memory");
            const unsigned og = xb_add(&bar[XB_TOP], 1u);
            const unsigned tg = og / nx;
            if (og + 1u == (tg + 1u) * nx) xb_add(&bar[XB_TOPGEN], 1u);
            else XB_SPIN(xb_ld(&bar[XB_TOPGEN]) == tg, bar);
            __builtin_amdgcn_fence(__ATOMIC_ACQUIRE, "agent");
            xb_add(&bar[XB_XGEN(b.x)], 1u);
            asm volatile("s_waitcnt vmcnt(0)" ::: "memory");
        } else {
            XB_SPIN(xb_ld(&bar[XB_XGEN(b.x)]) == gen, bar);
            __builtin_amdgcn_fence(__ATOMIC_ACQUIRE, "agent");
            asm volatile("s_waitcnt vmcnt(0)" ::: "memory");
        }
    }
    __syncthreads();
}

constexpr int NPHASE = 2 + 9 * DEPTH + 1;
__global__ void __launch_bounds__(256, 2) mk(Params p_unused, int lo, int hi) {
    extern __shared__ __attribute__((aligned(16))) char smem[];
    cg::grid_group grid = cg::this_grid();
    volatile LAS unsigned* xst = (volatile LAS unsigned*)(smem + RS_OFF + 512);
    if (threadIdx.x == 0) { xst[0] = 0u; xst[1] = 0u; xst[2] = 0u; xst[3] = 0u; }
    __syncthreads();
    const XcdBarrier xbar = xcd_barrier_post((unsigned*)(kparams()->ws + OFF_BAR), xst);
    for (int ph = lo; ph < hi; ++ph) {
        KP p = kparams();
        if (ph == 0) phase_setup(p, smem);
        else if (ph == 1) ph_memkv(p, smem);
        else if (ph == NPHASE - 1) ph_final(p);
        else {
            const int l = (ph - 2) / 9, s = (ph - 2) % 9;
            const float* xin = l == 0 ? p->x : p->out;
            const int reps = ((REPMASK >> s) & 1) ? 2 : 1;
            for (int rep = 0; rep < reps; ++rep) {
                const bool dry = rep + 1 < reps;
                switch (s) {
                    case 0: ph_in(p, l, xin, smem); break;
                    case 1: ph_qkv(p, l, smem); break;
                    case 2: ph_mix(p, l, smem); break;
                    case 3: ph_res(p, (const bf16_t*)(p->ws + OFF_OMIX), DM, (const bf16_t*)(p->ws + OFF_WOUT) + (size_t)l * DM * DM, xin, smem, dry); break;
                    case 4: ph_qm(p, l, smem); break;
                    case 5: ph_memattn(p, l, smem); break;
                    case 6: ph_res(p, (const bf16_t*)(p->ws + OFF_OMEM), DM, (const bf16_t*)(p->ws + OFF_WMO) + (size_t)l * DM * DM, p->out, smem, dry); break;
                    case 7: ph_up(p, l, smem); break;
                    case 8: ph_res(p, (const bf16_t*)(p->ws + OFF_ACT), DFF, (const bf16_t*)(p->ws + OFF_WDN) + (size_t)l * DM * DFF, p->out, smem, dry); break;
                }
                if (dry) xcd_barrier(xbar);
            }
        }
        if (ph + 1 < hi) { if (ph == 0) grid.sync(); else if (ph != 1) xcd_barrier(xbar); }
    }
}

extern "C" void kernel_launch(void* const* d_in, const int* in_sizes, int n_in, void* d_out, int out_size, void* d_ws, size_t ws_size, hipStream_t stream) {
    static int grid_blocks = 0;
    if (!grid_blocks) {
        int dev = 0, cus = 0, per_cu = 0;
        hipGetDevice(&dev);
        hipDeviceGetAttribute(&cus, hipDeviceAttributeMultiprocessorCount, dev);
        hipFuncSetAttribute((const void*)mk, hipFuncAttributeMaxDynamicSharedMemorySize, LDS_BYTES);
        hipOccupancyMaxActiveBlocksPerMultiprocessor(&per_cu, (const void*)mk, 256, LDS_BYTES);
        if (per_cu < 1) per_cu = 1;
        if (per_cu > 2) per_cu = 2;
        grid_blocks = cus * per_cu;
        if (ws_size < OFF_END) fprintf(stderr, "kernel_launch: workspace too small: %zu < %zu\n", ws_size, (size_t)OFF_END);
    }
    Params p{};
    const float** fp = (const float**)&p;
    p.x = (const float*)d_in[0]; p.mem = (const float*)d_in[1]; p.pos = (const int*)d_in[2];
    p.norm_mix_g = (const float*)d_in[3]; p.w_in = (const float*)d_in[4]; p.q_norm_g = (const float*)d_in[5]; p.w_uq = (const float*)d_in[6];
    p.kv_norm_g = (const float*)d_in[7]; p.w_ukv = (const float*)d_in[8]; p.sg_ln_g = (const float*)d_in[9]; p.sg_ln_b = (const float*)d_in[10];
    p.sg_w_s = (const float*)d_in[11]; p.sg_b_s = (const float*)d_in[12]; p.out_norm_mla_g = (const float*)d_in[13]; p.out_norm_sg_g = (const float*)d_in[14];
    p.w_out = (const float*)d_in[15]; p.norm_mem_g = (const float*)d_in[16]; p.mem_norm_g = (const float*)d_in[17]; p.w_mq = (const float*)d_in[18];
    p.w_mkv = (const float*)d_in[19]; p.w_mo = (const float*)d_in[20]; p.norm_ffn_g = (const float*)d_in[21]; p.w_up = (const float*)d_in[22];
    p.conv_w = (const float*)d_in[23]; p.conv_b = (const float*)d_in[24]; p.w_down = (const float*)d_in[25]; p.final_norm_g = (const float*)d_in[26];
    p.out = (float*)d_out; p.ws = (char*)d_ws;
    (void)fp;
    (void)hipMemsetAsync((char*)d_ws + OFF_BAR, 0, BAR_BYTES, stream);
#if COOP
    int lo = 0, hi = NPHASE;
    void* args[] = {&p, &lo, &hi};
    hipError_t e = hipLaunchCooperativeKernel((const void*)mk, dim3(grid_blocks), dim3(256), args, LDS_BYTES, stream);
    if (e != hipSuccess) fprintf(stderr, "cooperative launch failed: %s (grid %d)\n", hipGetErrorString(e), grid_blocks);
#else
    for (int ph = 0; ph < NPHASE; ++ph) hipLaunchKernelGGL(mk, dim3(grid_blocks), dim3(256), LDS_BYTES, stream, p, ph, ph + 1);
#endif
}
```

```cpp
#include <hip/hip_runtime.h>
#include <hip/hip_cooperative_groups.h>
#include <stdint.h>
#include <stdio.h>
namespace cg = cooperative_groups;

#ifndef PHMASK
#define PHMASK 0xFFFF
#endif
#ifndef REPMASK
#define REPMASK 0
#endif
#ifndef COOP
#define COOP 1
#endif

typedef unsigned short bf16_t;
typedef __attribute__((ext_vector_type(8))) short bf16x8;
typedef __attribute__((ext_vector_type(16))) float f32x16;
typedef __attribute__((ext_vector_type(4))) unsigned u32x4;
#define DI __device__ __forceinline__
#define MFMA(a, b, c) __builtin_amdgcn_mfma_f32_32x32x16_bf16((a), (b), (c), 0, 0, 0)

constexpr int NBATCH = 8, SEQ = 8192, TOK = NBATCH * SEQ, DM = 1024, DEPTH = 4;
constexpr int NMEM = 256, QL = 256, KVL = 128, ROPE = 32, NOPE = 64, VD = 64, NH = 8;
constexpr int SGW = 512, INC = 1440, INCP = 1536, DFF = 2816;
constexpr float EPS = 1e-6f;
constexpr float LOG2E = 1.4426950408889634f;

constexpr size_t al256(size_t x) { return (x + 255) & ~(size_t)255; }
constexpr size_t SZ_WIN = (size_t)DEPTH * INCP * DM * 2;
constexpr size_t SZ_WUQ = (size_t)DEPTH * 768 * QL * 2;
constexpr size_t SZ_WUKV = (size_t)DEPTH * 1024 * KVL * 2;
constexpr size_t SZ_WS = (size_t)DEPTH * 8 * 128 * 128 * 2;
constexpr size_t SZ_W1K = (size_t)DEPTH * DM * DM * 2;
constexpr size_t SZ_WMKV = (size_t)DEPTH * 2048 * DM * 2;
constexpr size_t SZ_WUP = (size_t)DEPTH * 2 * DFF * DM * 2;
constexpr size_t SZ_WDN = (size_t)DEPTH * DM * DFF * 2;
constexpr size_t OFF_WIN = 0;
constexpr size_t OFF_WUQ = OFF_WIN + SZ_WIN;
constexpr size_t OFF_WUKV = OFF_WUQ + SZ_WUQ;
constexpr size_t OFF_WSG = OFF_WUKV + SZ_WUKV;
constexpr size_t OFF_WOUT = OFF_WSG + SZ_WS;
constexpr size_t OFF_WMQ = OFF_WOUT + SZ_W1K;
constexpr size_t OFF_WMKV = OFF_WMQ + SZ_W1K;
constexpr size_t OFF_WMO = OFF_WMKV + SZ_WMKV;
constexpr size_t OFF_WUP = OFF_WMO + SZ_W1K;
constexpr size_t OFF_WDN = OFF_WUP + SZ_WUP;
constexpr size_t OFF_COS = OFF_WDN + SZ_WDN;
constexpr size_t OFF_SIN = OFF_COS + (size_t)TOK * 16 * 4;
constexpr size_t OFF_KMEM = OFF_SIN + (size_t)TOK * 16 * 4;
constexpr size_t SZ_KMEM = (size_t)DEPTH * NBATCH * 4 * 256 * 256 * 2;
constexpr size_t OFF_VMEM = OFF_KMEM + SZ_KMEM;
constexpr size_t OFF_ACT0 = OFF_VMEM + SZ_KMEM;
constexpr size_t OFF_Q = OFF_ACT0;
constexpr size_t OFF_K = OFF_Q + (size_t)TOK * 8 * 96 * 2;
constexpr size_t OFF_VT = OFF_K + (size_t)TOK * 8 * 96 * 2;
constexpr size_t OFF_U = OFF_VT + (size_t)TOK * 512 * 2;
constexpr size_t OFF_V = OFF_U + (size_t)TOK * 512 * 2;
constexpr size_t OFF_OMIX = OFF_V + (size_t)TOK * 512 * 2;
constexpr size_t OFF_HQ = OFF_OMIX + (size_t)TOK * 1024 * 2;
constexpr size_t OFF_HKV = OFF_HQ + (size_t)TOK * 256 * 2;
constexpr size_t OFF_XB = OFF_HKV + (size_t)TOK * 128 * 2;
constexpr size_t OFF_MEMB = OFF_XB + (size_t)TOK * DM * 2;
constexpr size_t OFF_RSC = OFF_MEMB + (size_t)NBATCH * NMEM * DM * 2;
constexpr size_t OFF_BAR = OFF_RSC + (size_t)TOK * 16 * 4;
constexpr size_t BAR_BYTES = 16384;
constexpr size_t OFF_END = OFF_BAR + BAR_BYTES;
constexpr size_t OFF_QM = OFF_Q;
constexpr size_t OFF_OMEM = OFF_OMIX;
constexpr size_t OFF_ACT = OFF_ACT0;
static_assert(OFF_ACT + (size_t)TOK * DFF * 2 <= OFF_XB, "act alias");
static_assert(OFF_END <= (size_t)1000 * 1024 * 1024, "ws budget");

struct Params {
    const float *x, *mem; const int* pos;
    const float *norm_mix_g, *w_in, *q_norm_g, *w_uq, *kv_norm_g, *w_ukv, *sg_ln_g, *sg_ln_b, *sg_w_s, *sg_b_s,
        *out_norm_mla_g, *out_norm_sg_g, *w_out, *norm_mem_g, *mem_norm_g, *w_mq, *w_mkv, *w_mo, *norm_ffn_g, *w_up,
        *conv_w, *conv_b, *w_down, *final_norm_g;
    float* out; char* ws;
};

typedef const __attribute__((address_space(4))) Params* KP;
DI KP kparams() { KP k = (KP)__builtin_amdgcn_kernarg_segment_ptr(); asm volatile("" : "+s"(k)); return k; }
typedef __bf16 bf16v2_t __attribute__((ext_vector_type(2)));
typedef float f32v2_t __attribute__((ext_vector_type(2)));
DI unsigned pack2(float a, float b) { f32v2_t v = {a, b}; return __builtin_bit_cast(unsigned, __builtin_convertvector(v, bf16v2_t)); }
DI bf16_t f2bf(float f) { return (bf16_t)(pack2(f, f) & 0xffffu); }
typedef _Float16 f16x8 __attribute__((ext_vector_type(8)));
typedef _Float16 f16v2_t __attribute__((ext_vector_type(2)));
DI unsigned pack2h(float a, float b) { f16v2_t v = {(_Float16)a, (_Float16)b}; return __builtin_bit_cast(unsigned, v); }
DI bf16_t f2h(float f) { return __builtin_bit_cast(unsigned short, (_Float16)f); }
DI float h2f(bf16_t u) { return (float)__builtin_bit_cast(_Float16, u); }
DI float hlo(unsigned u) { return h2f((bf16_t)(u & 0xffffu)); }
DI float hhi(unsigned u) { return h2f((bf16_t)(u >> 16)); }
#define MFMA_H(a, b, c) __builtin_amdgcn_mfma_f32_32x32x16_f16(__builtin_bit_cast(f16x8, (a)), __builtin_bit_cast(f16x8, (b)), (c), 0, 0, 0)
DI float bf2f(bf16_t b) { return __uint_as_float((unsigned)b << 16); }
DI float bflo(unsigned u) { return __uint_as_float(u << 16); }
DI float bfhi(unsigned u) { return __uint_as_float(u & 0xffff0000u); }
DI float ex2(float x) { return __builtin_amdgcn_exp2f(x); }
DI float gelu_tanh(float x) { float y = 0.7978845608028654f * (x + 0.044715f * x * x * x); return x * __builtin_amdgcn_rcpf(1.f + ex2(-2.f * LOG2E * y)); }
DI float silu(float x) { return x * __builtin_amdgcn_rcpf(1.f + ex2(-LOG2E * x)); }
DI int tid() { int t = threadIdx.x; asm volatile("" : "+v"(t)); return t; }
DI int crow(int r, int h) { return (r & 3) + 8 * (r >> 2) + 4 * h; }
DI void st_nt16(void* p, const uint4& v) { u32x4 t = {v.x, v.y, v.z, v.w}; __builtin_nontemporal_store(t, (u32x4*)p); }
DI void st_nt4(unsigned* p, unsigned v) { __builtin_nontemporal_store(v, p); }
typedef __attribute__((ext_vector_type(4))) float f32v4_t;
DI void st_nt16f(float4* p, const float4& v) { f32v4_t t = {v.x, v.y, v.z, v.w}; __builtin_nontemporal_store(t, (f32v4_t*)p); }
DI float4 ld_nt16f(const float4* p) { const f32v4_t t = __builtin_nontemporal_load((const f32v4_t*)p); return make_float4(t[0], t[1], t[2], t[3]); }
DI uint4 ld_nt16(const void* p) { const u32x4 t = __builtin_nontemporal_load((const u32x4*)p); return make_uint4(t[0], t[1], t[2], t[3]); }
DI int swap23(int r) { return (r & ~12) | ((r & 4) << 1) | ((r & 8) >> 1); }

template <class F> DI void for_tiles(int ntiles, F f) {
    const int G = gridDim.x, b = blockIdx.x;
    const bool sw = (G & 7) == 0;
    const int tpx = (ntiles + 7) >> 3;
    const int start = sw ? (b >> 3) : b, step = sw ? (G >> 3) : G, lim = sw ? tpx : ntiles, base = sw ? (b & 7) * tpx : 0;
    for (int i = start; i < lim; i += step) {
        const int t = base + i;
        if (t < ntiles) f(t);
    }
}

constexpr int LK = 72;
constexpr int GEMM_LDS = 4 * 128 * LK * 2;
constexpr int RS_OFF = GEMM_LDS;
constexpr int LDS_BYTES = GEMM_LDS + 1024;

template <int AMODE, bool F16 = false, bool MASK = false>
DI void gemm_tile(const bf16_t* __restrict__ Ab, int lda, int row0, int rlo, int rhi,
                  const bf16_t* __restrict__ Bt, int ldb, int K, char* smem, f32x16 (&acc)[2][2]) {
    const int t = tid(), lane = t & 63, w = __builtin_amdgcn_readfirstlane(t >> 6), wm = w >> 1, wn = w & 1, l32 = lane & 31, h = lane >> 5;
    bf16_t* As = (bf16_t*)smem;
    bf16_t* Bs = As + 2 * 128 * LK;
    float* rs = (float*)(smem + RS_OFF);
#pragma unroll
    for (int i = 0; i < 2; ++i)
#pragma unroll
        for (int j = 0; j < 2; ++j)
#pragma unroll
            for (int r = 0; r < 16; ++r) acc[i][j][r] = 0.f;

    uint4 p0a0, p0a1, p0a2, p0a3, p0b0, p0b1, p0b2, p0b3, p1a0, p1a1, p1a2, p1a3, p1b0, p1b1, p1b2, p1b3;
    float ss0 = 0.f, ss1 = 0.f, ss2 = 0.f, ss3 = 0.f;
    const int gr0 = row0 + (t >> 3);
    const bool rv0 = gr0 >= rlo && gr0 < rhi, rv1 = gr0 + 32 >= rlo && gr0 + 32 < rhi, rv2 = gr0 + 64 >= rlo && gr0 + 64 < rhi, rv3 = gr0 + 96 >= rlo && gr0 + 96 < rhi;
    const int nk = K >> 6;
    const int rhm = rhi - 1;
    const unsigned aoff0 = (unsigned)min(max(gr0, rlo), rhm) * (unsigned)lda + 8u * (t & 7);
    const unsigned aoff1 = (unsigned)min(max(gr0 + 32, rlo), rhm) * (unsigned)lda + 8u * (t & 7);
    const unsigned aoff2 = (unsigned)min(max(gr0 + 64, rlo), rhm) * (unsigned)lda + 8u * (t & 7);
    const unsigned aoff3 = (unsigned)min(max(gr0 + 96, rlo), rhm) * (unsigned)lda + 8u * (t & 7);
    const unsigned btoff = (unsigned)((t >> 3) * ldb + 8 * (t & 7));

    __syncthreads();

#define LD1(S, j, k0)                                                                                         \
    {                                                                                                         \
        S##a##j = *(const uint4*)(Ab + (k0) + aoff##j);          \
        S##b##j = *(const uint4*)(Bt + (size_t)(32 * j) * ldb + (k0) + btoff);                                \
    }
#define LOADS(S, k0) { LD1(S, 0, k0) LD1(S, 1, k0) LD1(S, 2, k0) LD1(S, 3, k0) }
#define ST1(S, j, buf)                                                                                        \
    {                                                                                                         \
        uint4 v = S##a##j;                                                                                    \
        if constexpr (MASK) { if (!rv##j) v = make_uint4(0, 0, 0, 0); }     \
        if (AMODE == 1) {                                                                                     \
            float a0 = bflo(v.x), a1 = bfhi(v.x), a2 = bflo(v.y), a3 = bfhi(v.y), a4 = bflo(v.z), a5 = bfhi(v.z), a6 = bflo(v.w), a7 = bfhi(v.w); \
            ss##j += a0 * a0 + a1 * a1 + a2 * a2 + a3 * a3 + a4 * a4 + a5 * a5 + a6 * a6 + a7 * a7;          \
        }                                                                                                     \
        *(uint4*)(As + (buf) * 128 * LK + ((t >> 3) + 32 * j) * LK + 8 * (t & 7)) = v;                        \
        *(uint4*)(Bs + (buf) * 128 * LK + ((t >> 3) + 32 * j) * LK + 8 * (t & 7)) = S##b##j;                  \
    }
#define STORES(S, buf) { ST1(S, 0, buf) ST1(S, 1, buf) ST1(S, 2, buf) ST1(S, 3, buf) }
#define FRAGS(ks, A0, A1, B0, B1) { A0 = *(const bf16x8*)(a_s + (ks) * 16); A1 = *(const bf16x8*)(a_s + 32 * LK + (ks) * 16); B0 = *(const bf16x8*)(b_s + (ks) * 16); B1 = *(const bf16x8*)(b_s + 32 * LK + (ks) * 16); }
#define MMAS(A0, A1, B0, B1) { __builtin_amdgcn_s_setprio(1); if constexpr (F16) { acc[0][0] = MFMA_H(A0, B0, acc[0][0]); acc[0][1] = MFMA_H(A0, B1, acc[0][1]); acc[1][0] = MFMA_H(A1, B0, acc[1][0]); acc[1][1] = MFMA_H(A1, B1, acc[1][1]); } else { acc[0][0] = MFMA(A0, B0, acc[0][0]); acc[0][1] = MFMA(A0, B1, acc[0][1]); acc[1][0] = MFMA(A1, B0, acc[1][0]); acc[1][1] = MFMA(A1, B1, acc[1][1]); } __builtin_amdgcn_s_setprio(0); }
#define COMPUTE(buf)                                                                                          \
    {                                                                                                         \
        const bf16_t* a_s = As + (buf) * 128 * LK + (wm * 64 + l32) * LK + h * 8;                             \
        const bf16_t* b_s = Bs + (buf) * 128 * LK + (wn * 64 + l32) * LK + h * 8;                             \
        bf16x8 xa0, xa1, xb0, xb1, ya0, ya1, yb0, yb1;                                                        \
        FRAGS(0, xa0, xa1, xb0, xb1)                                                                          \
        FRAGS(1, ya0, ya1, yb0, yb1)                                                                          \
        MMAS(xa0, xa1, xb0, xb1)                                                                              \
        FRAGS(2, xa0, xa1, xb0, xb1)                                                                          \
        MMAS(ya0, ya1, yb0, yb1)                                                                              \
        FRAGS(3, ya0, ya1, yb0, yb1)                                                                          \
        MMAS(xa0, xa1, xb0, xb1)                                                                              \
        MMAS(ya0, ya1, yb0, yb1)                                                                              \
    }

    const int klast = (nk - 1) * 64;
    LOADS(p0, 0);
    LOADS(p1, 64);
    STORES(p0, 0);
    LOADS(p0, min(128, klast));
    __syncthreads();
    for (int kt = 0; kt < nk; kt += 2) {
        COMPUTE(0);
        STORES(p1, 1);
        LOADS(p1, min((kt + 3) * 64, klast));
        __syncthreads();
        COMPUTE(1);
        if (kt + 2 < nk) STORES(p0, 0);
        LOADS(p0, min((kt + 4) * 64, klast));
        __syncthreads();
    }
#undef LOADS
#undef STORES
#undef COMPUTE
#undef FRAGS
#undef MMAS
#undef LD1
#undef ST1
    if (AMODE == 1) {
#define RS1(j) { float s = ss##j; s += __shfl_xor(s, 1); s += __shfl_xor(s, 2); s += __shfl_xor(s, 4); if ((t & 7) == 0) rs[(t >> 3) + 32 * j] = rsqrtf(s / (float)K + EPS); }
        RS1(0) RS1(1) RS1(2) RS1(3)
#undef RS1
        __syncthreads();
    }
}

DI float rs_load(KP p, int row0) {
    const int t = tid(), r = row0 + (t >> 1);
    float sum = 0.f;
    if (r >= 0 && r < TOK) {
        const float4* ps = (const float4*)((const float*)(p->ws + OFF_RSC) + (size_t)r * 16 + (t & 1) * 8);
        const float4 a = ps[0], b = ps[1];
        sum = (a.x + a.y) + (a.z + a.w) + (b.x + b.y) + (b.z + b.w);
    }
    return sum;
}
DI void rs_finish(float sum, int row0, char* smem) {
    const int t = tid(), r = row0 + (t >> 1);
    sum += __shfl_xor(sum, 1);
    if ((t & 1) == 0) ((float*)(smem + RS_OFF))[t >> 1] = (r >= 0 && r < TOK) ? rsqrtf(sum * (1.f / DM) + EPS) : 0.f;
    __syncthreads();
}

DI void tile_rc(int t, int NT, int& rt, int& ct) { const int g = t / (8 * NT), rem = t - g * 8 * NT; ct = rem >> 3; rt = g * 8 + (rem & 7); }

template <class E> DI void run_epi(const f32x16 (&acc)[2][2], const E& e) {
    const int w = __builtin_amdgcn_readfirstlane(tid() >> 6), wm = w >> 1, wn = w & 1;
#pragma unroll
    for (int i = 0; i < 2; ++i)
#pragma unroll
        for (int j = 0; j < 2; ++j) e(wm * 64 + i * 32, wn * 64 + j * 32, acc[i][j]);
}

DI int up_perm(int n) { return n < DFF ? (n >> 6) * 128 + (n & 63) : ((n - DFF) >> 6) * 128 + 64 + ((n - DFF) & 63); }

DI void conv_tile(const float* __restrict__ src, int K, int N, const float* g1, const float* g2, int ksplit,
                  bf16_t* __restrict__ dst, int rowmap, int tile, float* lds, int mode, bool f16 = false) {
    const int ntn = N >> 5, tk = tile / ntn, tn = tile - tk * ntn, k0 = tk * 32, n0 = tn * 32;
    const int tx = tid() & 31, ty = tid() >> 5;
    if (mode == 0) {
#pragma unroll
        for (int i = 0; i < 4; ++i) {
            int k = k0 + ty + 8 * i;
            float v = src[(size_t)k * N + n0 + tx];
            float g = g1 ? (k < ksplit ? g1[k] : g2[k - ksplit]) : 1.f;
            lds[(ty + 8 * i) * 33 + tx] = v * g;
        }
    } else {
#pragma unroll
        for (int i = 0; i < 4; ++i) {
            int n = n0 + ty + 8 * i;
            int nn = rowmap ? up_perm(n) : n;
            const float wv = lds[tx * 33 + ty + 8 * i];
            dst[(size_t)nn * K + k0 + tx] = f16 ? f2h(wv) : f2bf(wv);
        }
    }
}

__device__ void phase_setup(KP p, char* smem) {
    float* lds = (float*)smem;
    char* ws = p->ws;
    constexpr int PER_LAYER = 1440 + 192 + 128 + 1024 + 1024 + 2048 + 1024 + 5632 + 2816;
    auto job = [&](int t, float* ldsq, int mode) __attribute__((always_inline)) {
        int l = t / PER_LAYER, r = t - l * PER_LAYER;
        if (r < 1440) conv_tile(p->w_in + (size_t)l * DM * INC, DM, INC, p->norm_mix_g + l * DM, nullptr, DM, (bf16_t*)(ws + OFF_WIN) + (size_t)l * INCP * DM, 0, r, ldsq, mode, true);
        else if ((r -= 1440) < 192) conv_tile(p->w_uq + (size_t)l * QL * 768, QL, 768, p->q_norm_g + l * QL, nullptr, QL, (bf16_t*)(ws + OFF_WUQ) + (size_t)l * 768 * QL, 0, r, ldsq, mode);
        else if ((r -= 192) < 128) conv_tile(p->w_ukv + (size_t)l * KVL * 1024, KVL, 1024, p->kv_norm_g + l * KVL, nullptr, KVL, (bf16_t*)(ws + OFF_WUKV) + (size_t)l * 1024 * KVL, 0, r, ldsq, mode);
        else if ((r -= 128) < 1024) conv_tile(p->w_out + (size_t)l * DM * DM, DM, DM, p->out_norm_mla_g + l * 512, p->out_norm_sg_g + l * 512, 512, (bf16_t*)(ws + OFF_WOUT) + (size_t)l * DM * DM, 0, r, ldsq, mode);
        else if ((r -= 1024) < 1024) conv_tile(p->w_mq + (size_t)l * DM * DM, DM, DM, p->norm_mem_g + l * DM, nullptr, DM, (bf16_t*)(ws + OFF_WMQ) + (size_t)l * DM * DM, 0, r, ldsq, mode, true);
        else if ((r -= 1024) < 2048) conv_tile(p->w_mkv + (size_t)l * DM * 2048, DM, 2048, p->mem_norm_g + l * DM, nullptr, DM, (bf16_t*)(ws + OFF_WMKV) + (size_t)l * 2048 * DM, 0, r, ldsq, mode);
        else if ((r -= 2048) < 1024) conv_tile(p->w_mo + (size_t)l * DM * DM, DM, DM, nullptr, nullptr, DM, (bf16_t*)(ws + OFF_WMO) + (size_t)l * DM * DM, 0, r, ldsq, mode);
        else if ((r -= 1024) < 5632) conv_tile(p->w_up + (size_t)l * DM * 2 * DFF, DM, 2 * DFF, p->norm_ffn_g + l * DM, nullptr, DM, (bf16_t*)(ws + OFF_WUP) + (size_t)l * 2 * DFF * DM, 1, r, ldsq, mode, true);
        else { r -= 5632; conv_tile(p->w_down + (size_t)l * DFF * DM, DFF, DM, nullptr, nullptr, DFF, (bf16_t*)(ws + OFF_WDN) + (size_t)l * DM * DFF, 0, r, ldsq, mode); }
    };
    constexpr int NJOB = PER_LAYER * DEPTH, TPB = 4;
    for (int t0 = blockIdx.x; t0 < NJOB; t0 += TPB * gridDim.x) {
#pragma unroll
        for (int u = 0; u < TPB; ++u) { const int t = t0 + u * gridDim.x; if (t < NJOB) job(t, lds + u * 32 * 33, 0); }
        __syncthreads();
#pragma unroll
        for (int u = 0; u < TPB; ++u) { const int t = t0 + u * gridDim.x; if (t < NJOB) job(t, lds + u * 32 * 33, 1); }
        __syncthreads();
    }
    const size_t gt = (size_t)blockIdx.x * 256 + tid(), gn = (size_t)gridDim.x * 256;
    bf16_t* wsg = (bf16_t*)(ws + OFF_WSG);
    for (size_t i = gt; i < (size_t)DEPTH * 8 * 128 * 128; i += gn) wsg[i] = f2bf(p->sg_w_s[i]);
    for (size_t i = gt; i < (size_t)DEPTH * 96 * DM; i += gn) {
        size_t l = i / (96 * DM), r = i - l * (96 * DM);
        ((bf16_t*)(ws + OFF_WIN))[(l * INCP + INC) * DM + r] = 0;
    }
    {
        {
            const int lane = tid() & 63, wv = blockIdx.x * 4 + (tid() >> 6), nw = gridDim.x * 4;
            float* rsc = (float*)(ws + OFF_RSC);
            for (int row = wv; row < TOK; row += nw) {
                const float4* xs = (const float4*)(p->x + (size_t)row * DM); uint2* xd = (uint2*)(ws + OFF_XB) + (size_t)row * (DM / 4);
                float sacc = 0.f;
#pragma unroll
                for (int i = 0; i < 4; ++i) { float4 v = ld_nt16f(xs + lane + 64 * i); sacc += v.x * v.x + v.y * v.y + v.z * v.z + v.w * v.w; uint2 o; o.x = pack2h(v.x, v.y); o.y = pack2h(v.z, v.w); xd[lane + 64 * i] = o; }
#pragma unroll
                for (int o = 1; o < 64; o <<= 1) sacc += __shfl_xor(sacc, o);
                if (lane < 16) rsc[(size_t)row * 16 + lane] = lane == 0 ? sacc : 0.f;
            }
        }
        const float4* ms = (const float4*)p->mem; uint2* md = (uint2*)(ws + OFF_MEMB);
        for (size_t i = gt; i < (size_t)NBATCH * NMEM * DM / 4; i += gn) { float4 v = ms[i]; uint2 o; o.x = pack2(v.x, v.y); o.y = pack2(v.z, v.w); md[i] = o; }
    }
    float* cs = (float*)(ws + OFF_COS); float* sn = (float*)(ws + OFF_SIN);
    for (size_t i = gt; i < (size_t)TOK * 16; i += gn) {
        int tok = (int)(i >> 4), f = (int)(i & 15);
        const float inv = ex2(-(float)f * 0.83048202372184058f);
        const float ang = (float)p->pos[tok] * inv;
        const float c_hi = 0.15915494309189535f, c_lo = 6.4206383e-9f;
        const float rh = ang * c_hi;
        const float re = fmaf(ang, c_hi, -rh) + ang * c_lo;
        float rf = (rh - floorf(rh)) + re;
        cs[i] = __builtin_amdgcn_cosf(rf);
        sn[i] = __builtin_amdgcn_sinf(rf);
    }
}

struct EpiMemKV {
    bf16_t* km; bf16_t* vm; const float* rs; int row0, col0;
    DI void operator()(int rb, int cb, const f32x16& a) const {
        const int lane = tid() & 63, c = lane & 31, h = lane >> 5;
        const int n0 = col0 + cb;
        if (n0 < 1024) {
            const int head = n0 >> 8, d = (n0 & 255) + c;
#pragma unroll
            for (int r = 0; r < 16; ++r) {
                int row = rb + crow(r, h), gr = row0 + row, b = gr >> 8, key = gr & 255;
                km[(((size_t)(b * 4 + head)) * 256 + key) * 256 + d] = f2bf(a[r] * rs[row]);
            }
        } else {
            const int head = (n0 - 1024) >> 8, d = ((n0 - 1024) & 255) + c;
#pragma unroll
            for (int g = 0; g < 4; ++g) {
                int row = rb + 8 * g + 4 * h, gr = row0 + row, b = gr >> 8, key = gr & 255;
                uint2 pk;
                pk.x = pack2(a[4 * g] * rs[row], a[4 * g + 1] * rs[row + 1]);
                pk.y = pack2(a[4 * g + 2] * rs[row + 2], a[4 * g + 3] * rs[row + 3]);
                *(uint2*)(vm + (((size_t)(b * 4 + head)) * 256 + d) * 256 + key) = pk;
            }
        }
    }
};

struct EpiIn {
    bf16_t *hq, *hkv, *u, *v, *kb; const float *cs, *sn, *rs; int row0, col0;
    DI void operator()(int rb, int cb, const f32x16& a) const {
        const int lane = tid() & 63, c = lane & 31, h = lane >> 5;
        const int nb = col0 + cb;
        if (nb >= INC) return;
        if (nb == 384) {
#pragma unroll
            for (int r = 0; r < 16; ++r) {
                const int row = rb + crow(r, h), tok = row0 + row;
                const float val = a[r] * rs[row];
                float pt = __shfl_xor(val, 16);
                float co = cs[tok * 16 + (c & 15)], si = sn[tok * 16 + (c & 15)];
                float o = (c < 16) ? val * co - pt * si : val * co + pt * si;
                bf16_t ob = f2bf(o);
                const int b = tok >> 13, s = tok & 8191;
                bf16_t* dst = kb + (((size_t)(b * 8)) * SEQ + s) * 96 + 64 + c;
                for (int hd = 0; hd < 8; ++hd) dst[(size_t)hd * SEQ * 96] = ob;
            }
            return;
        }
        bf16_t* dst; int pitch, off; bool act;
        if (nb < 256) { dst = hq; pitch = 256; off = nb; act = false; }
        else if (nb < 384) { dst = hkv; pitch = 128; off = nb - 256; act = false; }
        else if (nb < 928) { dst = u; pitch = 512; off = nb - 416; act = true; }
        else { dst = v; pitch = 512; off = nb - 928; act = true; }
        dst += (size_t)(row0 + rb + 4 * h) * pitch + off + c;
#pragma unroll
        for (int r = 0; r < 16; ++r) {
            const int rr = (r & 3) + 8 * (r >> 2);
            float val = a[r] * rs[rb + rr + 4 * h];
            if (act) val = gelu_tanh(val);
            dst[(size_t)rr * pitch] = f2bf(val);
        }
    }
};

struct EpiQ {
    bf16_t* q; const float *cs, *sn, *rs; int row0, col0;
    DI void operator()(int rb, int cb, const f32x16& a) const {
        const int lane = tid() & 63, c = lane & 31, h = lane >> 5;
        const int n0 = col0 + cb, head = n0 / 96, w0 = n0 - head * 96;
        const float qs = 0.10206207261596575f * LOG2E;
#pragma unroll
        for (int r = 0; r < 16; ++r) {
            const int row = rb + crow(r, h), tok = row0 + row;
            float val = a[r] * rs[row] * qs;
            if (w0 == 64) {
                float pt = __shfl_xor(val, 16);
                float co = cs[tok * 16 + (c & 15)], si = sn[tok * 16 + (c & 15)];
                val = (c < 16) ? val * co - pt * si : val * co + pt * si;
            }
            const int b = tok >> 13, s = tok & 8191;
            q[(((size_t)(b * 8 + head)) * SEQ + s) * 96 + w0 + c] = f2bf(val);
        }
    }
};

struct EpiKV {
    bf16_t *kb, *vstage; const float* rs; int row0, col0;
    DI void operator()(int rb, int cb, const f32x16& a) const {
        const int lane = tid() & 63, c = lane & 31, h = lane >> 5;
        const int n0 = col0 + cb, head = n0 >> 7, w0 = n0 & 127;
        if (w0 < 64) {
#pragma unroll
            for (int r = 0; r < 16; ++r) {
                const int row = rb + crow(r, h), tok = row0 + row, b = tok >> 13, s = tok & 8191;
                kb[(((size_t)(b * 8 + head)) * SEQ + s) * 96 + w0 + c] = f2bf(a[r] * rs[row]);
            }
        } else {
            const int d = w0 - 64 + c;
#pragma unroll
            for (int g = 0; g < 4; ++g) {
                const int row = rb + 8 * g + 4 * h;
                uint2 pk;
                pk.x = pack2(a[4 * g] * rs[row], a[4 * g + 1] * rs[row + 1]);
                pk.y = pack2(a[4 * g + 2] * rs[row + 2], a[4 * g + 3] * rs[row + 3]);
                *(uint2*)(vstage + d * 136 + row) = pk;
            }
        }
    }
};

struct EpiRes {
    bf16_t* xb; int row0, col0; bool dry;
    DI void operator()(int rb, int cb, const f32x16& a, f32x16& sq) const {
        const int lane = tid() & 63, c = lane & 31, h = lane >> 5;
        if (dry && a[0] != 1.2345e30f) return;
        bf16_t* ptr = xb + (size_t)(row0 + rb + 4 * h) * DM + col0 + cb + c;
#pragma unroll
        for (int r = 0; r < 16; ++r) {
            const int rr = (r & 3) + 8 * (r >> 2);
            const bf16_t nb = f2h(h2f(ptr[(size_t)rr * DM]) + a[r]);
            ptr[(size_t)rr * DM] = nb;
            const float nv = h2f(nb);
            sq[r] += nv * nv;
        }
    }
};

struct EpiQm {
    bf16_t* qm; const float* rs; int row0, col0;
    DI void operator()(int rb, int cb, const f32x16& a) const {
        const int lane = tid() & 63, c = lane & 31, h = lane >> 5;
#pragma unroll
        for (int r = 0; r < 16; ++r) {
            const int row = rb + crow(r, h);
            qm[(size_t)(row0 + row) * DM + col0 + cb + c] = f2bf(a[r] * rs[row] * (0.0625f * LOG2E));
        }
    }
};

template <int DQK, int DV, int NBUF, bool QREG, int QW, int LDQ, int LDK, int LDV, int LDO>
DI void flash_item(const bf16_t* __restrict__ Qp, const bf16_t* __restrict__ Kp, const bf16_t* __restrict__ Vtp, int nkt,
                   bf16_t* __restrict__ Op, char* smem, float& ssq) {
    constexpr int KP = DQK + 8;
    constexpr int VP = 72;
    constexpr int CPR = DQK / 8;
    constexpr int KCH = 64 * CPR / 256;
    constexpr int VCH = DV * 8 / 256;
    constexpr int NKS = DQK / 16, NMT = DV / 32 / QW;
    constexpr bool KROWS = (256 % CPR) == 0;
    static_assert(KROWS || LDK == DQK, "K tile addressing");
    static_assert(KCH <= 8 && VCH <= 8, "staging regs");
    static_assert(NBUF == 2 ? (KCH <= 4 && VCH <= 2) : (KCH == 8 && VCH == 8), "staging");
    bf16_t* Ks = (bf16_t*)smem;
    bf16_t* Vs = Ks + NBUF * 64 * KP;
    const int t = tid(), lane = t & 63, w = __builtin_amdgcn_readfirstlane(t >> 6), l32 = lane & 31, h = lane >> 5;
    const int q = (w / QW) * 32 + l32, dv0 = (w % QW) * (DV / QW);
    const unsigned ktoff = KROWS ? (unsigned)((t / CPR) * LDK + (t % CPR) * 8) : (unsigned)(t * 8);
    const unsigned vtoff = (unsigned)((t >> 3) * LDV + (t & 7) * 8);

    bf16x8 qf[QREG ? NKS : 1];
    if constexpr (QREG) {
#pragma unroll
        for (int ks = 0; ks < NKS; ++ks) qf[ks] = *(const bf16x8*)(Qp + (size_t)q * LDQ + ks * 16 + 8 * h);
    }
    f32x16 o[NMT];
#pragma unroll
    for (int mt = 0; mt < NMT; ++mt)
#pragma unroll
        for (int r = 0; r < 16; ++r) o[mt][r] = 0.f;
    float m = -INFINITY, lsum = 0.f;

    uint4 rk0, rk1, rk2, rk3, rk4, rk5, rk6, rk7, rv0, rv1;
    (void)rk0; (void)rk1; (void)rk2; (void)rk3; (void)rk4; (void)rk5; (void)rk6; (void)rk7; (void)rv0; (void)rv1;
#define LKJ(kt, i, R) { const bf16_t* kb_ = KROWS ? Kp + (size_t)((kt) * 64 + (i) * (256 / CPR)) * LDK : Kp + (size_t)(kt) * 64 * DQK + (i) * 2048; R = *(const uint4*)(kb_ + ktoff); }
#define SKJ(buf, i, R) { int c = t + 256 * (i), row = c / CPR, cc = c - row * CPR; *(uint4*)(Ks + (buf) * 64 * KP + swap23(row) * KP + cc * 8) = R; }
#define LVJ(kt, i, R) { const bf16_t* vb_ = Vtp + (size_t)(i) * 32 * LDV + (kt) * 64; R = *(const uint4*)(vb_ + vtoff); }
#define SVJ(buf, i, R) { int c = t + 256 * (i), d = c >> 3, cc = c & 7; *(uint4*)(Vs + (buf) * DV * VP + d * VP + cc * 8) = R; }
#define ATT_LOAD(kt) { LKJ(kt, 0, rk0) if constexpr (KCH > 1) LKJ(kt, 1, rk1) if constexpr (KCH > 2) LKJ(kt, 2, rk2) if constexpr (KCH > 3) LKJ(kt, 3, rk3) LVJ(kt, 0, rv0) if constexpr (VCH > 1) LVJ(kt, 1, rv1) }
#define ATT_STORE(buf) { SKJ(buf, 0, rk0) if constexpr (KCH > 1) SKJ(buf, 1, rk1) if constexpr (KCH > 2) SKJ(buf, 2, rk2) if constexpr (KCH > 3) SKJ(buf, 3, rk3) SVJ(buf, 0, rv0) if constexpr (VCH > 1) SVJ(buf, 1, rv1) }

    __syncthreads();
    if constexpr (NBUF == 2) ATT_LOAD(0);
    for (int kt = 0; kt < nkt; ++kt) {
        const int buf = (NBUF == 2) ? (kt & 1) : 0;
        if constexpr (NBUF == 1) {
            __syncthreads();
            LKJ(kt, 0, rk0) LKJ(kt, 1, rk1) LKJ(kt, 2, rk2) LKJ(kt, 3, rk3)
            LKJ(kt, 4, rk4) LKJ(kt, 5, rk5) LKJ(kt, 6, rk6) LKJ(kt, 7, rk7)
            SKJ(0, 0, rk0) SKJ(0, 1, rk1) SKJ(0, 2, rk2) SKJ(0, 3, rk3)
            asm volatile("" ::: "memory");
            LVJ(kt, 0, rk0) LVJ(kt, 1, rk1) LVJ(kt, 2, rk2) LVJ(kt, 3, rk3)
            SKJ(0, 4, rk4) SKJ(0, 5, rk5) SKJ(0, 6, rk6) SKJ(0, 7, rk7)
            asm volatile("" ::: "memory");
            LVJ(kt, 4, rk4) LVJ(kt, 5, rk5) LVJ(kt, 6, rk6) LVJ(kt, 7, rk7)
            SVJ(0, 0, rk0) SVJ(0, 1, rk1) SVJ(0, 2, rk2) SVJ(0, 3, rk3)
            asm volatile("" ::: "memory");
            SVJ(0, 4, rk4) SVJ(0, 5, rk5) SVJ(0, 6, rk6) SVJ(0, 7, rk7)
        } else { ATT_STORE(buf); }
        __syncthreads();
        if constexpr (NBUF == 2) { if (kt + 1 < nkt) ATT_LOAD(kt + 1); }

        const bf16_t* kb = Ks + buf * 64 * KP + l32 * KP + 8 * h;
        f32x16 s0, s1;
#pragma unroll
        for (int r = 0; r < 16; ++r) { s0[r] = 0.f; s1[r] = 0.f; }
#pragma unroll
        for (int ks = 0; ks < NKS; ++ks) {
            bf16x8 qq;
            if constexpr (QREG) qq = qf[ks]; else qq = *(const bf16x8*)(Qp + (size_t)q * LDQ + ks * 16 + 8 * h);
            bf16x8 k0 = *(const bf16x8*)(kb + ks * 16);
            bf16x8 k1 = *(const bf16x8*)(kb + 32 * KP + ks * 16);
            s0 = MFMA(k0, qq, s0);
            s1 = MFMA(k1, qq, s1);
        }
        float mx = s0[0];
#pragma unroll
        for (int r = 1; r < 16; ++r) mx = fmaxf(mx, s0[r]);
#pragma unroll
        for (int r = 0; r < 16; ++r) mx = fmaxf(mx, s1[r]);
        mx = fmaxf(mx, __shfl_xor(mx, 32));
        const float mn = fmaxf(m, mx);
        const float alpha = ex2(m - mn);
        m = mn;
        float psum = 0.f;
#pragma unroll
        for (int r = 0; r < 16; ++r) { s0[r] = ex2(s0[r] - mn); psum += s0[r]; }
#pragma unroll
        for (int r = 0; r < 16; ++r) { s1[r] = ex2(s1[r] - mn); psum += s1[r]; }
        lsum = lsum * alpha + psum;
        if (__builtin_amdgcn_ballot_w64(alpha != 1.f) != 0ull) {
#pragma unroll
            for (int mt = 0; mt < NMT; ++mt)
#pragma unroll
                for (int r = 0; r < 16; ++r) o[mt][r] *= alpha;
        }
        const bf16_t* vb = Vs + buf * DV * VP + (dv0 + l32) * VP + 8 * h;
#pragma unroll
        for (int t2 = 0; t2 < 2; ++t2)
#pragma unroll
            for (int s2 = 0; s2 < 2; ++s2) {
                u32x4 pu;
#pragma unroll
                for (int j = 0; j < 4; ++j)
                    pu[j] = t2 ? pack2(s1[8 * s2 + 2 * j], s1[8 * s2 + 2 * j + 1]) : pack2(s0[8 * s2 + 2 * j], s0[8 * s2 + 2 * j + 1]);
                const bf16x8 pfv = __builtin_bit_cast(bf16x8, pu);
#pragma unroll
                for (int mt = 0; mt < NMT; ++mt) {
                    bf16x8 vv = *(const bf16x8*)(vb + mt * 32 * VP + t2 * 32 + s2 * 16);
                    o[mt] = MFMA(vv, pfv, o[mt]);
                }
            }
    }
#undef ATT_LOAD
#undef ATT_STORE
#undef LKJ
#undef SKJ
#undef LVJ
#undef SVJ
    const float inv = 1.f / (lsum + __shfl_xor(lsum, 32));
#pragma unroll
    for (int mt = 0; mt < NMT; ++mt)
#pragma unroll
        for (int g = 0; g < 4; ++g) {
            float v0 = o[mt][4 * g] * inv, v1 = o[mt][4 * g + 1] * inv, v2 = o[mt][4 * g + 2] * inv, v3 = o[mt][4 * g + 3] * inv;
            uint2 pk; pk.x = pack2(v0, v1); pk.y = pack2(v2, v3);
            float r0 = bflo(pk.x), r1 = bfhi(pk.x), r2 = bflo(pk.y), r3 = bfhi(pk.y);
            ssq += r0 * r0 + r1 * r1 + r2 * r2 + r3 * r3;
            *(uint2*)(Op + (size_t)q * LDO + dv0 + mt * 32 + 8 * g + 4 * h) = pk;
        }
}

DI void flash_mla2(const bf16_t* __restrict__ Qp, const bf16_t* __restrict__ Kp, const bf16_t* __restrict__ Vtp,
                   bf16_t* __restrict__ Op, char* smem, float& ssq) {
    constexpr int DQK = 96, DV = 64, LDQ = 96, LDV = SEQ, LDO = DM, NKT = SEQ / 64;
    constexpr int KP = DQK + 8, VP = 72, CPR = DQK / 8, NKS = DQK / 16, NMT = DV / 32;
    bf16_t* Ks = (bf16_t*)smem;
    bf16_t* Vs = Ks + 2 * 64 * KP;
    const int t = tid(), lane = t & 63, w = __builtin_amdgcn_readfirstlane(t >> 6), l32 = lane & 31, h = lane >> 5;
    const int q = w * 32 + l32;
    const unsigned ktoff = (unsigned)(t * 8);
    const unsigned vtoff = (unsigned)((t >> 3) * LDV + (t & 7) * 8);
    bf16x8 qf[NKS];
#pragma unroll
    for (int ks = 0; ks < NKS; ++ks) qf[ks] = *(const bf16x8*)(Qp + (size_t)q * LDQ + ks * 16 + 8 * h);
    f32x16 o[NMT];
#pragma unroll
    for (int mt = 0; mt < NMT; ++mt)
#pragma unroll
        for (int r = 0; r < 16; ++r) o[mt][r] = 0.f;
    float m = 0.f, lsum = 0.f;
    uint4 ak0, ak1, ak2, av0, av1, bk0, bk1, bk2, bv0, bv1;
#define M2_LOAD(S, kt) { const bf16_t* kb_ = Kp + (size_t)(kt) * 64 * DQK; S##k0 = *(const uint4*)(kb_ + ktoff); S##k1 = *(const uint4*)(kb_ + 2048 + ktoff); S##k2 = *(const uint4*)(kb_ + 4096 + ktoff); \
        const bf16_t* vb_ = Vtp + (kt) * 64; S##v0 = *(const uint4*)(vb_ + vtoff); S##v1 = *(const uint4*)(vb_ + (size_t)32 * LDV + vtoff); }
#define M2_SK(i, R, buf) { int c = t + 256 * (i), row = c / CPR, cc = c - row * CPR; *(uint4*)(Ks + (buf) * 64 * KP + swap23(row) * KP + cc * 8) = R; }
#define M2_SV(i, R, buf) { int c = t + 256 * (i), d = c >> 3, cc = c & 7; *(uint4*)(Vs + (buf) * DV * VP + d * VP + cc * 8) = R; }
#define M2_STORE(S, buf) { M2_SK(0, S##k0, buf) M2_SK(1, S##k1, buf) M2_SK(2, S##k2, buf) M2_SV(0, S##v0, buf) M2_SV(1, S##v1, buf) }
#define M2_COMPUTE(buf) { \
        if (__builtin_amdgcn_ballot_w64(alpha != 1.f) != 0ull) { \
            _Pragma("unroll") for (int mt = 0; mt < NMT; ++mt) _Pragma("unroll") for (int r = 0; r < 16; ++r) o[mt][r] *= alpha; } \
        lsum *= alpha; \
        const bf16_t* kb = Ks + (buf) * 64 * KP + l32 * KP + 8 * h; \
        f32x16 s0, s1; \
        const float nm = -m; \
        _Pragma("unroll") for (int r = 0; r < 16; ++r) { s0[r] = nm; s1[r] = nm; } \
        _Pragma("unroll") for (int ks = 0; ks < NKS; ++ks) { bf16x8 k0 = *(const bf16x8*)(kb + ks * 16); bf16x8 k1 = *(const bf16x8*)(kb + 32 * KP + ks * 16); s0 = MFMA(k0, qf[ks], s0); s1 = MFMA(k1, qf[ks], s1); } \
        float mx = s0[0]; \
        _Pragma("unroll") for (int r = 1; r < 16; ++r) mx = fmaxf(mx, s0[r]); \
        _Pragma("unroll") for (int r = 0; r < 16; ++r) mx = fmaxf(mx, s1[r]); \
        mx = fmaxf(mx, __shfl_xor(mx, 32)); \
        float psum = 0.f; \
        _Pragma("unroll") for (int r = 0; r < 16; ++r) { s0[r] = ex2(s0[r]); psum += s0[r]; } \
        _Pragma("unroll") for (int r = 0; r < 16; ++r) { s1[r] = ex2(s1[r]); psum += s1[r]; } \
        lsum += psum; \
        const float dgrow = fmaxf(mx, 0.f); alpha = ex2(-dgrow); m += dgrow; \
        const bf16_t* vb = Vs + (buf) * DV * VP + l32 * VP + 8 * h; \
        _Pragma("unroll") for (int s2 = 0; s2 < 2; ++s2) { \
            u32x4 pu0, pu1; \
            _Pragma("unroll") for (int j = 0; j < 4; ++j) { pu0[j] = pack2(s0[8 * s2 + 2 * j], s0[8 * s2 + 2 * j + 1]); pu1[j] = pack2(s1[8 * s2 + 2 * j], s1[8 * s2 + 2 * j + 1]); } \
            const bf16x8 pf0 = __builtin_bit_cast(bf16x8, pu0), pf1 = __builtin_bit_cast(bf16x8, pu1); \
            _Pragma("unroll") for (int mt = 0; mt < NMT; ++mt) { \
                bf16x8 v0 = *(const bf16x8*)(vb + mt * 32 * VP + s2 * 16); bf16x8 v1 = *(const bf16x8*)(vb + mt * 32 * VP + 32 + s2 * 16); \
                o[mt] = MFMA(v0, pf0, o[mt]); o[mt] = MFMA(v1, pf1, o[mt]); } } }

    float alpha = 1.f;
    __syncthreads();
    M2_LOAD(a, 0);
    M2_LOAD(b, 1);
    {
        M2_STORE(a, 0);
        __syncthreads();
        const bf16_t* kb = Ks + l32 * KP + 8 * h;
        f32x16 s0, s1;
#pragma unroll
        for (int r = 0; r < 16; ++r) { s0[r] = 0.f; s1[r] = 0.f; }
#pragma unroll
        for (int ks = 0; ks < NKS; ++ks) { bf16x8 k0 = *(const bf16x8*)(kb + ks * 16); bf16x8 k1 = *(const bf16x8*)(kb + 32 * KP + ks * 16); s0 = MFMA(k0, qf[ks], s0); s1 = MFMA(k1, qf[ks], s1); }
        float mx = s0[0];
#pragma unroll
        for (int r = 1; r < 16; ++r) mx = fmaxf(mx, s0[r]);
#pragma unroll
        for (int r = 0; r < 16; ++r) mx = fmaxf(mx, s1[r]);
        m = fmaxf(mx, __shfl_xor(mx, 32));
        __syncthreads();
    }
    for (int kt = 0; kt < NKT; kt += 2) {
        M2_STORE(a, 0);
        __syncthreads();
        M2_LOAD(a, min(kt + 2, NKT - 1));
        M2_COMPUTE(0);
        M2_STORE(b, 1);
        __syncthreads();
        M2_LOAD(b, min(kt + 3, NKT - 1));
        M2_COMPUTE(1);
    }
#undef M2_LOAD
#undef M2_SK
#undef M2_SV
#undef M2_STORE
#undef M2_COMPUTE
    const float inv = 1.f / (lsum + __shfl_xor(lsum, 32));
#pragma unroll
    for (int mt = 0; mt < NMT; ++mt)
#pragma unroll
        for (int g = 0; g < 4; ++g) {
            float v0 = o[mt][4 * g] * inv, v1 = o[mt][4 * g + 1] * inv, v2 = o[mt][4 * g + 2] * inv, v3 = o[mt][4 * g + 3] * inv;
            uint2 pk; pk.x = pack2(v0, v1); pk.y = pack2(v2, v3);
            float r0 = bflo(pk.x), r1 = bfhi(pk.x), r2 = bflo(pk.y), r3 = bfhi(pk.y);
            ssq += r0 * r0 + r1 * r1 + r2 * r2 + r3 * r3;
            *(uint2*)(Op + (size_t)q * LDO + mt * 32 + 8 * g + 4 * h) = pk;
        }
}

DI void mla_item(KP p, int item, char* smem) {
    const int b = item >> 6, qb = item & 63;
    const bf16_t* Q = (const bf16_t*)(p->ws + OFF_Q);
    const bf16_t* K = (const bf16_t*)(p->ws + OFF_K);
    const bf16_t* Vt = (const bf16_t*)(p->ws + OFF_VT);
    bf16_t* om = (bf16_t*)(p->ws + OFF_OMIX) + ((size_t)b * SEQ + qb * 128) * DM;
    float ssq = 0.f;
    for (int hd = 0; hd < 8; ++hd) {
        const size_t bh = (size_t)(b * 8 + hd);
        flash_mla2(Q + (bh * SEQ + qb * 128) * 96, K + bh * SEQ * 96, Vt + bh * 64 * SEQ, om + hd * 64, smem, ssq);
    }
    ssq += __shfl_xor(ssq, 32);
    const float sc = rsqrtf(ssq * (1.f / 512.f) + EPS);
    const int lane = tid() & 63, w = tid() >> 6, q = w * 32 + (lane & 31), h = lane >> 5;
    for (int i = 0; i < 64; ++i) {
        uint2* ptr = (uint2*)(om + (size_t)q * DM + (i >> 3) * 64 + ((i >> 2) & 1) * 32 + (i & 3) * 8 + 4 * h);
        uint2 v = *ptr;
        v.x = pack2(bflo(v.x) * sc, bfhi(v.x) * sc);
        v.y = pack2(bflo(v.y) * sc, bfhi(v.y) * sc);
        *ptr = v;
    }
}

DI void memattn_item(KP p, int l, int item, char* smem) {
    const int head = item & 3, qt = (item >> 2) & 127, b = item >> 9;
    const bf16_t* qm = (const bf16_t*)(p->ws + OFF_QM) + ((size_t)b * SEQ + qt * 64) * DM + head * 256;
    const bf16_t* km = (const bf16_t*)(p->ws + OFF_KMEM) + ((size_t)((l * NBATCH + b) * 4 + head)) * 256 * 256;
    const bf16_t* vm = (const bf16_t*)(p->ws + OFF_VMEM) + ((size_t)((l * NBATCH + b) * 4 + head)) * 256 * 256;
    bf16_t* om = (bf16_t*)(p->ws + OFF_OMEM) + ((size_t)b * SEQ + qt * 64) * DM + head * 256;
    float dummy = 0.f;
    flash_item<256, 256, 1, true, 2, DM, 256, 256, DM>(qm, km, vm, 4, om, smem, dummy);
}

DI void gmlp_item(KP p, int l, int ci, char* smem) {
    constexpr int AP = 136;
    bf16_t* As = (bf16_t*)smem;
    bf16_t* Bs = As + 128 * AP;
    float* st = (float*)(Bs + 64 * AP);
    const int t = tid(), lane = t & 63, w = __builtin_amdgcn_readfirstlane(t >> 6), l32 = lane & 31, h = lane >> 5;
    const int tok0 = ci * 128;
    const bf16_t* vbuf = (const bf16_t*)(p->ws + OFF_V) + (size_t)tok0 * 512;
    const bf16_t* ubuf = (const bf16_t*)(p->ws + OFF_U) + (size_t)(tok0 + w * 32) * 512;
    bf16_t* om = (bf16_t*)(p->ws + OFF_OMIX) + (size_t)(tok0 + w * 32) * DM + 512;
    const bf16_t* wsg = (const bf16_t*)(p->ws + OFF_WSG) + (size_t)l * 8 * 128 * 128;
    const float* lng = p->sg_ln_g + l * 512; const float* lnb = p->sg_ln_b + l * 512;
    const float* bs = p->sg_b_s + l * 8 * 128 + w * 32;
    __syncthreads();
    {
        const int row = t >> 1, half = t & 1;
        const uint4* src = (const uint4*)(vbuf + (size_t)row * 512 + half * 256);
        float s = 0.f, s2 = 0.f;
#pragma unroll 4
        for (int i = 0; i < 32; ++i) {
            uint4 qv = src[i];
            float a0 = bflo(qv.x), a1 = bfhi(qv.x), a2 = bflo(qv.y), a3 = bfhi(qv.y), a4 = bflo(qv.z), a5 = bfhi(qv.z), a6 = bflo(qv.w), a7 = bfhi(qv.w);
            s += a0 + a1 + a2 + a3 + a4 + a5 + a6 + a7;
            s2 += a0 * a0 + a1 * a1 + a2 * a2 + a3 * a3 + a4 * a4 + a5 * a5 + a6 * a6 + a7 * a7;
        }
        s += __shfl_xor(s, 1); s2 += __shfl_xor(s2, 1);
        const float mean = s * (1.f / 512.f);
        const float var = fmaxf(s2 * (1.f / 512.f) - mean * mean, 0.f);
        if (half == 0) { st[2 * row] = mean; st[2 * row + 1] = rsqrtf(var + EPS); }
    }
    __syncthreads();
    float rq0 = 0.f, rq1 = 0.f, rq2 = 0.f, rq3 = 0.f;
    const bf16_t* ub0 = (const bf16_t*)(p->ws + OFF_U) + (size_t)tok0 * 512;
    bf16_t* om0 = (bf16_t*)(p->ws + OFF_OMIX) + (size_t)tok0 * DM + 512;
    const unsigned wtoff = (unsigned)((t >> 4) * 128 + (t & 15) * 8);
    const unsigned vtoff = (unsigned)((t >> 3) * 512 + (t & 7) * 8);
    const unsigned eoff_u = (unsigned)(4 * h * 512 + l32), eoff_o = (unsigned)(4 * h * DM + l32);
    for (int hd = 0; hd < 8; ++hd) {
        const bf16_t* wh = wsg + (size_t)hd * 128 * 128;
#pragma unroll
        for (int i = 0; i < 8; ++i)
            *(uint4*)(As + ((t >> 4) + 16 * i) * AP + (t & 15) * 8) = *(const uint4*)(wh + i * 16 * 128 + wtoff);
#pragma unroll
        for (int i = 0; i < 4; ++i) {
            const int j = (t >> 3) + 32 * i, c8 = t & 7;
            uint4 qv = *(const uint4*)(vbuf + (size_t)i * 32 * 512 + hd * 64 + vtoff);
            const float mean = st[2 * j], rstd = st[2 * j + 1];
            const int ch = hd * 64 + c8 * 8;
            const float4 g0 = *(const float4*)(lng + ch), g1 = *(const float4*)(lng + ch + 4);
            const float4 b0 = *(const float4*)(lnb + ch), b1 = *(const float4*)(lnb + ch + 4);
            bf16_t* bd = Bs + (c8 * 8) * AP + j;
            bd[0 * AP] = f2bf((bflo(qv.x) - mean) * rstd * g0.x + b0.x);
            bd[1 * AP] = f2bf((bfhi(qv.x) - mean) * rstd * g0.y + b0.y);
            bd[2 * AP] = f2bf((bflo(qv.y) - mean) * rstd * g0.z + b0.z);
            bd[3 * AP] = f2bf((bfhi(qv.y) - mean) * rstd * g0.w + b0.w);
            bd[4 * AP] = f2bf((bflo(qv.z) - mean) * rstd * g1.x + b1.x);
            bd[5 * AP] = f2bf((bfhi(qv.z) - mean) * rstd * g1.y + b1.y);
            bd[6 * AP] = f2bf((bflo(qv.w) - mean) * rstd * g1.z + b1.z);
            bd[7 * AP] = f2bf((bfhi(qv.w) - mean) * rstd * g1.w + b1.w);
        }
        __syncthreads();
        f32x16 acc[2];
#pragma unroll
        for (int r = 0; r < 16; ++r) { acc[0][r] = 0.f; acc[1][r] = 0.f; }
        const bf16_t* a_s = As + (w * 32 + l32) * AP + 8 * h;
        const bf16_t* b_s = Bs + l32 * AP + 8 * h;
#pragma unroll
        for (int ks = 0; ks < 8; ++ks) {
            bf16x8 a = *(const bf16x8*)(a_s + ks * 16);
            bf16x8 b0 = *(const bf16x8*)(b_s + ks * 16);
            bf16x8 b1 = *(const bf16x8*)(b_s + 32 * AP + ks * 16);
            acc[0] = MFMA(a, b0, acc[0]);
            acc[1] = MFMA(a, b1, acc[1]);
        }
        __syncthreads();
        float* stgf = (float*)As;
#pragma unroll
        for (int j2 = 0; j2 < 2; ++j2)
#pragma unroll
            for (int r = 0; r < 16; ++r) {
                const int rr = (r & 3) + 8 * (r >> 2);
                stgf[(w * 32 + rr + 4 * h) * 68 + j2 * 32 + l32] = acc[j2][r] + (bs + hd * 128 + rr)[4 * h];
            }
        __syncthreads();
#pragma unroll
        for (int i = 0; i < 4; ++i) {
            const int row = (t >> 3) + 32 * i, c8 = t & 7;
            const float4 lo = *(const float4*)(stgf + row * 68 + c8 * 8), hi = *(const float4*)(stgf + row * 68 + c8 * 8 + 4);
            const uint4 uv = ld_nt16(ub0 + (size_t)row * 512 + hd * 64 + c8 * 8);
            uint4 ov;
            ov.x = pack2(bflo(uv.x) * lo.x, bfhi(uv.x) * lo.y); ov.y = pack2(bflo(uv.y) * lo.z, bfhi(uv.y) * lo.w);
            ov.z = pack2(bflo(uv.z) * hi.x, bfhi(uv.z) * hi.y); ov.w = pack2(bflo(uv.w) * hi.z, bfhi(uv.w) * hi.w);
            *(uint4*)(om0 + (size_t)row * DM + hd * 64 + c8 * 8) = ov;
            const float q0 = bflo(ov.x), q1 = bfhi(ov.x), q2 = bflo(ov.y), q3 = bfhi(ov.y), q4 = bflo(ov.z), q5 = bfhi(ov.z), q6 = bflo(ov.w), q7 = bfhi(ov.w);
            const float sqp = q0 * q0 + q1 * q1 + q2 * q2 + q3 * q3 + q4 * q4 + q5 * q5 + q6 * q6 + q7 * q7;
            if (i == 0) rq0 += sqp; else if (i == 1) rq1 += sqp; else if (i == 2) rq2 += sqp; else rq3 += sqp;
        }
        __syncthreads();
    }
#define GM_FIN(RQ, i) { float s_ = RQ; s_ += __shfl_xor(s_, 1); s_ += __shfl_xor(s_, 2); s_ += __shfl_xor(s_, 4); const float sc_ = rsqrtf(s_ * (1.f / 512.f) + EPS); \
        const int row = (t >> 3) + 32 * (i), c8 = t & 7; \
        for (int hd = 0; hd < 8; ++hd) { uint4* ptr = (uint4*)(om0 + (size_t)row * DM + hd * 64 + c8 * 8); uint4 v = *ptr; \
            v.x = pack2(bflo(v.x) * sc_, bfhi(v.x) * sc_); v.y = pack2(bflo(v.y) * sc_, bfhi(v.y) * sc_); v.z = pack2(bflo(v.z) * sc_, bfhi(v.z) * sc_); v.w = pack2(bflo(v.w) * sc_, bfhi(v.w) * sc_); *ptr = v; } }
    GM_FIN(rq0, 0) GM_FIN(rq1, 1) GM_FIN(rq2, 2) GM_FIN(rq3, 3)
#undef GM_FIN
}

DI void ph_memkv(KP p, char* smem) {
    for_tiles(DEPTH * 16 * 16, [&](int t) __attribute__((always_inline)) {
        const int l = t >> 8, rt = (t >> 4) & 15, ct = t & 15;
        f32x16 acc[2][2];
        gemm_tile<1>((const bf16_t*)(p->ws + OFF_MEMB), DM, rt * 128, 0, NBATCH * NMEM, (const bf16_t*)(p->ws + OFF_WMKV) + ((size_t)l * 2048 + ct * 128) * DM, DM, DM, smem, acc);
        EpiMemKV e{(bf16_t*)(p->ws + OFF_KMEM) + (size_t)l * NBATCH * 4 * 256 * 256, (bf16_t*)(p->ws + OFF_VMEM) + (size_t)l * NBATCH * 4 * 256 * 256,
                   (const float*)(smem + RS_OFF), rt * 128, ct * 128};
        run_epi(acc, e);
    });
}
DI float* stage_tile(const f32x16 (&acc)[2][2], const float* rs, char* smem) {
    const int tt = tid(), lane = tt & 63, w = __builtin_amdgcn_readfirstlane(tt >> 6), wm = w >> 1, wn = w & 1, l32 = lane & 31, h = lane >> 5;
    float* stg = (float*)smem;
#pragma unroll
    for (int i = 0; i < 2; ++i)
#pragma unroll
        for (int j = 0; j < 2; ++j)
#pragma unroll
            for (int r = 0; r < 16; ++r) {
                const int row = wm * 64 + i * 32 + crow(r, h);
                stg[row * 132 + wn * 64 + j * 32 + l32] = rs ? acc[i][j][r] * rs[row] : acc[i][j][r];
            }
    __syncthreads();
    return stg;
}
DI uint4 pack8(const float4& a, const float4& b) { uint4 o; o.x = pack2(a.x, a.y); o.y = pack2(a.z, a.w); o.z = pack2(b.x, b.y); o.w = pack2(b.z, b.w); return o; }
DI float4 gelu4(const float4& a) { float4 o; o.x = gelu_tanh(a.x); o.y = gelu_tanh(a.y); o.z = gelu_tanh(a.z); o.w = gelu_tanh(a.w); return o; }
DI void rope8(float4& lo, float4& hi, const float4& plo, const float4& phi, const float* cs, const float* sn, int c) {
    const float4 c0 = *(const float4*)(cs + (c & 15)), c1 = *(const float4*)(cs + (c & 15) + 4);
    const float4 s0 = *(const float4*)(sn + (c & 15)), s1 = *(const float4*)(sn + (c & 15) + 4);
    const float sg = c < 16 ? -1.f : 1.f;
    lo.x = lo.x * c0.x + sg * plo.x * s0.x; lo.y = lo.y * c0.y + sg * plo.y * s0.y; lo.z = lo.z * c0.z + sg * plo.z * s0.z; lo.w = lo.w * c0.w + sg * plo.w * s0.w;
    hi.x = hi.x * c1.x + sg * phi.x * s1.x; hi.y = hi.y * c1.y + sg * phi.y * s1.y; hi.z = hi.z * c1.z + sg * phi.z * s1.z; hi.w = hi.w * c1.w + sg * phi.w * s1.w;
}

DI void ph_in(KP p, int l, const float* xin, char* smem) {
    for_tiles(512 * 12, [&](int t) __attribute__((always_inline)) {
        int rt, ct; tile_rc(t, 12, rt, ct);
        f32x16 acc[2][2];
        const float rsp = rs_load(p, rt * 128);
        gemm_tile<0, true>((const bf16_t*)(p->ws + OFF_XB), DM, rt * 128, 0, TOK, (const bf16_t*)(p->ws + OFF_WIN) + ((size_t)l * INCP + ct * 128) * DM, DM, DM, smem, acc);
        rs_finish(rsp, rt * 128, smem);
        const float* stg = stage_tile(acc, (const float*)(smem + RS_OFF), smem);
        const int tt = tid(), c8 = tt & 15, nb = ct * 128 + c8 * 8;
        if (nb < INC) {
#pragma unroll
            for (int i = 0; i < 8; ++i) {
                const int row = (tt >> 4) + 16 * i, tok = rt * 128 + row;
                float4 lo = *(const float4*)(stg + row * 132 + c8 * 8), hi = *(const float4*)(stg + row * 132 + c8 * 8 + 4);
                if (nb < 256) st_nt16((bf16_t*)(p->ws + OFF_HQ) + (size_t)tok * 256 + nb, pack8(lo, hi));
                else if (nb < 384) st_nt16((bf16_t*)(p->ws + OFF_HKV) + (size_t)tok * 128 + (nb - 256), pack8(lo, hi));
                else if (nb < 416) {
                    const int c = nb - 384, pc = c8 * 8 + (c < 16 ? 16 : -16);
                    const float4 plo = *(const float4*)(stg + row * 132 + pc), phi = *(const float4*)(stg + row * 132 + pc + 4);
                    rope8(lo, hi, plo, phi, (const float*)(p->ws + OFF_COS) + (size_t)tok * 16, (const float*)(p->ws + OFF_SIN) + (size_t)tok * 16, c);
                    const uint4 ov = pack8(lo, hi);
                    const int b = tok >> 13, sx = tok & 8191;
                    bf16_t* dst = (bf16_t*)(p->ws + OFF_K) + (((size_t)(b * 8)) * SEQ + sx) * 96 + 64 + c;
#pragma unroll
                    for (int hd = 0; hd < 8; ++hd) st_nt16(dst + (size_t)hd * SEQ * 96, ov);
                } else if (nb < 928) st_nt16((bf16_t*)(p->ws + OFF_U) + (size_t)tok * 512 + (nb - 416), pack8(gelu4(lo), gelu4(hi)));
                else st_nt16((bf16_t*)(p->ws + OFF_V) + (size_t)tok * 512 + (nb - 928), pack8(gelu4(lo), gelu4(hi)));
            }
        }
    });
}
DI void ph_qkv(KP p, int l, char* smem) {
    for_tiles(512 * 14, [&](int t) __attribute__((always_inline)) {
        int rt, ct; tile_rc(t, 14, rt, ct);
        f32x16 acc[2][2];
        if (ct < 6) {
            gemm_tile<1>((const bf16_t*)(p->ws + OFF_HQ), QL, rt * 128, 0, TOK, (const bf16_t*)(p->ws + OFF_WUQ) + ((size_t)l * 768 + ct * 128) * QL, QL, QL, smem, acc);
            const float* stg = stage_tile(acc, (const float*)(smem + RS_OFF), smem);
            const int tt = tid(), c8 = tt & 15, n8 = ct * 128 + c8 * 8, head = n8 / 96, w0 = n8 - head * 96;
            const float qs = 0.10206207261596575f * LOG2E;
#pragma unroll
            for (int i = 0; i < 8; ++i) {
                const int row = (tt >> 4) + 16 * i, tok = rt * 128 + row;
                float4 lo = *(const float4*)(stg + row * 132 + c8 * 8), hi = *(const float4*)(stg + row * 132 + c8 * 8 + 4);
                if (w0 >= 64) {
                    const int c = w0 - 64, pc = c8 * 8 + (c < 16 ? 16 : -16);
                    const float4 plo = *(const float4*)(stg + row * 132 + pc), phi = *(const float4*)(stg + row * 132 + pc + 4);
                    rope8(lo, hi, plo, phi, (const float*)(p->ws + OFF_COS) + (size_t)tok * 16, (const float*)(p->ws + OFF_SIN) + (size_t)tok * 16, c);
                }
                lo.x *= qs; lo.y *= qs; lo.z *= qs; lo.w *= qs; hi.x *= qs; hi.y *= qs; hi.z *= qs; hi.w *= qs;
                const int b = tok >> 13, sx = tok & 8191;
                st_nt16((bf16_t*)(p->ws + OFF_Q) + (((size_t)(b * 8 + head)) * SEQ + sx) * 96 + w0, pack8(lo, hi));
            }
        } else {
            const int c2 = ct - 6;
            gemm_tile<1>((const bf16_t*)(p->ws + OFF_HKV), KVL, rt * 128, 0, TOK, (const bf16_t*)(p->ws + OFF_WUKV) + ((size_t)l * 1024 + c2 * 128) * KVL, KVL, KVL, smem, acc);
            const float* stg = stage_tile(acc, (const float*)(smem + RS_OFF), smem);
            const int tt = tid(), tok0 = rt * 128, b = tok0 >> 13, s0 = tok0 & 8191;
            {
                const int c8 = tt & 7;
#pragma unroll
                for (int i = 0; i < 4; ++i) {
                    const int row = (tt >> 3) + 32 * i;
                    const float4 lo = *(const float4*)(stg + row * 132 + c8 * 8), hi = *(const float4*)(stg + row * 132 + c8 * 8 + 4);
                    st_nt16((bf16_t*)(p->ws + OFF_K) + (((size_t)(b * 8 + c2)) * SEQ + s0 + row) * 96 + c8 * 8, pack8(lo, hi));
                }
            }
            {
                const int tc = tt & 15;
#pragma unroll
                for (int i = 0; i < 4; ++i) {
                    const int d = (tt >> 4) + 16 * i;
                    const float* sp = stg + (tc * 8) * 132 + 64 + d;
                    uint4 ov;
                    ov.x = pack2(sp[0], sp[132]); ov.y = pack2(sp[2 * 132], sp[3 * 132]); ov.z = pack2(sp[4 * 132], sp[5 * 132]); ov.w = pack2(sp[6 * 132], sp[7 * 132]);
                    st_nt16((bf16_t*)(p->ws + OFF_VT) + (((size_t)(b * 8 + c2)) * 64 + d) * SEQ + s0 + tc * 8, ov);
                }
            }
        }
    });
}
DI void ph_mix(KP p, int l, char* smem) {
    for_tiles(512, [&](int t) __attribute__((always_inline)) { mla_item(p, t, smem); });
    for_tiles(512, [&](int t) __attribute__((always_inline)) { gmlp_item(p, l, t, smem); });
}
DI void ph_res(KP p, const bf16_t* A, int K, const bf16_t* Wt, const float* xin, char* smem, bool dry) {
    for_tiles(512 * 8, [&](int t) __attribute__((always_inline)) {
        int rt, ct; tile_rc(t, 8, rt, ct);
        f32x16 acc[2][2];
        gemm_tile<0>(A, K, rt * 128, 0, TOK, Wt + (size_t)ct * 128 * K, K, K, smem, acc);
        if (dry) return;
        const int tt = tid(), lane = tt & 63, w = __builtin_amdgcn_readfirstlane(tt >> 6), wm = w >> 1, wn = w & 1, l32 = lane & 31, h = lane >> 5;
        float* stg = (float*)smem;
#pragma unroll
        for (int i = 0; i < 2; ++i)
#pragma unroll
            for (int j = 0; j < 2; ++j)
#pragma unroll
                for (int r = 0; r < 16; ++r) stg[(wm * 64 + i * 32 + crow(r, h)) * 132 + wn * 64 + j * 32 + l32] = acc[i][j][r];
        __syncthreads();
        bf16_t* xb = (bf16_t*)(p->ws + OFF_XB) + (size_t)(rt * 128) * DM + ct * 128;
        float* part = (float*)(p->ws + OFF_RSC) + (size_t)(rt * 128) * 16 + ct * 2;
        const int c8 = tt & 15;
#pragma unroll
        for (int i = 0; i < 8; ++i) {
            const int row = (tt >> 4) + 16 * i;
            const float4 lo = *(const float4*)(stg + row * 132 + c8 * 8), hi = *(const float4*)(stg + row * 132 + c8 * 8 + 4);
            uint4* gp = (uint4*)(xb + (size_t)row * DM + c8 * 8);
            const uint4 xv = ld_nt16(gp);
            uint4 nv;
            nv.x = pack2h(hlo(xv.x) + lo.x, hhi(xv.x) + lo.y); nv.y = pack2h(hlo(xv.y) + lo.z, hhi(xv.y) + lo.w);
            nv.z = pack2h(hlo(xv.z) + hi.x, hhi(xv.z) + hi.y); nv.w = pack2h(hlo(xv.w) + hi.z, hhi(xv.w) + hi.w);
            st_nt16(gp, nv);
            float s0 = hlo(nv.x), s1 = hhi(nv.x), s2 = hlo(nv.y), s3 = hhi(nv.y), s4 = hlo(nv.z), s5 = hhi(nv.z), s6 = hlo(nv.w), s7 = hhi(nv.w);
            float sq = s0 * s0 + s1 * s1 + s2 * s2 + s3 * s3 + s4 * s4 + s5 * s5 + s6 * s6 + s7 * s7;
            sq += __shfl_xor(sq, 1); sq += __shfl_xor(sq, 2); sq += __shfl_xor(sq, 4); sq += __shfl_xor(sq, 8);
            if (c8 == 0) { float2 pv; pv.x = sq; pv.y = 0.f; *(float2*)(part + (size_t)row * 16) = pv; }
        }
    });
}
DI void ph_qm(KP p, int l, char* smem) {
    for_tiles(512 * 8, [&](int t) __attribute__((always_inline)) {
        int rt, ct; tile_rc(t, 8, rt, ct);
        f32x16 acc[2][2];
        const float rsp = rs_load(p, rt * 128);
        gemm_tile<0, true>((const bf16_t*)(p->ws + OFF_XB), DM, rt * 128, 0, TOK, (const bf16_t*)(p->ws + OFF_WMQ) + ((size_t)l * DM + ct * 128) * DM, DM, DM, smem, acc);
        rs_finish(rsp, rt * 128, smem);
        const float* stg = stage_tile(acc, (const float*)(smem + RS_OFF), smem);
        const int tt = tid(), c8 = tt & 15;
        const float qs = 0.0625f * LOG2E;
#pragma unroll
        for (int i = 0; i < 8; ++i) {
            const int row = (tt >> 4) + 16 * i;
            float4 lo = *(const float4*)(stg + row * 132 + c8 * 8), hi = *(const float4*)(stg + row * 132 + c8 * 8 + 4);
            lo.x *= qs; lo.y *= qs; lo.z *= qs; lo.w *= qs; hi.x *= qs; hi.y *= qs; hi.z *= qs; hi.w *= qs;
            st_nt16((bf16_t*)(p->ws + OFF_QM) + (size_t)(rt * 128 + row) * DM + ct * 128 + c8 * 8, pack8(lo, hi));
        }
    });
}
DI void ph_memattn(KP p, int l, char* smem) {
    for_tiles(NBATCH * 128 * 4, [&](int t) __attribute__((always_inline)) { memattn_item(p, l, t, smem); });
}
typedef float f32p __attribute__((ext_vector_type(2)));
DI void ph_up(KP p, int l, char* smem) {
    for_tiles(NBATCH * 66 * 44, [&](int t) __attribute__((always_inline)) {
        int rt, ct; tile_rc(t, 44, rt, ct);
        const int b = rt / 66, rl = rt - b * 66, s0 = rl * 126;
        const float* cw = p->conv_w + (size_t)l * 3 * 2 * DFF; const float* cb = p->conv_b + (size_t)l * 2 * DFF;
        const int cp2 = (tid() & 31) * 2, c = ct * 64 + cp2, c2 = DFF + c;
        const f32p g0 = *(const f32p*)(cw + c), g1 = *(const f32p*)(cw + 2 * DFF + c), g2 = *(const f32p*)(cw + 4 * DFF + c), gb = *(const f32p*)(cb + c);
        const f32p u0 = *(const f32p*)(cw + c2), u1 = *(const f32p*)(cw + 2 * DFF + c2), u2 = *(const f32p*)(cw + 4 * DFF + c2), ub = *(const f32p*)(cb + c2);
        f32x16 acc[2][2];
        const float rsp = rs_load(p, b * SEQ + s0 - 1);
        if (rl == 0 || rl == 65) gemm_tile<0, true, true>((const bf16_t*)(p->ws + OFF_XB), DM, b * SEQ + s0 - 1, b * SEQ, (b + 1) * SEQ, (const bf16_t*)(p->ws + OFF_WUP) + ((size_t)l * 2 * DFF + ct * 128) * DM, DM, DM, smem, acc);
        else gemm_tile<0, true, false>((const bf16_t*)(p->ws + OFF_XB), DM, b * SEQ + s0 - 1, b * SEQ, (b + 1) * SEQ, (const bf16_t*)(p->ws + OFF_WUP) + ((size_t)l * 2 * DFF + ct * 128) * DM, DM, DM, smem, acc);
        rs_finish(rsp, b * SEQ + s0 - 1, smem);
        const float* rs = (const float*)(smem + RS_OFF);
        float* stg = (float*)smem;
        const int tt = tid(), lane = tt & 63, w = __builtin_amdgcn_readfirstlane(tt >> 6), wm = w >> 1, wn = w & 1, l32 = lane & 31, h = lane >> 5;
#pragma unroll
        for (int i = 0; i < 2; ++i)
#pragma unroll
            for (int j = 0; j < 2; ++j)
#pragma unroll
                for (int r = 0; r < 16; ++r) {
                    const int row = wm * 64 + i * 32 + crow(r, h), col = wn * 64 + j * 32 + l32;
                    stg[row * 130 + col] = acc[i][j][r] * rs[row];
                }
        __syncthreads();
        bf16_t* act = (bf16_t*)(p->ws + OFF_ACT);
        const int rmax = min(126, SEQ - s0);
        const int rbeg = w * 32 + h * 16, rend = min(rbeg + 16, rmax);
        if (rbeg < rend) {
            const float* sg = stg + rbeg * 130 + cp2;
            unsigned* arow = (unsigned*)(act + ((size_t)b * SEQ + s0 + rbeg) * DFF + c);
            f32p ga = *(const f32p*)sg, gm = *(const f32p*)(sg + 130), ua = *(const f32p*)(sg + 64), um = *(const f32p*)(sg + 130 + 64);
#pragma unroll 4
            for (int r = rbeg; r < rend; ++r) {
                sg += 130;
                const f32p gn = *(const f32p*)(sg + 130), un = *(const f32p*)(sg + 130 + 64);
                const f32p g = g0 * ga + g1 * gm + g2 * gn + gb;
                const f32p up = u0 * ua + u1 * um + u2 * un + ub;
                const f32p e = g * (-LOG2E);
                f32p den; den.x = 1.f + ex2(e.x); den.y = 1.f + ex2(e.y);
                f32p sig; sig.x = __builtin_amdgcn_rcpf(den.x); sig.y = __builtin_amdgcn_rcpf(den.y);
                const f32p o = g * sig * up;
                st_nt4(arow, pack2(o.x, o.y));
                arow += DFF / 2;
                ga = gm; gm = gn; ua = um; um = un;
            }
        }
    });
}
DI void ph_final(KP p) {
    const int lane = tid() & 63, wv = blockIdx.x * 4 + (tid() >> 6), nw = gridDim.x * 4;
    const bf16_t* xbp = (const bf16_t*)(p->ws + OFF_XB);
    const float* rsc = (const float*)(p->ws + OFF_RSC);
    for (int row = wv; row < TOK; row += nw) {
        const uint4* xr = (const uint4*)(xbp + (size_t)row * DM);
        float4* orow = (float4*)(p->out + (size_t)row * DM);
        float ps = lane < 16 ? rsc[(size_t)row * 16 + lane] : 0.f;
        ps += __shfl_xor(ps, 1); ps += __shfl_xor(ps, 2); ps += __shfl_xor(ps, 4); ps += __shfl_xor(ps, 8);
        const float sc = rsqrtf(__shfl(ps, 0) * (1.f / DM) + EPS);
#pragma unroll
        for (int i = 0; i < 2; ++i) {
            const uint4 v = ld_nt16(xr + lane + 64 * i);
            const float4 g0 = ((const float4*)p->final_norm_g)[2 * (lane + 64 * i)], g1 = ((const float4*)p->final_norm_g)[2 * (lane + 64 * i) + 1];
            float4 o0, o1;
            o0.x = hlo(v.x) * sc * g0.x; o0.y = hhi(v.x) * sc * g0.y; o0.z = hlo(v.y) * sc * g0.z; o0.w = hhi(v.y) * sc * g0.w;
            o1.x = hlo(v.z) * sc * g1.x; o1.y = hhi(v.z) * sc * g1.y; o1.z = hlo(v.w) * sc * g1.z; o1.w = hhi(v.w) * sc * g1.w;
            st_nt16f(orow + 2 * (lane + 64 * i), o0); st_nt16f(orow + 2 * (lane + 64 * i) + 1, o1);
        }
    }
}

#define XB_TMO      128
#define XB_XCNT(j)  (256  + 64 * (j))
#define XB_XSUB(j)  (1280 + 64 * (j))
#define XB_XGEN(j)  (2304 + 64 * (j))
#define XB_TOP      3328
#define XB_TOPGEN   3392
#define XCD_BAR_WORDS 3456
#define XB_SPIN_CAP (1u << 22)
#define LAS __attribute__((address_space(3)))
static_assert(XCD_BAR_WORDS * 4 <= BAR_BYTES, "barrier words");
DI unsigned xb_ld(unsigned* p) { return __hip_atomic_load(p, __ATOMIC_RELAXED, __HIP_MEMORY_SCOPE_AGENT); }
DI unsigned xb_add(unsigned* p, unsigned v) { return __hip_atomic_fetch_add(p, v, __ATOMIC_RELAXED, __HIP_MEMORY_SCOPE_AGENT); }
DI unsigned xb_xcc_id() { return (unsigned)__builtin_amdgcn_s_getreg((3 << 11) | 20) & 0xFu; }
#define XB_SPIN(cond, bar) do { unsigned _sp = 0; while (cond) { __builtin_amdgcn_s_sleep(1); \
    if ((++_sp & 255u) == 0u) { if (xb_ld(&(bar)[XB_TMO])) break; if (_sp > XB_SPIN_CAP) { atomicAdd(&(bar)[XB_TMO], 1u); break; } } } } while (0)
struct XcdBarrier { unsigned* bar; unsigned x; volatile LAS unsigned* st; };
DI XcdBarrier xcd_barrier_post(unsigned* bar, volatile LAS unsigned* st) {
    XcdBarrier b; b.bar = bar; b.x = xb_xcc_id(); b.st = st;
    if (threadIdx.x == 0) (void)xb_add(&bar[XB_XCNT(b.x)], 1u);
    return b;
}
DI void xcd_barrier_complete(unsigned* bar, unsigned x, unsigned& nloc, unsigned& nx) {
    const unsigned G = gridDim.x * gridDim.y * gridDim.z;
    unsigned sum, cnt, mine, sp = 0u;
    for (;;) {
        sum = 0u; cnt = 0u; mine = 0u;
#pragma unroll
        for (unsigned j = 0; j < 16; ++j) { const unsigned c = xb_ld(&bar[XB_XCNT(j)]); sum += c; cnt += (c > 0u) ? 1u : 0u; mine = (j == x) ? c : mine; }
        if (sum == G) break;
        __builtin_amdgcn_s_sleep(1);
        if ((++sp & 255u) == 0u) { if (xb_ld(&bar[XB_TMO])) break; if (sp > XB_SPIN_CAP) { atomicAdd(&bar[XB_TMO], 1u); break; } }
    }
    nloc = mine > 0u ? mine : 1u; nx = cnt > 0u ? cnt : 1u;
}
DI void xcd_barrier(const XcdBarrier& b) {
    asm volatile("s_waitcnt vmcnt(0)" ::: "memory");
    __syncthreads();
    if (threadIdx.x == 0) {
        unsigned* bar = b.bar;
        __builtin_amdgcn_s_waitcnt(0);
        unsigned nloc = b.st[0], nx = b.st[1];
        if (nloc == 0u) { xcd_barrier_complete(bar, b.x, nloc, nx); b.st[0] = nloc; b.st[1] = nx; }
        const unsigned old = xb_add(&bar[XB_XSUB(b.x)], 1u);
        const unsigned gen = old / nloc;
        if (old + 1u == (gen + 1u) * nloc) {
            __builtin_amdgcn_fence(__ATOMIC_RELEASE, "agent");
            asm volatile("s_waitcnt vmcnt(0)" ::: "memory");
            const unsigned og = xb_add(&bar[XB_TOP], 1u);
            const unsigned tg = og / nx;
            if (og + 1u == (tg + 1u) * nx) xb_add(&bar[XB_TOPGEN], 1u);
            else XB_SPIN(xb_ld(&bar[XB_TOPGEN]) == tg, bar);
            __builtin_amdgcn_fence(__ATOMIC_ACQUIRE, "agent");
            xb_add(&bar[XB_XGEN(b.x)], 1u);
            asm volatile("s_waitcnt vmcnt(0)" ::: "memory");
        } else {
            XB_SPIN(xb_ld(&bar[XB_XGEN(b.x)]) == gen, bar);
            __builtin_amdgcn_fence(__ATOMIC_ACQUIRE, "agent");
            asm volatile("s_waitcnt vmcnt(0)" ::: "memory");
        }
    }
    __syncthreads();
}

constexpr int NPHASE = 2 + 9 * DEPTH + 1;
__global__ void __launch_bounds__(256, 2) mk(Params p_unused, int lo, int hi) {
    extern __shared__ __attribute__((aligned(16))) char smem[];
    cg::grid_group grid = cg::this_grid();
    volatile LAS unsigned* xst = (volatile LAS unsigned*)(smem + RS_OFF + 512);
    if (threadIdx.x == 0) { xst[0] = 0u; xst[1] = 0u; xst[2] = 0u; xst[3] = 0u; }
    __syncthreads();
    const XcdBarrier xbar = xcd_barrier_post((unsigned*)(kparams()->ws + OFF_BAR), xst);
    for (int ph = lo; ph < hi; ++ph) {
        KP p = kparams();
        if (ph == 0) phase_setup(p, smem);
        else if (ph == 1) ph_memkv(p, smem);
        else if (ph == NPHASE - 1) ph_final(p);
        else {
            const int l = (ph - 2) / 9, s = (ph - 2) % 9;
            const float* xin = l == 0 ? p->x : p->out;
            const int reps = ((REPMASK >> s) & 1) ? 2 : 1;
            for (int rep = 0; rep < reps; ++rep) {
                const bool dry = rep + 1 < reps;
                switch (s) {
                    case 0: ph_in(p, l, xin, smem); break;
                    case 1: ph_qkv(p, l, smem); break;
                    case 2: ph_mix(p, l, smem); break;
                    case 3: ph_res(p, (const bf16_t*)(p->ws + OFF_OMIX), DM, (const bf16_t*)(p->ws + OFF_WOUT) + (size_t)l * DM * DM, xin, smem, dry); break;
                    case 4: ph_qm(p, l, smem); break;
                    case 5: ph_memattn(p, l, smem); break;
                    case 6: ph_res(p, (const bf16_t*)(p->ws + OFF_OMEM), DM, (const bf16_t*)(p->ws + OFF_WMO) + (size_t)l * DM * DM, p->out, smem, dry); break;
                    case 7: ph_up(p, l, smem); break;
                    case 8: ph_res(p, (const bf16_t*)(p->ws + OFF_ACT), DFF, (const bf16_t*)(p->ws + OFF_WDN) + (size_t)l * DM * DFF, p->out, smem, dry); break;
                }
                if (dry) xcd_barrier(xbar);
            }
        }
        if (ph + 1 < hi) { if (ph == 0) grid.sync(); else if (ph != 1) xcd_barrier(xbar); }
    }
}

extern "C" void kernel_launch(void* const* d_in, const int* in_sizes, int n_in, void* d_out, int out_size, void* d_ws, size_t ws_size, hipStream_t stream) {
    static int grid_blocks = 0;
    if (!grid_blocks) {
        int dev = 0, cus = 0, per_cu = 0;
        hipGetDevice(&dev);
        hipDeviceGetAttribute(&cus, hipDeviceAttributeMultiprocessorCount, dev);
        hipFuncSetAttribute((const void*)mk, hipFuncAttributeMaxDynamicSharedMemorySize, LDS_BYTES);
        hipOccupancyMaxActiveBlocksPerMultiprocessor(&per_cu, (const void*)mk, 256, LDS_BYTES);
        if (per_cu < 1) per_cu = 1;
        if (per_cu > 2) per_cu = 2;
        grid_blocks = cus * per_cu;
        if (ws_size < OFF_END) fprintf(stderr, "kernel_launch: workspace too small: %zu < %zu\n", ws_size, (size_t)OFF_END);
    }
    Params p{};
    const float** fp = (const float**)&p;
    p.x = (const float*)d_in[0]; p.mem = (const float*)d_in[1]; p.pos = (const int*)d_in[2];
    p.norm_mix_g = (const float*)d_in[3]; p.w_in = (const float*)d_in[4]; p.q_norm_g = (const float*)d_in[5]; p.w_uq = (const float*)d_in[6];
    p.kv_norm_g = (const float*)d_in[7]; p.w_ukv = (const float*)d_in[8]; p.sg_ln_g = (const float*)d_in[9]; p.sg_ln_b = (const float*)d_in[10];
    p.sg_w_s = (const float*)d_in[11]; p.sg_b_s = (const float*)d_in[12]; p.out_norm_mla_g = (const float*)d_in[13]; p.out_norm_sg_g = (const float*)d_in[14];
    p.w_out = (const float*)d_in[15]; p.norm_mem_g = (const float*)d_in[16]; p.mem_norm_g = (const float*)d_in[17]; p.w_mq = (const float*)d_in[18];
    p.w_mkv = (const float*)d_in[19]; p.w_mo = (const float*)d_in[20]; p.norm_ffn_g = (const float*)d_in[21]; p.w_up = (const float*)d_in[22];
    p.conv_w = (const float*)d_in[23]; p.conv_b = (const float*)d_in[24]; p.w_down = (const float*)d_in[25]; p.final_norm_g = (const float*)d_in[26];
    p.out = (float*)d_out; p.ws = (char*)d_ws;
    (void)fp;
    (void)hipMemsetAsync((char*)d_ws + OFF_BAR, 0, BAR_BYTES, stream);
#if COOP
    int lo = 0, hi = NPHASE;
    void* args[] = {&p, &lo, &hi};
    hipError_t e = hipLaunchCooperativeKernel((const void*)mk, dim3(grid_blocks), dim3(256), args, LDS_BYTES, stream);
    if (e != hipSuccess) fprintf(stderr, "cooperative launch failed: %s (grid %d)\n", hipGetErrorString(e), grid_blocks);
#else
    for (int ph = 0; ph < NPHASE; ++ph) hipLaunchKernelGGL(mk, dim3(grid_blocks), dim3(256), LDS_BYTES, stream, p, ph, ph + 1);
#endif
}
```

```cpp
#include <hip/hip_runtime.h>
#include <hip/hip_cooperative_groups.h>
#include <stdint.h>
#include <stdio.h>
namespace cg = cooperative_groups;

#ifndef PHMASK
#define PHMASK 0xFFFF
#endif
#ifndef REPMASK
#define REPMASK 0
#endif
#ifndef COOP
#define COOP 1
#endif

typedef unsigned short bf16_t;
typedef __attribute__((ext_vector_type(8))) short bf16x8;
typedef __attribute__((ext_vector_type(16))) float f32x16;
typedef __attribute__((ext_vector_type(4))) unsigned u32x4;
#define DI __device__ __forceinline__
#define MFMA(a, b, c) __builtin_amdgcn_mfma_f32_32x32x16_bf16((a), (b), (c), 0, 0, 0)

constexpr int NBATCH = 8, SEQ = 8192, TOK = NBATCH * SEQ, DM = 1024, DEPTH = 4;
constexpr int NMEM = 256, QL = 256, KVL = 128, ROPE = 32, NOPE = 64, VD = 64, NH = 8;
constexpr int SGW = 512, INC = 1440, INCP = 1536, DFF = 2816;
constexpr float EPS = 1e-6f;
constexpr float LOG2E = 1.4426950408889634f;

constexpr size_t al256(size_t x) { return (x + 255) & ~(size_t)255; }
constexpr size_t SZ_WIN = (size_t)DEPTH * INCP * DM * 2;
constexpr size_t SZ_WUQ = (size_t)DEPTH * 768 * QL * 2;
constexpr size_t SZ_WUKV = (size_t)DEPTH * 1024 * KVL * 2;
constexpr size_t SZ_WS = (size_t)DEPTH * 8 * 128 * 128 * 2;
constexpr size_t SZ_W1K = (size_t)DEPTH * DM * DM * 2;
constexpr size_t SZ_WMKV = (size_t)DEPTH * 2048 * DM * 2;
constexpr size_t SZ_WUP = (size_t)DEPTH * 2 * DFF * DM * 2;
constexpr size_t SZ_WDN = (size_t)DEPTH * DM * DFF * 2;
constexpr size_t OFF_WIN = 0;
constexpr size_t OFF_WUQ = OFF_WIN + SZ_WIN;
constexpr size_t OFF_WUKV = OFF_WUQ + SZ_WUQ;
constexpr size_t OFF_WSG = OFF_WUKV + SZ_WUKV;
constexpr size_t OFF_WOUT = OFF_WSG + SZ_WS;
constexpr size_t OFF_WMQ = OFF_WOUT + SZ_W1K;
constexpr size_t OFF_WMKV = OFF_WMQ + SZ_W1K;
constexpr size_t OFF_WMO = OFF_WMKV + SZ_WMKV;
constexpr size_t OFF_WUP = OFF_WMO + SZ_W1K;
constexpr size_t OFF_WDN = OFF_WUP + SZ_WUP;
constexpr size_t OFF_COS = OFF_WDN + SZ_WDN;
constexpr size_t OFF_SIN = OFF_COS + (size_t)TOK * 16 * 4;
constexpr size_t OFF_KMEM = OFF_SIN + (size_t)TOK * 16 * 4;
constexpr size_t SZ_KMEM = (size_t)DEPTH * NBATCH * 4 * 256 * 256 * 2;
constexpr size_t OFF_VMEM = OFF_KMEM + SZ_KMEM;
constexpr size_t OFF_ACT0 = OFF_VMEM + SZ_KMEM;
constexpr size_t OFF_Q = OFF_ACT0;
constexpr size_t OFF_K = OFF_Q + (size_t)TOK * 8 * 96 * 2;
constexpr size_t OFF_VT = OFF_K + (size_t)TOK * 8 * 96 * 2;
constexpr size_t OFF_U = OFF_VT + (size_t)TOK * 512 * 2;
constexpr size_t OFF_V = OFF_U + (size_t)TOK * 512 * 2;
constexpr size_t OFF_OMIX = OFF_V + (size_t)TOK * 512 * 2;
constexpr size_t OFF_HQ = OFF_OMIX + (size_t)TOK * 1024 * 2;
constexpr size_t OFF_HKV = OFF_HQ + (size_t)TOK * 256 * 2;
constexpr size_t OFF_XB = OFF_HKV + (size_t)TOK * 128 * 2;
constexpr size_t OFF_MEMB = OFF_XB + (size_t)TOK * DM * 2;
constexpr size_t OFF_RSC = OFF_MEMB + (size_t)NBATCH * NMEM * DM * 2;
constexpr size_t OFF_BAR = OFF_RSC + (size_t)TOK * 16 * 4;
constexpr size_t BAR_BYTES = 16384;
constexpr size_t OFF_END = OFF_BAR + BAR_BYTES;
constexpr size_t OFF_QM = OFF_Q;
constexpr size_t OFF_OMEM = OFF_OMIX;
constexpr size_t OFF_ACT = OFF_ACT0;
static_assert(OFF_ACT + (size_t)TOK * DFF * 2 <= OFF_XB, "act alias");
static_assert(OFF_END <= (size_t)1000 * 1024 * 1024, "ws budget");

struct Params {
    const float *x, *mem; const int* pos;
    const float *norm_mix_g, *w_in, *q_norm_g, *w_uq, *kv_norm_g, *w_ukv, *sg_ln_g, *sg_ln_b, *sg_w_s, *sg_b_s,
        *out_norm_mla_g, *out_norm_sg_g, *w_out, *norm_mem_g, *mem_norm_g, *w_mq, *w_mkv, *w_mo, *norm_ffn_g, *w_up,
        *conv_w, *conv_b, *w_down, *final_norm_g;
    float* out; char* ws;
};

typedef const __attribute__((address_space(4))) Params* KP;
DI KP kparams() { KP k = (KP)__builtin_amdgcn_kernarg_segment_ptr(); asm volatile("" : "+s"(k)); return k; }
typedef __bf16 bf16v2_t __attribute__((ext_vector_type(2)));
typedef float f32v2_t __attribute__((ext_vector_type(2)));
DI unsigned pack2(float a, float b) { f32v2_t v = {a, b}; return __builtin_bit_cast(unsigned, __builtin_convertvector(v, bf16v2_t)); }
DI bf16_t f2bf(float f) { return (bf16_t)(pack2(f, f) & 0xffffu); }
typedef _Float16 f16x8 __attribute__((ext_vector_type(8)));
typedef _Float16 f16v2_t __attribute__((ext_vector_type(2)));
DI unsigned pack2h(float a, float b) { f16v2_t v = {(_Float16)a, (_Float16)b}; return __builtin_bit_cast(unsigned, v); }
DI bf16_t f2h(float f) { return __builtin_bit_cast(unsigned short, (_Float16)f); }
DI float h2f(bf16_t u) { return (float)__builtin_bit_cast(_Float16, u); }
DI float hlo(unsigned u) { return h2f((bf16_t)(u & 0xffffu)); }
DI float hhi(unsigned u) { return h2f((bf16_t)(u >> 16)); }
#define MFMA_H(a, b, c) __builtin_amdgcn_mfma_f32_32x32x16_f16(__builtin_bit_cast(f16x8, (a)), __builtin_bit_cast(f16x8, (b)), (c), 0, 0, 0)
DI float bf2f(bf16_t b) { return __uint_as_float((unsigned)b << 16); }
DI float bflo(unsigned u) { return __uint_as_float(u << 16); }
DI float bfhi(unsigned u) { return __uint_as_float(u & 0xffff0000u); }
DI float ex2(float x) { return __builtin_amdgcn_exp2f(x); }
DI float gelu_tanh(float x) { float y = 0.7978845608028654f * (x + 0.044715f * x * x * x); return x * __builtin_amdgcn_rcpf(1.f + ex2(-2.f * LOG2E * y)); }
DI float silu(float x) { return x * __builtin_amdgcn_rcpf(1.f + ex2(-LOG2E * x)); }
DI int tid() { int t = threadIdx.x; asm volatile("" : "+v"(t)); return t; }
DI int crow(int r, int h) { return (r & 3) + 8 * (r >> 2) + 4 * h; }
DI void st_nt16(void* p, const uint4& v) { u32x4 t = {v.x, v.y, v.z, v.w}; __builtin_nontemporal_store(t, (u32x4*)p); }
DI void st_nt4(unsigned* p, unsigned v) { __builtin_nontemporal_store(v, p); }
typedef __attribute__((ext_vector_type(4))) float f32v4_t;
DI void st_nt16f(float4* p, const float4& v) { f32v4_t t = {v.x, v.y, v.z, v.w}; __builtin_nontemporal_store(t, (f32v4_t*)p); }
DI float4 ld_nt16f(const float4* p) { const f32v4_t t = __builtin_nontemporal_load((const f32v4_t*)p); return make_float4(t[0], t[1], t[2], t[3]); }
DI uint4 ld_nt16(const void* p) { const u32x4 t = __builtin_nontemporal_load((const u32x4*)p); return make_uint4(t[0], t[1], t[2], t[3]); }
DI int swap23(int r) { return (r & ~12) | ((r & 4) << 1) | ((r & 8) >> 1); }

template <class F> DI void for_tiles(int ntiles, F f) {
    const int G = gridDim.x, b = blockIdx.x;
    const bool sw = (G & 7) == 0;
    const int tpx = (ntiles + 7) >> 3;
    const int start = sw ? (b >> 3) : b, step = sw ? (G >> 3) : G, lim = sw ? tpx : ntiles, base = sw ? (b & 7) * tpx : 0;
    for (int i = start; i < lim; i += step) {
        const int t = base + i;
        if (t < ntiles) f(t);
    }
}

constexpr int LK = 72;
constexpr int GEMM_LDS = 4 * 128 * LK * 2;
constexpr int RS_OFF = GEMM_LDS;
constexpr int LDS_BYTES = GEMM_LDS + 1024;

template <int AMODE, bool F16 = false, bool MASK = false>
DI void gemm_tile(const bf16_t* __restrict__ Ab, int lda, int row0, int rlo, int rhi,
                  const bf16_t* __restrict__ Bt, int ldb, int K, char* smem, f32x16 (&acc)[2][2]) {
    const int t = tid(), lane = t & 63, w = __builtin_amdgcn_readfirstlane(t >> 6), wm = w >> 1, wn = w & 1, l32 = lane & 31, h = lane >> 5;
    bf16_t* As = (bf16_t*)smem;
    bf16_t* Bs = As + 2 * 128 * LK;
    float* rs = (float*)(smem + RS_OFF);
#pragma unroll
    for (int i = 0; i < 2; ++i)
#pragma unroll
        for (int j = 0; j < 2; ++j)
#pragma unroll
            for (int r = 0; r < 16; ++r) acc[i][j][r] = 0.f;

    uint4 p0a0, p0a1, p0a2, p0a3, p0b0, p0b1, p0b2, p0b3, p1a0, p1a1, p1a2, p1a3, p1b0, p1b1, p1b2, p1b3;
    float ss0 = 0.f, ss1 = 0.f, ss2 = 0.f, ss3 = 0.f;
    const int gr0 = row0 + (t >> 3);
    const bool rv0 = gr0 >= rlo && gr0 < rhi, rv1 = gr0 + 32 >= rlo && gr0 + 32 < rhi, rv2 = gr0 + 64 >= rlo && gr0 + 64 < rhi, rv3 = gr0 + 96 >= rlo && gr0 + 96 < rhi;
    const int nk = K >> 6;
    const int rhm = rhi - 1;
    const unsigned aoff0 = (unsigned)min(max(gr0, rlo), rhm) * (unsigned)lda + 8u * (t & 7);
    const unsigned aoff1 = (unsigned)min(max(gr0 + 32, rlo), rhm) * (unsigned)lda + 8u * (t & 7);
    const unsigned aoff2 = (unsigned)min(max(gr0 + 64, rlo), rhm) * (unsigned)lda + 8u * (t & 7);
    const unsigned aoff3 = (unsigned)min(max(gr0 + 96, rlo), rhm) * (unsigned)lda + 8u * (t & 7);
    const unsigned btoff = (unsigned)((t >> 3) * ldb + 8 * (t & 7));

    __syncthreads();

#define LD1(S, j, k0)                                                                                         \
    {                                                                                                         \
        S##a##j = *(const uint4*)(Ab + (k0) + aoff##j);          \
        S##b##j = *(const uint4*)(Bt + (size_t)(32 * j) * ldb + (k0) + btoff);                                \
    }
#define LOADS(S, k0) { LD1(S, 0, k0) LD1(S, 1, k0) LD1(S, 2, k0) LD1(S, 3, k0) }
#define ST1(S, j, buf)                                                                                        \
    {                                                                                                         \
        uint4 v = S##a##j;                                                                                    \
        if constexpr (MASK) { if (!rv##j) v = make_uint4(0, 0, 0, 0); }     \
        if (AMODE == 1) {                                                                                     \
            float a0 = bflo(v.x), a1 = bfhi(v.x), a2 = bflo(v.y), a3 = bfhi(v.y), a4 = bflo(v.z), a5 = bfhi(v.z), a6 = bflo(v.w), a7 = bfhi(v.w); \
            ss##j += a0 * a0 + a1 * a1 + a2 * a2 + a3 * a3 + a4 * a4 + a5 * a5 + a6 * a6 + a7 * a7;          \
        }                                                                                                     \
        *(uint4*)(As + (buf) * 128 * LK + ((t >> 3) + 32 * j) * LK + 8 * (t & 7)) = v;                        \
        *(uint4*)(Bs + (buf) * 128 * LK + ((t >> 3) + 32 * j) * LK + 8 * (t & 7)) = S##b##j;                  \
    }
#define STORES(S, buf) { ST1(S, 0, buf) ST1(S, 1, buf) ST1(S, 2, buf) ST1(S, 3, buf) }
#define FRAGS(ks, A0, A1, B0, B1) { A0 = *(const bf16x8*)(a_s + (ks) * 16); A1 = *(const bf16x8*)(a_s + 32 * LK + (ks) * 16); B0 = *(const bf16x8*)(b_s + (ks) * 16); B1 = *(const bf16x8*)(b_s + 32 * LK + (ks) * 16); }
#define MMAS(A0, A1, B0, B1) { __builtin_amdgcn_s_setprio(1); if constexpr (F16) { acc[0][0] = MFMA_H(A0, B0, acc[0][0]); acc[0][1] = MFMA_H(A0, B1, acc[0][1]); acc[1][0] = MFMA_H(A1, B0, acc[1][0]); acc[1][1] = MFMA_H(A1, B1, acc[1][1]); } else { acc[0][0] = MFMA(A0, B0, acc[0][0]); acc[0][1] = MFMA(A0, B1, acc[0][1]); acc[1][0] = MFMA(A1, B0, acc[1][0]); acc[1][1] = MFMA(A1, B1, acc[1][1]); } __builtin_amdgcn_s_setprio(0); }
#define COMPUTE(buf)                                                                                          \
    {                                                                                                         \
        const bf16_t* a_s = As + (buf) * 128 * LK + (wm * 64 + l32) * LK + h * 8;                             \
        const bf16_t* b_s = Bs + (buf) * 128 * LK + (wn * 64 + l32) * LK + h * 8;                             \
        bf16x8 xa0, xa1, xb0, xb1, ya0, ya1, yb0, yb1;                                                        \
        FRAGS(0, xa0, xa1, xb0, xb1)                                                                          \
        FRAGS(1, ya0, ya1, yb0, yb1)                                                                          \
        MMAS(xa0, xa1, xb0, xb1)                                                                              \
        FRAGS(2, xa0, xa1, xb0, xb1)                                                                          \
        MMAS(ya0, ya1, yb0, yb1)                                                                              \
        FRAGS(3, ya0, ya1, yb0, yb1)                                                                          \
        MMAS(xa0, xa1, xb0, xb1)                                                                              \
        MMAS(ya0, ya1, yb0, yb1)                                                                              \
    }

    const int klast = (nk - 1) * 64;
    LOADS(p0, 0);
    LOADS(p1, 64);
    STORES(p0, 0);
    LOADS(p0, min(128, klast));
    __syncthreads();
    for (int kt = 0; kt < nk; kt += 2) {
        COMPUTE(0);
        STORES(p1, 1);
        LOADS(p1, min((kt + 3) * 64, klast));
        __syncthreads();
        COMPUTE(1);
        if (kt + 2 < nk) STORES(p0, 0);
        LOADS(p0, min((kt + 4) * 64, klast));
        __syncthreads();
    }
#undef LOADS
#undef STORES
#undef COMPUTE
#undef FRAGS
#undef MMAS
#undef LD1
#undef ST1
    if (AMODE == 1) {
#define RS1(j) { float s = ss##j; s += __shfl_xor(s, 1); s += __shfl_xor(s, 2); s += __shfl_xor(s, 4); if ((t & 7) == 0) rs[(t >> 3) + 32 * j] = rsqrtf(s / (float)K + EPS); }
        RS1(0) RS1(1) RS1(2) RS1(3)
#undef RS1
        __syncthreads();
    }
}

DI float rs_load(KP p, int row0) {
    const int t = tid(), r = row0 + (t >> 1);
    float sum = 0.f;
    if (r >= 0 && r < TOK) {
        const float4* ps = (const float4*)((const float*)(p->ws + OFF_RSC) + (size_t)r * 16 + (t & 1) * 8);
        const float4 a = ps[0], b = ps[1];
        sum = (a.x + a.y) + (a.z + a.w) + (b.x + b.y) + (b.z + b.w);
    }
    return sum;
}
DI void rs_finish(float sum, int row0, char* smem) {
    const int t = tid(), r = row0 + (t >> 1);
    sum += __shfl_xor(sum, 1);
    if ((t & 1) == 0) ((float*)(smem + RS_OFF))[t >> 1] = (r >= 0 && r < TOK) ? rsqrtf(sum * (1.f / DM) + EPS) : 0.f;
    __syncthreads();
}

DI void tile_rc(int t, int NT, int& rt, int& ct) { const int g = t / (8 * NT), rem = t - g * 8 * NT; ct = rem >> 3; rt = g * 8 + (rem & 7); }

template <class E> DI void run_epi(const f32x16 (&acc)[2][2], const E& e) {
    const int w = __builtin_amdgcn_readfirstlane(tid() >> 6), wm = w >> 1, wn = w & 1;
#pragma unroll
    for (int i = 0; i < 2; ++i)
#pragma unroll
        for (int j = 0; j < 2; ++j) e(wm * 64 + i * 32, wn * 64 + j * 32, acc[i][j]);
}

DI int up_perm(int n) { return n < DFF ? (n >> 6) * 128 + (n & 63) : ((n - DFF) >> 6) * 128 + 64 + ((n - DFF) & 63); }

DI void conv_tile(const float* __restrict__ src, int K, int N, const float* g1, const float* g2, int ksplit,
                  bf16_t* __restrict__ dst, int rowmap, int tile, float* lds, int mode, bool f16 = false) {
    const int ntn = N >> 5, tk = tile / ntn, tn = tile - tk * ntn, k0 = tk * 32, n0 = tn * 32;
    const int tx = tid() & 31, ty = tid() >> 5;
    if (mode == 0) {
#pragma unroll
        for (int i = 0; i < 4; ++i) {
            int k = k0 + ty + 8 * i;
            float v = __builtin_nontemporal_load(src + (size_t)k * N + n0 + tx);
            float g = g1 ? (k < ksplit ? g1[k] : g2[k - ksplit]) : 1.f;
            lds[(ty + 8 * i) * 33 + tx] = v * g;
        }
    } else {
#pragma unroll
        for (int i = 0; i < 4; ++i) {
            int n = n0 + ty + 8 * i;
            int nn = rowmap ? up_perm(n) : n;
            const float wv = lds[tx * 33 + ty + 8 * i];
            dst[(size_t)nn * K + k0 + tx] = f16 ? f2h(wv) : f2bf(wv);
        }
    }
}

__device__ void phase_setup(KP p, char* smem) {
    float* lds = (float*)smem;
    char* ws = p->ws;
    constexpr int PER_LAYER = 1440 + 192 + 128 + 1024 + 1024 + 2048 + 1024 + 5632 + 2816;
    auto job = [&](int t, float* ldsq, int mode) __attribute__((always_inline)) {
        int l = t / PER_LAYER, r = t - l * PER_LAYER;
        if (r < 1440) conv_tile(p->w_in + (size_t)l * DM * INC, DM, INC, p->norm_mix_g + l * DM, nullptr, DM, (bf16_t*)(ws + OFF_WIN) + (size_t)l * INCP * DM, 0, r, ldsq, mode, true);
        else if ((r -= 1440) < 192) conv_tile(p->w_uq + (size_t)l * QL * 768, QL, 768, p->q_norm_g + l * QL, nullptr, QL, (bf16_t*)(ws + OFF_WUQ) + (size_t)l * 768 * QL, 0, r, ldsq, mode);
        else if ((r -= 192) < 128) conv_tile(p->w_ukv + (size_t)l * KVL * 1024, KVL, 1024, p->kv_norm_g + l * KVL, nullptr, KVL, (bf16_t*)(ws + OFF_WUKV) + (size_t)l * 1024 * KVL, 0, r, ldsq, mode);
        else if ((r -= 128) < 1024) conv_tile(p->w_out + (size_t)l * DM * DM, DM, DM, p->out_norm_mla_g + l * 512, p->out_norm_sg_g + l * 512, 512, (bf16_t*)(ws + OFF_WOUT) + (size_t)l * DM * DM, 0, r, ldsq, mode);
        else if ((r -= 1024) < 1024) conv_tile(p->w_mq + (size_t)l * DM * DM, DM, DM, p->norm_mem_g + l * DM, nullptr, DM, (bf16_t*)(ws + OFF_WMQ) + (size_t)l * DM * DM, 0, r, ldsq, mode, true);
        else if ((r -= 1024) < 2048) conv_tile(p->w_mkv + (size_t)l * DM * 2048, DM, 2048, p->mem_norm_g + l * DM, nullptr, DM, (bf16_t*)(ws + OFF_WMKV) + (size_t)l * 2048 * DM, 0, r, ldsq, mode);
        else if ((r -= 2048) < 1024) conv_tile(p->w_mo + (size_t)l * DM * DM, DM, DM, nullptr, nullptr, DM, (bf16_t*)(ws + OFF_WMO) + (size_t)l * DM * DM, 0, r, ldsq, mode);
        else if ((r -= 1024) < 5632) conv_tile(p->w_up + (size_t)l * DM * 2 * DFF, DM, 2 * DFF, p->norm_ffn_g + l * DM, nullptr, DM, (bf16_t*)(ws + OFF_WUP) + (size_t)l * 2 * DFF * DM, 1, r, ldsq, mode, true);
        else { r -= 5632; conv_tile(p->w_down + (size_t)l * DFF * DM, DFF, DM, nullptr, nullptr, DFF, (bf16_t*)(ws + OFF_WDN) + (size_t)l * DM * DFF, 0, r, ldsq, mode); }
    };
    constexpr int NJOB = PER_LAYER * DEPTH, TPB = 4;
    for (int t0 = blockIdx.x; t0 < NJOB; t0 += TPB * gridDim.x) {
#pragma unroll
        for (int u = 0; u < TPB; ++u) { const int t = t0 + u * gridDim.x; if (t < NJOB) job(t, lds + u * 32 * 33, 0); }
        __syncthreads();
#pragma unroll
        for (int u = 0; u < TPB; ++u) { const int t = t0 + u * gridDim.x; if (t < NJOB) job(t, lds + u * 32 * 33, 1); }
        __syncthreads();
    }
    const size_t gt = (size_t)blockIdx.x * 256 + tid(), gn = (size_t)gridDim.x * 256;
    bf16_t* wsg = (bf16_t*)(ws + OFF_WSG);
    for (size_t i = gt; i < (size_t)DEPTH * 8 * 128 * 128; i += gn) wsg[i] = f2bf(p->sg_w_s[i]);
    for (size_t i = gt; i < (size_t)DEPTH * 96 * DM; i += gn) {
        size_t l = i / (96 * DM), r = i - l * (96 * DM);
        ((bf16_t*)(ws + OFF_WIN))[(l * INCP + INC) * DM + r] = 0;
    }
    {
        {
            const int lane = tid() & 63, wv = blockIdx.x * 4 + (tid() >> 6), nw = gridDim.x * 4;
            float* rsc = (float*)(ws + OFF_RSC);
            for (int row = wv; row < TOK; row += nw) {
                const float4* xs = (const float4*)(p->x + (size_t)row * DM); uint2* xd = (uint2*)(ws + OFF_XB) + (size_t)row * (DM / 4);
                float sacc = 0.f;
#pragma unroll
                for (int i = 0; i < 4; ++i) { float4 v = ld_nt16f(xs + lane + 64 * i); sacc += v.x * v.x + v.y * v.y + v.z * v.z + v.w * v.w; uint2 o; o.x = pack2h(v.x, v.y); o.y = pack2h(v.z, v.w); xd[lane + 64 * i] = o; }
#pragma unroll
                for (int o = 1; o < 64; o <<= 1) sacc += __shfl_xor(sacc, o);
                if (lane < 16) rsc[(size_t)row * 16 + lane] = lane == 0 ? sacc : 0.f;
            }
        }
        const float4* ms = (const float4*)p->mem; uint2* md = (uint2*)(ws + OFF_MEMB);
        for (size_t i = gt; i < (size_t)NBATCH * NMEM * DM / 4; i += gn) { float4 v = ms[i]; uint2 o; o.x = pack2(v.x, v.y); o.y = pack2(v.z, v.w); md[i] = o; }
    }
    float* cs = (float*)(ws + OFF_COS); float* sn = (float*)(ws + OFF_SIN);
    for (size_t i = gt; i < (size_t)TOK * 16; i += gn) {
        int tok = (int)(i >> 4), f = (int)(i & 15);
        const float inv = ex2(-(float)f * 0.83048202372184058f);
        const float ang = (float)p->pos[tok] * inv;
        const float c_hi = 0.15915494309189535f, c_lo = 6.4206383e-9f;
        const float rh = ang * c_hi;
        const float re = fmaf(ang, c_hi, -rh) + ang * c_lo;
        float rf = (rh - floorf(rh)) + re;
        cs[i] = __builtin_amdgcn_cosf(rf);
        sn[i] = __builtin_amdgcn_sinf(rf);
    }
}

struct EpiMemKV {
    bf16_t* km; bf16_t* vm; const float* rs; int row0, col0;
    DI void operator()(int rb, int cb, const f32x16& a) const {
        const int lane = tid() & 63, c = lane & 31, h = lane >> 5;
        const int n0 = col0 + cb;
        if (n0 < 1024) {
            const int head = n0 >> 8, d = (n0 & 255) + c;
#pragma unroll
            for (int r = 0; r < 16; ++r) {
                int row = rb + crow(r, h), gr = row0 + row, b = gr >> 8, key = gr & 255;
                km[(((size_t)(b * 4 + head)) * 256 + key) * 256 + d] = f2bf(a[r] * rs[row]);
            }
        } else {
            const int head = (n0 - 1024) >> 8, d = ((n0 - 1024) & 255) + c;
#pragma unroll
            for (int g = 0; g < 4; ++g) {
                int row = rb + 8 * g + 4 * h, gr = row0 + row, b = gr >> 8, key = gr & 255;
                uint2 pk;
                pk.x = pack2(a[4 * g] * rs[row], a[4 * g + 1] * rs[row + 1]);
                pk.y = pack2(a[4 * g + 2] * rs[row + 2], a[4 * g + 3] * rs[row + 3]);
                *(uint2*)(vm + (((size_t)(b * 4 + head)) * 256 + d) * 256 + key) = pk;
            }
        }
    }
};

struct EpiIn {
    bf16_t *hq, *hkv, *u, *v, *kb; const float *cs, *sn, *rs; int row0, col0;
    DI void operator()(int rb, int cb, const f32x16& a) const {
        const int lane = tid() & 63, c = lane & 31, h = lane >> 5;
        const int nb = col0 + cb;
        if (nb >= INC) return;
        if (nb == 384) {
#pragma unroll
            for (int r = 0; r < 16; ++r) {
                const int row = rb + crow(r, h), tok = row0 + row;
                const float val = a[r] * rs[row];
                float pt = __shfl_xor(val, 16);
                float co = cs[tok * 16 + (c & 15)], si = sn[tok * 16 + (c & 15)];
                float o = (c < 16) ? val * co - pt * si : val * co + pt * si;
                bf16_t ob = f2bf(o);
                const int b = tok >> 13, s = tok & 8191;
                bf16_t* dst = kb + (((size_t)(b * 8)) * SEQ + s) * 96 + 64 + c;
                for (int hd = 0; hd < 8; ++hd) dst[(size_t)hd * SEQ * 96] = ob;
            }
            return;
        }
        bf16_t* dst; int pitch, off; bool act;
        if (nb < 256) { dst = hq; pitch = 256; off = nb; act = false; }
        else if (nb < 384) { dst = hkv; pitch = 128; off = nb - 256; act = false; }
        else if (nb < 928) { dst = u; pitch = 512; off = nb - 416; act = true; }
        else { dst = v; pitch = 512; off = nb - 928; act = true; }
        dst += (size_t)(row0 + rb + 4 * h) * pitch + off + c;
#pragma unroll
        for (int r = 0; r < 16; ++r) {
            const int rr = (r & 3) + 8 * (r >> 2);
            float val = a[r] * rs[rb + rr + 4 * h];
            if (act) val = gelu_tanh(val);
            dst[(size_t)rr * pitch] = f2bf(val);
        }
    }
};

struct EpiQ {
    bf16_t* q; const float *cs, *sn, *rs; int row0, col0;
    DI void operator()(int rb, int cb, const f32x16& a) const {
        const int lane = tid() & 63, c = lane & 31, h = lane >> 5;
        const int n0 = col0 + cb, head = n0 / 96, w0 = n0 - head * 96;
        const float qs = 0.10206207261596575f * LOG2E;
#pragma unroll
        for (int r = 0; r < 16; ++r) {
            const int row = rb + crow(r, h), tok = row0 + row;
            float val = a[r] * rs[row] * qs;
            if (w0 == 64) {
                float pt = __shfl_xor(val, 16);
                float co = cs[tok * 16 + (c & 15)], si = sn[tok * 16 + (c & 15)];
                val = (c < 16) ? val * co - pt * si : val * co + pt * si;
            }
            const int b = tok >> 13, s = tok & 8191;
            q[(((size_t)(b * 8 + head)) * SEQ + s) * 96 + w0 + c] = f2bf(val);
        }
    }
};

struct EpiKV {
    bf16_t *kb, *vstage; const float* rs; int row0, col0;
    DI void operator()(int rb, int cb, const f32x16& a) const {
        const int lane = tid() & 63, c = lane & 31, h = lane >> 5;
        const int n0 = col0 + cb, head = n0 >> 7, w0 = n0 & 127;
        if (w0 < 64) {
#pragma unroll
            for (int r = 0; r < 16; ++r) {
                const int row = rb + crow(r, h), tok = row0 + row, b = tok >> 13, s = tok & 8191;
                kb[(((size_t)(b * 8 + head)) * SEQ + s) * 96 + w0 + c] = f2bf(a[r] * rs[row]);
            }
        } else {
            const int d = w0 - 64 + c;
#pragma unroll
            for (int g = 0; g < 4; ++g) {
                const int row = rb + 8 * g + 4 * h;
                uint2 pk;
                pk.x = pack2(a[4 * g] * rs[row], a[4 * g + 1] * rs[row + 1]);
                pk.y = pack2(a[4 * g + 2] * rs[row + 2], a[4 * g + 3] * rs[row + 3]);
                *(uint2*)(vstage + d * 136 + row) = pk;
            }
        }
    }
};

struct EpiRes {
    bf16_t* xb; int row0, col0; bool dry;
    DI void operator()(int rb, int cb, const f32x16& a, f32x16& sq) const {
        const int lane = tid() & 63, c = lane & 31, h = lane >> 5;
        if (dry && a[0] != 1.2345e30f) return;
        bf16_t* ptr = xb + (size_t)(row0 + rb + 4 * h) * DM + col0 + cb + c;
#pragma unroll
        for (int r = 0; r < 16; ++r) {
            const int rr = (r & 3) + 8 * (r >> 2);
            const bf16_t nb = f2h(h2f(ptr[(size_t)rr * DM]) + a[r]);
            ptr[(size_t)rr * DM] = nb;
            const float nv = h2f(nb);
            sq[r] += nv * nv;
        }
    }
};

struct EpiQm {
    bf16_t* qm; const float* rs; int row0, col0;
    DI void operator()(int rb, int cb, const f32x16& a) const {
        const int lane = tid() & 63, c = lane & 31, h = lane >> 5;
#pragma unroll
        for (int r = 0; r < 16; ++r) {
            const int row = rb + crow(r, h);
            qm[(size_t)(row0 + row) * DM + col0 + cb + c] = f2bf(a[r] * rs[row] * (0.0625f * LOG2E));
        }
    }
};

template <int DQK, int DV, int NBUF, bool QREG, int QW, int LDQ, int LDK, int LDV, int LDO>
DI void flash_item(const bf16_t* __restrict__ Qp, const bf16_t* __restrict__ Kp, const bf16_t* __restrict__ Vtp, int nkt,
                   bf16_t* __restrict__ Op, char* smem, float& ssq) {
    constexpr int KP = DQK + 8;
    constexpr int VP = 72;
    constexpr int CPR = DQK / 8;
    constexpr int KCH = 64 * CPR / 256;
    constexpr int VCH = DV * 8 / 256;
    constexpr int NKS = DQK / 16, NMT = DV / 32 / QW;
    constexpr bool KROWS = (256 % CPR) == 0;
    static_assert(KROWS || LDK == DQK, "K tile addressing");
    static_assert(KCH <= 8 && VCH <= 8, "staging regs");
    static_assert(NBUF == 2 ? (KCH <= 4 && VCH <= 2) : (KCH == 8 && VCH == 8), "staging");
    bf16_t* Ks = (bf16_t*)smem;
    bf16_t* Vs = Ks + NBUF * 64 * KP;
    const int t = tid(), lane = t & 63, w = __builtin_amdgcn_readfirstlane(t >> 6), l32 = lane & 31, h = lane >> 5;
    const int q = (w / QW) * 32 + l32, dv0 = (w % QW) * (DV / QW);
    const unsigned ktoff = KROWS ? (unsigned)((t / CPR) * LDK + (t % CPR) * 8) : (unsigned)(t * 8);
    const unsigned vtoff = (unsigned)((t >> 3) * LDV + (t & 7) * 8);

    bf16x8 qf[QREG ? NKS : 1];
    if constexpr (QREG) {
#pragma unroll
        for (int ks = 0; ks < NKS; ++ks) qf[ks] = *(const bf16x8*)(Qp + (size_t)q * LDQ + ks * 16 + 8 * h);
    }
    f32x16 o[NMT];
#pragma unroll
    for (int mt = 0; mt < NMT; ++mt)
#pragma unroll
        for (int r = 0; r < 16; ++r) o[mt][r] = 0.f;
    float m = -INFINITY, lsum = 0.f;

    uint4 rk0, rk1, rk2, rk3, rk4, rk5, rk6, rk7, rv0, rv1;
    (void)rk0; (void)rk1; (void)rk2; (void)rk3; (void)rk4; (void)rk5; (void)rk6; (void)rk7; (void)rv0; (void)rv1;
#define LKJ(kt, i, R) { const bf16_t* kb_ = KROWS ? Kp + (size_t)((kt) * 64 + (i) * (256 / CPR)) * LDK : Kp + (size_t)(kt) * 64 * DQK + (i) * 2048; R = *(const uint4*)(kb_ + ktoff); }
#define SKJ(buf, i, R) { int c = t + 256 * (i), row = c / CPR, cc = c - row * CPR; *(uint4*)(Ks + (buf) * 64 * KP + swap23(row) * KP + cc * 8) = R; }
#define LVJ(kt, i, R) { const bf16_t* vb_ = Vtp + (size_t)(i) * 32 * LDV + (kt) * 64; R = *(const uint4*)(vb_ + vtoff); }
#define SVJ(buf, i, R) { int c = t + 256 * (i), d = c >> 3, cc = c & 7; *(uint4*)(Vs + (buf) * DV * VP + d * VP + cc * 8) = R; }
#define ATT_LOAD(kt) { LKJ(kt, 0, rk0) if constexpr (KCH > 1) LKJ(kt, 1, rk1) if constexpr (KCH > 2) LKJ(kt, 2, rk2) if constexpr (KCH > 3) LKJ(kt, 3, rk3) LVJ(kt, 0, rv0) if constexpr (VCH > 1) LVJ(kt, 1, rv1) }
#define ATT_STORE(buf) { SKJ(buf, 0, rk0) if constexpr (KCH > 1) SKJ(buf, 1, rk1) if constexpr (KCH > 2) SKJ(buf, 2, rk2) if constexpr (KCH > 3) SKJ(buf, 3, rk3) SVJ(buf, 0, rv0) if constexpr (VCH > 1) SVJ(buf, 1, rv1) }

    __syncthreads();
    if constexpr (NBUF == 2) ATT_LOAD(0);
    for (int kt = 0; kt < nkt; ++kt) {
        const int buf = (NBUF == 2) ? (kt & 1) : 0;
        if constexpr (NBUF == 1) {
            __syncthreads();
            LKJ(kt, 0, rk0) LKJ(kt, 1, rk1) LKJ(kt, 2, rk2) LKJ(kt, 3, rk3)
            LKJ(kt, 4, rk4) LKJ(kt, 5, rk5) LKJ(kt, 6, rk6) LKJ(kt, 7, rk7)
            SKJ(0, 0, rk0) SKJ(0, 1, rk1) SKJ(0, 2, rk2) SKJ(0, 3, rk3)
            asm volatile("" ::: "memory");
            LVJ(kt, 0, rk0) LVJ(kt, 1, rk1) LVJ(kt, 2, rk2) LVJ(kt, 3, rk3)
            SKJ(0, 4, rk4) SKJ(0, 5, rk5) SKJ(0, 6, rk6) SKJ(0, 7, rk7)
            asm volatile("" ::: "memory");
            LVJ(kt, 4, rk4) LVJ(kt, 5, rk5) LVJ(kt, 6, rk6) LVJ(kt, 7, rk7)
            SVJ(0, 0, rk0) SVJ(0, 1, rk1) SVJ(0, 2, rk2) SVJ(0, 3, rk3)
            asm volatile("" ::: "memory");
            SVJ(0, 4, rk4) SVJ(0, 5, rk5) SVJ(0, 6, rk6) SVJ(0, 7, rk7)
        } else { ATT_STORE(buf); }
        __syncthreads();
        if constexpr (NBUF == 2) { if (kt + 1 < nkt) ATT_LOAD(kt + 1); }

        const bf16_t* kb = Ks + buf * 64 * KP + l32 * KP + 8 * h;
        f32x16 s0, s1;
#pragma unroll
        for (int r = 0; r < 16; ++r) { s0[r] = 0.f; s1[r] = 0.f; }
#pragma unroll
        for (int ks = 0; ks < NKS; ++ks) {
            bf16x8 qq;
            if constexpr (QREG) qq = qf[ks]; else qq = *(const bf16x8*)(Qp + (size_t)q * LDQ + ks * 16 + 8 * h);
            bf16x8 k0 = *(const bf16x8*)(kb + ks * 16);
            bf16x8 k1 = *(const bf16x8*)(kb + 32 * KP + ks * 16);
            s0 = MFMA(k0, qq, s0);
            s1 = MFMA(k1, qq, s1);
        }
        float mx = s0[0];
#pragma unroll
        for (int r = 1; r < 16; ++r) mx = fmaxf(mx, s0[r]);
#pragma unroll
        for (int r = 0; r < 16; ++r) mx = fmaxf(mx, s1[r]);
        mx = fmaxf(mx, __shfl_xor(mx, 32));
        const float mn = fmaxf(m, mx);
        const float alpha = ex2(m - mn);
        m = mn;
        float psum = 0.f;
#pragma unroll
        for (int r = 0; r < 16; ++r) { s0[r] = ex2(s0[r] - mn); psum += s0[r]; }
#pragma unroll
        for (int r = 0; r < 16; ++r) { s1[r] = ex2(s1[r] - mn); psum += s1[r]; }
        lsum = lsum * alpha + psum;
        if (__builtin_amdgcn_ballot_w64(alpha != 1.f) != 0ull) {
#pragma unroll
            for (int mt = 0; mt < NMT; ++mt)
#pragma unroll
                for (int r = 0; r < 16; ++r) o[mt][r] *= alpha;
        }
        const bf16_t* vb = Vs + buf * DV * VP + (dv0 + l32) * VP + 8 * h;
#pragma unroll
        for (int t2 = 0; t2 < 2; ++t2)
#pragma unroll
            for (int s2 = 0; s2 < 2; ++s2) {
                u32x4 pu;
#pragma unroll
                for (int j = 0; j < 4; ++j)
                    pu[j] = t2 ? pack2(s1[8 * s2 + 2 * j], s1[8 * s2 + 2 * j + 1]) : pack2(s0[8 * s2 + 2 * j], s0[8 * s2 + 2 * j + 1]);
                const bf16x8 pfv = __builtin_bit_cast(bf16x8, pu);
#pragma unroll
                for (int mt = 0; mt < NMT; ++mt) {
                    bf16x8 vv = *(const bf16x8*)(vb + mt * 32 * VP + t2 * 32 + s2 * 16);
                    o[mt] = MFMA(vv, pfv, o[mt]);
                }
            }
    }
#undef ATT_LOAD
#undef ATT_STORE
#undef LKJ
#undef SKJ
#undef LVJ
#undef SVJ
    const float inv = 1.f / (lsum + __shfl_xor(lsum, 32));
#pragma unroll
    for (int mt = 0; mt < NMT; ++mt)
#pragma unroll
        for (int g = 0; g < 4; ++g) {
            float v0 = o[mt][4 * g] * inv, v1 = o[mt][4 * g + 1] * inv, v2 = o[mt][4 * g + 2] * inv, v3 = o[mt][4 * g + 3] * inv;
            uint2 pk; pk.x = pack2(v0, v1); pk.y = pack2(v2, v3);
            float r0 = bflo(pk.x), r1 = bfhi(pk.x), r2 = bflo(pk.y), r3 = bfhi(pk.y);
            ssq += r0 * r0 + r1 * r1 + r2 * r2 + r3 * r3;
            *(uint2*)(Op + (size_t)q * LDO + dv0 + mt * 32 + 8 * g + 4 * h) = pk;
        }
}

DI void flash_mla2(const bf16_t* __restrict__ Qp, const bf16_t* __restrict__ Kp, const bf16_t* __restrict__ Vtp,
                   bf16_t* __restrict__ Op, char* smem, float& ssq) {
    constexpr int DQK = 96, DV = 64, LDQ = 96, LDV = SEQ, LDO = DM, NKT = SEQ / 64;
    constexpr int KP = DQK + 8, VP = 72, CPR = DQK / 8, NKS = DQK / 16, NMT = DV / 32;
    bf16_t* Ks = (bf16_t*)smem;
    bf16_t* Vs = Ks + 2 * 64 * KP;
    const int t = tid(), lane = t & 63, w = __builtin_amdgcn_readfirstlane(t >> 6), l32 = lane & 31, h = lane >> 5;
    const int q = w * 32 + l32;
    const unsigned ktoff = (unsigned)(t * 8);
    const unsigned vtoff = (unsigned)((t >> 3) * LDV + (t & 7) * 8);
    bf16x8 qf[NKS];
#pragma unroll
    for (int ks = 0; ks < NKS; ++ks) qf[ks] = *(const bf16x8*)(Qp + (size_t)q * LDQ + ks * 16 + 8 * h);
    f32x16 o[NMT];
#pragma unroll
    for (int mt = 0; mt < NMT; ++mt)
#pragma unroll
        for (int r = 0; r < 16; ++r) o[mt][r] = 0.f;
    float m = 0.f, lsum = 0.f;
    uint4 ak0, ak1, ak2, av0, av1, bk0, bk1, bk2, bv0, bv1;
#define M2_LOAD(S, kt) { const bf16_t* kb_ = Kp + (size_t)(kt) * 64 * DQK; S##k0 = *(const uint4*)(kb_ + ktoff); S##k1 = *(const uint4*)(kb_ + 2048 + ktoff); S##k2 = *(const uint4*)(kb_ + 4096 + ktoff); \
        const bf16_t* vb_ = Vtp + (kt) * 64; S##v0 = *(const uint4*)(vb_ + vtoff); S##v1 = *(const uint4*)(vb_ + (size_t)32 * LDV + vtoff); }
#define M2_SK(i, R, buf) { int c = t + 256 * (i), row = c / CPR, cc = c - row * CPR; *(uint4*)(Ks + (buf) * 64 * KP + swap23(row) * KP + cc * 8) = R; }
#define M2_SV(i, R, buf) { int c = t + 256 * (i), d = c >> 3, cc = c & 7; *(uint4*)(Vs + (buf) * DV * VP + d * VP + cc * 8) = R; }
#define M2_STORE(S, buf) { M2_SK(0, S##k0, buf) M2_SK(1, S##k1, buf) M2_SK(2, S##k2, buf) M2_SV(0, S##v0, buf) M2_SV(1, S##v1, buf) }
#define M2_COMPUTE(buf) { \
        if (__builtin_amdgcn_ballot_w64(alpha != 1.f) != 0ull) { \
            _Pragma("unroll") for (int mt = 0; mt < NMT; ++mt) _Pragma("unroll") for (int r = 0; r < 16; ++r) o[mt][r] *= alpha; } \
        lsum *= alpha; \
        const bf16_t* kb = Ks + (buf) * 64 * KP + l32 * KP + 8 * h; \
        f32x16 s0, s1; \
        const float nm = -m; \
        _Pragma("unroll") for (int r = 0; r < 16; ++r) { s0[r] = nm; s1[r] = nm; } \
        _Pragma("unroll") for (int ks = 0; ks < NKS; ++ks) { bf16x8 k0 = *(const bf16x8*)(kb + ks * 16); bf16x8 k1 = *(const bf16x8*)(kb + 32 * KP + ks * 16); s0 = MFMA(k0, qf[ks], s0); s1 = MFMA(k1, qf[ks], s1); } \
        float mx = s0[0]; \
        _Pragma("unroll") for (int r = 1; r < 16; ++r) mx = fmaxf(mx, s0[r]); \
        _Pragma("unroll") for (int r = 0; r < 16; ++r) mx = fmaxf(mx, s1[r]); \
        mx = fmaxf(mx, __shfl_xor(mx, 32)); \
        float psum = 0.f; \
        _Pragma("unroll") for (int r = 0; r < 16; ++r) { s0[r] = ex2(s0[r]); psum += s0[r]; } \
        _Pragma("unroll") for (int r = 0; r < 16; ++r) { s1[r] = ex2(s1[r]); psum += s1[r]; } \
        lsum += psum; \
        const float dgrow = fmaxf(mx, 0.f); alpha = ex2(-dgrow); m += dgrow; \
        const bf16_t* vb = Vs + (buf) * DV * VP + l32 * VP + 8 * h; \
        _Pragma("unroll") for (int s2 = 0; s2 < 2; ++s2) { \
            u32x4 pu0, pu1; \
            _Pragma("unroll") for (int j = 0; j < 4; ++j) { pu0[j] = pack2(s0[8 * s2 + 2 * j], s0[8 * s2 + 2 * j + 1]); pu1[j] = pack2(s1[8 * s2 + 2 * j], s1[8 * s2 + 2 * j + 1]); } \
            const bf16x8 pf0 = __builtin_bit_cast(bf16x8, pu0), pf1 = __builtin_bit_cast(bf16x8, pu1); \
            _Pragma("unroll") for (int mt = 0; mt < NMT; ++mt) { \
                bf16x8 v0 = *(const bf16x8*)(vb + mt * 32 * VP + s2 * 16); bf16x8 v1 = *(const bf16x8*)(vb + mt * 32 * VP + 32 + s2 * 16); \
                o[mt] = MFMA(v0, pf0, o[mt]); o[mt] = MFMA(v1, pf1, o[mt]); } } }

    float alpha = 1.f;
    __syncthreads();
    M2_LOAD(a, 0);
    M2_LOAD(b, 1);
    {
        M2_STORE(a, 0);
        __syncthreads();
        const bf16_t* kb = Ks + l32 * KP + 8 * h;
        f32x16 s0, s1;
#pragma unroll
        for (int r = 0; r < 16; ++r) { s0[r] = 0.f; s1[r] = 0.f; }
#pragma unroll
        for (int ks = 0; ks < NKS; ++ks) { bf16x8 k0 = *(const bf16x8*)(kb + ks * 16); bf16x8 k1 = *(const bf16x8*)(kb + 32 * KP + ks * 16); s0 = MFMA(k0, qf[ks], s0); s1 = MFMA(k1, qf[ks], s1); }
        float mx = s0[0];
#pragma unroll
        for (int r = 1; r < 16; ++r) mx = fmaxf(mx, s0[r]);
#pragma unroll
        for (int r = 0; r < 16; ++r) mx = fmaxf(mx, s1[r]);
        m = fmaxf(mx, __shfl_xor(mx, 32));
        __syncthreads();
    }
    for (int kt = 0; kt < NKT; kt += 2) {
        M2_STORE(a, 0);
        __syncthreads();
        M2_LOAD(a, min(kt + 2, NKT - 1));
        M2_COMPUTE(0);
        M2_STORE(b, 1);
        __syncthreads();
        M2_LOAD(b, min(kt + 3, NKT - 1));
        M2_COMPUTE(1);
    }
#undef M2_LOAD
#undef M2_SK
#undef M2_SV
#undef M2_STORE
#undef M2_COMPUTE
    const float inv = 1.f / (lsum + __shfl_xor(lsum, 32));
#pragma unroll
    for (int mt = 0; mt < NMT; ++mt)
#pragma unroll
        for (int g = 0; g < 4; ++g) {
            float v0 = o[mt][4 * g] * inv, v1 = o[mt][4 * g + 1] * inv, v2 = o[mt][4 * g + 2] * inv, v3 = o[mt][4 * g + 3] * inv;
            uint2 pk; pk.x = pack2(v0, v1); pk.y = pack2(v2, v3);
            float r0 = bflo(pk.x), r1 = bfhi(pk.x), r2 = bflo(pk.y), r3 = bfhi(pk.y);
            ssq += r0 * r0 + r1 * r1 + r2 * r2 + r3 * r3;
            *(uint2*)(Op + (size_t)q * LDO + mt * 32 + 8 * g + 4 * h) = pk;
        }
}

DI void mla_item(KP p, int item, char* smem) {
    const int b = item >> 6, qb = item & 63;
    const bf16_t* Q = (const bf16_t*)(p->ws + OFF_Q);
    const bf16_t* K = (const bf16_t*)(p->ws + OFF_K);
    const bf16_t* Vt = (const bf16_t*)(p->ws + OFF_VT);
    bf16_t* om = (bf16_t*)(p->ws + OFF_OMIX) + ((size_t)b * SEQ + qb * 128) * DM;
    float ssq = 0.f;
    for (int hd = 0; hd < 8; ++hd) {
        const size_t bh = (size_t)(b * 8 + hd);
        flash_mla2(Q + (bh * SEQ + qb * 128) * 96, K + bh * SEQ * 96, Vt + bh * 64 * SEQ, om + hd * 64, smem, ssq);
    }
    ssq += __shfl_xor(ssq, 32);
    const float sc = rsqrtf(ssq * (1.f / 512.f) + EPS);
    const int lane = tid() & 63, w = tid() >> 6, q = w * 32 + (lane & 31), h = lane >> 5;
    for (int i = 0; i < 64; ++i) {
        uint2* ptr = (uint2*)(om + (size_t)q * DM + (i >> 3) * 64 + ((i >> 2) & 1) * 32 + (i & 3) * 8 + 4 * h);
        uint2 v = *ptr;
        v.x = pack2(bflo(v.x) * sc, bfhi(v.x) * sc);
        v.y = pack2(bflo(v.y) * sc, bfhi(v.y) * sc);
        *ptr = v;
    }
}

DI void memattn_item(KP p, int l, int item, char* smem) {
    const int head = item & 3, qt = (item >> 2) & 127, b = item >> 9;
    const bf16_t* qm = (const bf16_t*)(p->ws + OFF_QM) + ((size_t)b * SEQ + qt * 64) * DM + head * 256;
    const bf16_t* km = (const bf16_t*)(p->ws + OFF_KMEM) + ((size_t)((l * NBATCH + b) * 4 + head)) * 256 * 256;
    const bf16_t* vm = (const bf16_t*)(p->ws + OFF_VMEM) + ((size_t)((l * NBATCH + b) * 4 + head)) * 256 * 256;
    bf16_t* om = (bf16_t*)(p->ws + OFF_OMEM) + ((size_t)b * SEQ + qt * 64) * DM + head * 256;
    float dummy = 0.f;
    flash_item<256, 256, 1, true, 2, DM, 256, 256, DM>(qm, km, vm, 4, om, smem, dummy);
}

DI void gmlp_item(KP p, int l, int ci, char* smem) {
    constexpr int AP = 136;
    bf16_t* As = (bf16_t*)smem;
    bf16_t* Bs = As + 128 * AP;
    float* st = (float*)(Bs + 64 * AP);
    const int t = tid(), lane = t & 63, w = __builtin_amdgcn_readfirstlane(t >> 6), l32 = lane & 31, h = lane >> 5;
    const int tok0 = ci * 128;
    const bf16_t* vbuf = (const bf16_t*)(p->ws + OFF_V) + (size_t)tok0 * 512;
    const bf16_t* ubuf = (const bf16_t*)(p->ws + OFF_U) + (size_t)(tok0 + w * 32) * 512;
    bf16_t* om = (bf16_t*)(p->ws + OFF_OMIX) + (size_t)(tok0 + w * 32) * DM + 512;
    const bf16_t* wsg = (const bf16_t*)(p->ws + OFF_WSG) + (size_t)l * 8 * 128 * 128;
    const float* lng = p->sg_ln_g + l * 512; const float* lnb = p->sg_ln_b + l * 512;
    const float* bs = p->sg_b_s + l * 8 * 128 + w * 32;
    __syncthreads();
    {
        const int row = t >> 1, half = t & 1;
        const uint4* src = (const uint4*)(vbuf + (size_t)row * 512 + half * 256);
        float s = 0.f, s2 = 0.f;
#pragma unroll 4
        for (int i = 0; i < 32; ++i) {
            uint4 qv = src[i];
            float a0 = bflo(qv.x), a1 = bfhi(qv.x), a2 = bflo(qv.y), a3 = bfhi(qv.y), a4 = bflo(qv.z), a5 = bfhi(qv.z), a6 = bflo(qv.w), a7 = bfhi(qv.w);
            s += a0 + a1 + a2 + a3 + a4 + a5 + a6 + a7;
            s2 += a0 * a0 + a1 * a1 + a2 * a2 + a3 * a3 + a4 * a4 + a5 * a5 + a6 * a6 + a7 * a7;
        }
        s += __shfl_xor(s, 1); s2 += __shfl_xor(s2, 1);
        const float mean = s * (1.f / 512.f);
        const float var = fmaxf(s2 * (1.f / 512.f) - mean * mean, 0.f);
        if (half == 0) { st[2 * row] = mean; st[2 * row + 1] = rsqrtf(var + EPS); }
    }
    __syncthreads();
    float rq0 = 0.f, rq1 = 0.f, rq2 = 0.f, rq3 = 0.f;
    const bf16_t* ub0 = (const bf16_t*)(p->ws + OFF_U) + (size_t)tok0 * 512;
    bf16_t* om0 = (bf16_t*)(p->ws + OFF_OMIX) + (size_t)tok0 * DM + 512;
    const unsigned wtoff = (unsigned)((t >> 4) * 128 + (t & 15) * 8);
    const unsigned vtoff = (unsigned)((t >> 3) * 512 + (t & 7) * 8);
    const unsigned eoff_u = (unsigned)(4 * h * 512 + l32), eoff_o = (unsigned)(4 * h * DM + l32);
    for (int hd = 0; hd < 8; ++hd) {
        const bf16_t* wh = wsg + (size_t)hd * 128 * 128;
#pragma unroll
        for (int i = 0; i < 8; ++i)
            *(uint4*)(As + ((t >> 4) + 16 * i) * AP + (t & 15) * 8) = *(const uint4*)(wh + i * 16 * 128 + wtoff);
#pragma unroll
        for (int i = 0; i < 4; ++i) {
            const int j = (t >> 3) + 32 * i, c8 = t & 7;
            uint4 qv = *(const uint4*)(vbuf + (size_t)i * 32 * 512 + hd * 64 + vtoff);
            const float mean = st[2 * j], rstd = st[2 * j + 1];
            const int ch = hd * 64 + c8 * 8;
            const float4 g0 = *(const float4*)(lng + ch), g1 = *(const float4*)(lng + ch + 4);
            const float4 b0 = *(const float4*)(lnb + ch), b1 = *(const float4*)(lnb + ch + 4);
            bf16_t* bd = Bs + (c8 * 8) * AP + j;
            bd[0 * AP] = f2bf((bflo(qv.x) - mean) * rstd * g0.x + b0.x);
            bd[1 * AP] = f2bf((bfhi(qv.x) - mean) * rstd * g0.y + b0.y);
            bd[2 * AP] = f2bf((bflo(qv.y) - mean) * rstd * g0.z + b0.z);
            bd[3 * AP] = f2bf((bfhi(qv.y) - mean) * rstd * g0.w + b0.w);
            bd[4 * AP] = f2bf((bflo(qv.z) - mean) * rstd * g1.x + b1.x);
            bd[5 * AP] = f2bf((bfhi(qv.z) - mean) * rstd * g1.y + b1.y);
            bd[6 * AP] = f2bf((bflo(qv.w) - mean) * rstd * g1.z + b1.z);
            bd[7 * AP] = f2bf((bfhi(qv.w) - mean) * rstd * g1.w + b1.w);
        }
        __syncthreads();
        f32x16 acc[2];
#pragma unroll
        for (int r = 0; r < 16; ++r) { acc[0][r] = 0.f; acc[1][r] = 0.f; }
        const bf16_t* a_s = As + (w * 32 + l32) * AP + 8 * h;
        const bf16_t* b_s = Bs + l32 * AP + 8 * h;
#pragma unroll
        for (int ks = 0; ks < 8; ++ks) {
            bf16x8 a = *(const bf16x8*)(a_s + ks * 16);
            bf16x8 b0 = *(const bf16x8*)(b_s + ks * 16);
            bf16x8 b1 = *(const bf16x8*)(b_s + 32 * AP + ks * 16);
            acc[0] = MFMA(a, b0, acc[0]);
            acc[1] = MFMA(a, b1, acc[1]);
        }
        __syncthreads();
        float* stgf = (float*)As;
#pragma unroll
        for (int j2 = 0; j2 < 2; ++j2)
#pragma unroll
            for (int r = 0; r < 16; ++r) {
                const int rr = (r & 3) + 8 * (r >> 2);
                stgf[(w * 32 + rr + 4 * h) * 68 + j2 * 32 + l32] = acc[j2][r] + (bs + hd * 128 + rr)[4 * h];
            }
        __syncthreads();
#pragma unroll
        for (int i = 0; i < 4; ++i) {
            const int row = (t >> 3) + 32 * i, c8 = t & 7;
            const float4 lo = *(const float4*)(stgf + row * 68 + c8 * 8), hi = *(const float4*)(stgf + row * 68 + c8 * 8 + 4);
            const uint4 uv = ld_nt16(ub0 + (size_t)row * 512 + hd * 64 + c8 * 8);
            uint4 ov;
            ov.x = pack2(bflo(uv.x) * lo.x, bfhi(uv.x) * lo.y); ov.y = pack2(bflo(uv.y) * lo.z, bfhi(uv.y) * lo.w);
            ov.z = pack2(bflo(uv.z) * hi.x, bfhi(uv.z) * hi.y); ov.w = pack2(bflo(uv.w) * hi.z, bfhi(uv.w) * hi.w);
            *(uint4*)(om0 + (size_t)row * DM + hd * 64 + c8 * 8) = ov;
            const float q0 = bflo(ov.x), q1 = bfhi(ov.x), q2 = bflo(ov.y), q3 = bfhi(ov.y), q4 = bflo(ov.z), q5 = bfhi(ov.z), q6 = bflo(ov.w), q7 = bfhi(ov.w);
            const float sqp = q0 * q0 + q1 * q1 + q2 * q2 + q3 * q3 + q4 * q4 + q5 * q5 + q6 * q6 + q7 * q7;
            if (i == 0) rq0 += sqp; else if (i == 1) rq1 += sqp; else if (i == 2) rq2 += sqp; else rq3 += sqp;
        }
        __syncthreads();
    }
#define GM_FIN(RQ, i) { float s_ = RQ; s_ += __shfl_xor(s_, 1); s_ += __shfl_xor(s_, 2); s_ += __shfl_xor(s_, 4); const float sc_ = rsqrtf(s_ * (1.f / 512.f) + EPS); \
        const int row = (t >> 3) + 32 * (i), c8 = t & 7; \
        for (int hd = 0; hd < 8; ++hd) { uint4* ptr = (uint4*)(om0 + (size_t)row * DM + hd * 64 + c8 * 8); uint4 v = *ptr; \
            v.x = pack2(bflo(v.x) * sc_, bfhi(v.x) * sc_); v.y = pack2(bflo(v.y) * sc_, bfhi(v.y) * sc_); v.z = pack2(bflo(v.z) * sc_, bfhi(v.z) * sc_); v.w = pack2(bflo(v.w) * sc_, bfhi(v.w) * sc_); *ptr = v; } }
    GM_FIN(rq0, 0) GM_FIN(rq1, 1) GM_FIN(rq2, 2) GM_FIN(rq3, 3)
#undef GM_FIN
}

DI void ph_memkv(KP p, char* smem) {
    for_tiles(DEPTH * 16 * 16, [&](int t) __attribute__((always_inline)) {
        const int l = t >> 8, rt = (t >> 4) & 15, ct = t & 15;
        f32x16 acc[2][2];
        gemm_tile<1>((const bf16_t*)(p->ws + OFF_MEMB), DM, rt * 128, 0, NBATCH * NMEM, (const bf16_t*)(p->ws + OFF_WMKV) + ((size_t)l * 2048 + ct * 128) * DM, DM, DM, smem, acc);
        EpiMemKV e{(bf16_t*)(p->ws + OFF_KMEM) + (size_t)l * NBATCH * 4 * 256 * 256, (bf16_t*)(p->ws + OFF_VMEM) + (size_t)l * NBATCH * 4 * 256 * 256,
                   (const float*)(smem + RS_OFF), rt * 128, ct * 128};
        run_epi(acc, e);
    });
}
DI float* stage_tile(const f32x16 (&acc)[2][2], const float* rs, char* smem) {
    const int tt = tid(), lane = tt & 63, w = __builtin_amdgcn_readfirstlane(tt >> 6), wm = w >> 1, wn = w & 1, l32 = lane & 31, h = lane >> 5;
    float* stg = (float*)smem;
#pragma unroll
    for (int i = 0; i < 2; ++i)
#pragma unroll
        for (int j = 0; j < 2; ++j)
#pragma unroll
            for (int r = 0; r < 16; ++r) {
                const int row = wm * 64 + i * 32 + crow(r, h);
                stg[row * 132 + wn * 64 + j * 32 + l32] = rs ? acc[i][j][r] * rs[row] : acc[i][j][r];
            }
    __syncthreads();
    return stg;
}
DI uint4 pack8(const float4& a, const float4& b) { uint4 o; o.x = pack2(a.x, a.y); o.y = pack2(a.z, a.w); o.z = pack2(b.x, b.y); o.w = pack2(b.z, b.w); return o; }
DI float4 gelu4(const float4& a) { float4 o; o.x = gelu_tanh(a.x); o.y = gelu_tanh(a.y); o.z = gelu_tanh(a.z); o.w = gelu_tanh(a.w); return o; }
DI void rope8(float4& lo, float4& hi, const float4& plo, const float4& phi, const float* cs, const float* sn, int c) {
    const float4 c0 = *(const float4*)(cs + (c & 15)), c1 = *(const float4*)(cs + (c & 15) + 4);
    const float4 s0 = *(const float4*)(sn + (c & 15)), s1 = *(const float4*)(sn + (c & 15) + 4);
    const float sg = c < 16 ? -1.f : 1.f;
    lo.x = lo.x * c0.x + sg * plo.x * s0.x; lo.y = lo.y * c0.y + sg * plo.y * s0.y; lo.z = lo.z * c0.z + sg * plo.z * s0.z; lo.w = lo.w * c0.w + sg * plo.w * s0.w;
    hi.x = hi.x * c1.x + sg * phi.x * s1.x; hi.y = hi.y * c1.y + sg * phi.y * s1.y; hi.z = hi.z * c1.z + sg * phi.z * s1.z; hi.w = hi.w * c1.w + sg * phi.w * s1.w;
}

DI void ph_in(KP p, int l, const float* xin, char* smem) {
    for_tiles(512 * 12, [&](int t) __attribute__((always_inline)) {
        int rt, ct; tile_rc(t, 12, rt, ct);
        f32x16 acc[2][2];
        const float rsp = rs_load(p, rt * 128);
        gemm_tile<0, true>((const bf16_t*)(p->ws + OFF_XB), DM, rt * 128, 0, TOK, (const bf16_t*)(p->ws + OFF_WIN) + ((size_t)l * INCP + ct * 128) * DM, DM, DM, smem, acc);
        rs_finish(rsp, rt * 128, smem);
        const float* stg = stage_tile(acc, (const float*)(smem + RS_OFF), smem);
        const int tt = tid(), c8 = tt & 15, nb = ct * 128 + c8 * 8;
        if (nb < INC) {
#pragma unroll
            for (int i = 0; i < 8; ++i) {
                const int row = (tt >> 4) + 16 * i, tok = rt * 128 + row;
                float4 lo = *(const float4*)(stg + row * 132 + c8 * 8), hi = *(const float4*)(stg + row * 132 + c8 * 8 + 4);
                if (nb < 256) st_nt16((bf16_t*)(p->ws + OFF_HQ) + (size_t)tok * 256 + nb, pack8(lo, hi));
                else if (nb < 384) st_nt16((bf16_t*)(p->ws + OFF_HKV) + (size_t)tok * 128 + (nb - 256), pack8(lo, hi));
                else if (nb < 416) {
                    const int c = nb - 384, pc = c8 * 8 + (c < 16 ? 16 : -16);
                    const float4 plo = *(const float4*)(stg + row * 132 + pc), phi = *(const float4*)(stg + row * 132 + pc + 4);
                    rope8(lo, hi, plo, phi, (const float*)(p->ws + OFF_COS) + (size_t)tok * 16, (const float*)(p->ws + OFF_SIN) + (size_t)tok * 16, c);
                    const uint4 ov = pack8(lo, hi);
                    const int b = tok >> 13, sx = tok & 8191;
                    bf16_t* dst = (bf16_t*)(p->ws + OFF_K) + (((size_t)(b * 8)) * SEQ + sx) * 96 + 64 + c;
#pragma unroll
                    for (int hd = 0; hd < 8; ++hd) st_nt16(dst + (size_t)hd * SEQ * 96, ov);
                } else if (nb < 928) st_nt16((bf16_t*)(p->ws + OFF_U) + (size_t)tok * 512 + (nb - 416), pack8(gelu4(lo), gelu4(hi)));
                else st_nt16((bf16_t*)(p->ws + OFF_V) + (size_t)tok * 512 + (nb - 928), pack8(gelu4(lo), gelu4(hi)));
            }
        }
    });
}
DI void ph_qkv(KP p, int l, char* smem) {
    for_tiles(512 * 14, [&](int t) __attribute__((always_inline)) {
        int rt, ct; tile_rc(t, 14, rt, ct);
        f32x16 acc[2][2];
        if (ct < 6) {
            gemm_tile<1>((const bf16_t*)(p->ws + OFF_HQ), QL, rt * 128, 0, TOK, (const bf16_t*)(p->ws + OFF_WUQ) + ((size_t)l * 768 + ct * 128) * QL, QL, QL, smem, acc);
            const float* stg = stage_tile(acc, (const float*)(smem + RS_OFF), smem);
            const int tt = tid(), c8 = tt & 15, n8 = ct * 128 + c8 * 8, head = n8 / 96, w0 = n8 - head * 96;
            const float qs = 0.10206207261596575f * LOG2E;
#pragma unroll
            for (int i = 0; i < 8; ++i) {
                const int row = (tt >> 4) + 16 * i, tok = rt * 128 + row;
                float4 lo = *(const float4*)(stg + row * 132 + c8 * 8), hi = *(const float4*)(stg + row * 132 + c8 * 8 + 4);
                if (w0 >= 64) {
                    const int c = w0 - 64, pc = c8 * 8 + (c < 16 ? 16 : -16);
                    const float4 plo = *(const float4*)(stg + row * 132 + pc), phi = *(const float4*)(stg + row * 132 + pc + 4);
                    rope8(lo, hi, plo, phi, (const float*)(p->ws + OFF_COS) + (size_t)tok * 16, (const float*)(p->ws + OFF_SIN) + (size_t)tok * 16, c);
                }
                lo.x *= qs; lo.y *= qs; lo.z *= qs; lo.w *= qs; hi.x *= qs; hi.y *= qs; hi.z *= qs; hi.w *= qs;
                const int b = tok >> 13, sx = tok & 8191;
                st_nt16((bf16_t*)(p->ws + OFF_Q) + (((size_t)(b * 8 + head)) * SEQ + sx) * 96 + w0, pack8(lo, hi));
            }
        } else {
            const int c2 = ct - 6;
            gemm_tile<1>((const bf16_t*)(p->ws + OFF_HKV), KVL, rt * 128, 0, TOK, (const bf16_t*)(p->ws + OFF_WUKV) + ((size_t)l * 1024 + c2 * 128) * KVL, KVL, KVL, smem, acc);
            const float* stg = stage_tile(acc, (const float*)(smem + RS_OFF), smem);
            const int tt = tid(), tok0 = rt * 128, b = tok0 >> 13, s0 = tok0 & 8191;
            {
                const int c8 = tt & 7;
#pragma unroll
                for (int i = 0; i < 4; ++i) {
                    const int row = (tt >> 3) + 32 * i;
                    const float4 lo = *(const float4*)(stg + row * 132 + c8 * 8), hi = *(const float4*)(stg + row * 132 + c8 * 8 + 4);
                    st_nt16((bf16_t*)(p->ws + OFF_K) + (((size_t)(b * 8 + c2)) * SEQ + s0 + row) * 96 + c8 * 8, pack8(lo, hi));
                }
            }
            {
                const int tc = tt & 15;
#pragma unroll
                for (int i = 0; i < 4; ++i) {
                    const int d = (tt >> 4) + 16 * i;
                    const float* sp = stg + (tc * 8) * 132 + 64 + d;
                    uint4 ov;
                    ov.x = pack2(sp[0], sp[132]); ov.y = pack2(sp[2 * 132], sp[3 * 132]); ov.z = pack2(sp[4 * 132], sp[5 * 132]); ov.w = pack2(sp[6 * 132], sp[7 * 132]);
                    st_nt16((bf16_t*)(p->ws + OFF_VT) + (((size_t)(b * 8 + c2)) * 64 + d) * SEQ + s0 + tc * 8, ov);
                }
            }
        }
    });
}
DI void ph_mix(KP p, int l, char* smem) {
    for_tiles(512, [&](int t) __attribute__((always_inline)) { mla_item(p, t, smem); });
    for_tiles(512, [&](int t) __attribute__((always_inline)) { gmlp_item(p, l, t, smem); });
}
DI void ph_res(KP p, const bf16_t* A, int K, const bf16_t* Wt, const float* xin, char* smem, bool dry) {
    for_tiles(512 * 8, [&](int t) __attribute__((always_inline)) {
        int rt, ct; tile_rc(t, 8, rt, ct);
        f32x16 acc[2][2];
        gemm_tile<0>(A, K, rt * 128, 0, TOK, Wt + (size_t)ct * 128 * K, K, K, smem, acc);
        if (dry) return;
        const int tt = tid(), lane = tt & 63, w = __builtin_amdgcn_readfirstlane(tt >> 6), wm = w >> 1, wn = w & 1, l32 = lane & 31, h = lane >> 5;
        float* stg = (float*)smem;
#pragma unroll
        for (int i = 0; i < 2; ++i)
#pragma unroll
            for (int j = 0; j < 2; ++j)
#pragma unroll
                for (int r = 0; r < 16; ++r) stg[(wm * 64 + i * 32 + crow(r, h)) * 132 + wn * 64 + j * 32 + l32] = acc[i][j][r];
        __syncthreads();
        bf16_t* xb = (bf16_t*)(p->ws + OFF_XB) + (size_t)(rt * 128) * DM + ct * 128;
        float* part = (float*)(p->ws + OFF_RSC) + (size_t)(rt * 128) * 16 + ct * 2;
        const int c8 = tt & 15;
#pragma unroll
        for (int i = 0; i < 8; ++i) {
            const int row = (tt >> 4) + 16 * i;
            const float4 lo = *(const float4*)(stg + row * 132 + c8 * 8), hi = *(const float4*)(stg + row * 132 + c8 * 8 + 4);
            uint4* gp = (uint4*)(xb + (size_t)row * DM + c8 * 8);
            const uint4 xv = ld_nt16(gp);
            uint4 nv;
            nv.x = pack2h(hlo(xv.x) + lo.x, hhi(xv.x) + lo.y); nv.y = pack2h(hlo(xv.y) + lo.z, hhi(xv.y) + lo.w);
            nv.z = pack2h(hlo(xv.z) + hi.x, hhi(xv.z) + hi.y); nv.w = pack2h(hlo(xv.w) + hi.z, hhi(xv.w) + hi.w);
            st_nt16(gp, nv);
            float s0 = hlo(nv.x), s1 = hhi(nv.x), s2 = hlo(nv.y), s3 = hhi(nv.y), s4 = hlo(nv.z), s5 = hhi(nv.z), s6 = hlo(nv.w), s7 = hhi(nv.w);
            float sq = s0 * s0 + s1 * s1 + s2 * s2 + s3 * s3 + s4 * s4 + s5 * s5 + s6 * s6 + s7 * s7;
            sq += __shfl_xor(sq, 1); sq += __shfl_xor(sq, 2); sq += __shfl_xor(sq, 4); sq += __shfl_xor(sq, 8);
            if (c8 == 0) { float2 pv; pv.x = sq; pv.y = 0.f; *(float2*)(part + (size_t)row * 16) = pv; }
        }
    });
}
DI void ph_qm(KP p, int l, char* smem) {
    for_tiles(512 * 8, [&](int t) __attribute__((always_inline)) {
        int rt, ct; tile_rc(t, 8, rt, ct);
        f32x16 acc[2][2];
        const float rsp = rs_load(p, rt * 128);
        gemm_tile<0, true>((const bf16_t*)(p->ws + OFF_XB), DM, rt * 128, 0, TOK, (const bf16_t*)(p->ws + OFF_WMQ) + ((size_t)l * DM + ct * 128) * DM, DM, DM, smem, acc);
        rs_finish(rsp, rt * 128, smem);
        const float* stg = stage_tile(acc, (const float*)(smem + RS_OFF), smem);
        const int tt = tid(), c8 = tt & 15;
        const float qs = 0.0625f * LOG2E;
#pragma unroll
        for (int i = 0; i < 8; ++i) {
            const int row = (tt >> 4) + 16 * i;
            float4 lo = *(const float4*)(stg + row * 132 + c8 * 8), hi = *(const float4*)(stg + row * 132 + c8 * 8 + 4);
            lo.x *= qs; lo.y *= qs; lo.z *= qs; lo.w *= qs; hi.x *= qs; hi.y *= qs; hi.z *= qs; hi.w *= qs;
            st_nt16((bf16_t*)(p->ws + OFF_QM) + (size_t)(rt * 128 + row) * DM + ct * 128 + c8 * 8, pack8(lo, hi));
        }
    });
}
DI void ph_memattn(KP p, int l, char* smem) {
    for_tiles(NBATCH * 128 * 4, [&](int t) __attribute__((always_inline)) { memattn_item(p, l, t, smem); });
}
typedef float f32p __attribute__((ext_vector_type(2)));
DI void ph_up(KP p, int l, char* smem) {
    for_tiles(NBATCH * 66 * 44, [&](int t) __attribute__((always_inline)) {
        int rt, ct; tile_rc(t, 44, rt, ct);
        const int b = rt / 66, rl = rt - b * 66, s0 = rl * 126;
        const float* cw = p->conv_w + (size_t)l * 3 * 2 * DFF; const float* cb = p->conv_b + (size_t)l * 2 * DFF;
        const int cp2 = (tid() & 31) * 2, c = ct * 64 + cp2, c2 = DFF + c;
        const f32p g0 = *(const f32p*)(cw + c), g1 = *(const f32p*)(cw + 2 * DFF + c), g2 = *(const f32p*)(cw + 4 * DFF + c), gb = *(const f32p*)(cb + c);
        const f32p u0 = *(const f32p*)(cw + c2), u1 = *(const f32p*)(cw + 2 * DFF + c2), u2 = *(const f32p*)(cw + 4 * DFF + c2), ub = *(const f32p*)(cb + c2);
        f32x16 acc[2][2];
        const float rsp = rs_load(p, b * SEQ + s0 - 1);
        if (rl == 0 || rl == 65) gemm_tile<0, true, true>((const bf16_t*)(p->ws + OFF_XB), DM, b * SEQ + s0 - 1, b * SEQ, (b + 1) * SEQ, (const bf16_t*)(p->ws + OFF_WUP) + ((size_t)l * 2 * DFF + ct * 128) * DM, DM, DM, smem, acc);
        else gemm_tile<0, true, false>((const bf16_t*)(p->ws + OFF_XB), DM, b * SEQ + s0 - 1, b * SEQ, (b + 1) * SEQ, (const bf16_t*)(p->ws + OFF_WUP) + ((size_t)l * 2 * DFF + ct * 128) * DM, DM, DM, smem, acc);
        rs_finish(rsp, b * SEQ + s0 - 1, smem);
        const float* rs = (const float*)(smem + RS_OFF);
        float* stg = (float*)smem;
        const int tt = tid(), lane = tt & 63, w = __builtin_amdgcn_readfirstlane(tt >> 6), wm = w >> 1, wn = w & 1, l32 = lane & 31, h = lane >> 5;
#pragma unroll
        for (int i = 0; i < 2; ++i)
#pragma unroll
            for (int j = 0; j < 2; ++j)
#pragma unroll
                for (int r = 0; r < 16; ++r) {
                    const int row = wm * 64 + i * 32 + crow(r, h), col = wn * 64 + j * 32 + l32;
                    stg[row * 130 + col] = acc[i][j][r] * rs[row];
                }
        __syncthreads();
        bf16_t* act = (bf16_t*)(p->ws + OFF_ACT);
        const int rmax = min(126, SEQ - s0);
        const int rbeg = w * 32 + h * 16, rend = min(rbeg + 16, rmax);
        if (rbeg < rend) {
            const float* sg = stg + rbeg * 130 + cp2;
            unsigned* arow = (unsigned*)(act + ((size_t)b * SEQ + s0 + rbeg) * DFF + c);
            f32p ga = *(const f32p*)sg, gm = *(const f32p*)(sg + 130), ua = *(const f32p*)(sg + 64), um = *(const f32p*)(sg + 130 + 64);
#pragma unroll 4
            for (int r = rbeg; r < rend; ++r) {
                sg += 130;
                const f32p gn = *(const f32p*)(sg + 130), un = *(const f32p*)(sg + 130 + 64);
                const f32p g = g0 * ga + g1 * gm + g2 * gn + gb;
                const f32p up = u0 * ua + u1 * um + u2 * un + ub;
                const f32p e = g * (-LOG2E);
                f32p den; den.x = 1.f + ex2(e.x); den.y = 1.f + ex2(e.y);
                f32p sig; sig.x = __builtin_amdgcn_rcpf(den.x); sig.y = __builtin_amdgcn_rcpf(den.y);
                const f32p o = g * sig * up;
                st_nt4(arow, pack2(o.x, o.y));
                arow += DFF / 2;
                ga = gm; gm = gn; ua = um; um = un;
            }
        }
    });
}
DI void ph_final(KP p) {
    const int lane = tid() & 63, wv = blockIdx.x * 4 + (tid() >> 6), nw = gridDim.x * 4;
    const bf16_t* xbp = (const bf16_t*)(p->ws + OFF_XB);
    const float* rsc = (const float*)(p->ws + OFF_RSC);
    for (int row = wv; row < TOK; row += nw) {
        const uint4* xr = (const uint4*)(xbp + (size_t)row * DM);
        float4* orow = (float4*)(p->out + (size_t)row * DM);
        float ps = lane < 16 ? rsc[(size_t)row * 16 + lane] : 0.f;
        ps += __shfl_xor(ps, 1); ps += __shfl_xor(ps, 2); ps += __shfl_xor(ps, 4); ps += __shfl_xor(ps, 8);
        const float sc = rsqrtf(__shfl(ps, 0) * (1.f / DM) + EPS);
#pragma unroll
        for (int i = 0; i < 2; ++i) {
            const uint4 v = ld_nt16(xr + lane + 64 * i);
            const float4 g0 = ((const float4*)p->final_norm_g)[2 * (lane + 64 * i)], g1 = ((const float4*)p->final_norm_g)[2 * (lane + 64 * i) + 1];
            float4 o0, o1;
            o0.x = hlo(v.x) * sc * g0.x; o0.y = hhi(v.x) * sc * g0.y; o0.z = hlo(v.y) * sc * g0.z; o0.w = hhi(v.y) * sc * g0.w;
            o1.x = hlo(v.z) * sc * g1.x; o1.y = hhi(v.z) * sc * g1.y; o1.z = hlo(v.w) * sc * g1.z; o1.w = hhi(v.w) * sc * g1.w;
            st_nt16f(orow + 2 * (lane + 64 * i), o0); st_nt16f(orow + 2 * (lane + 64 * i) + 1, o1);
        }
    }
}

#define XB_TMO      128
#define XB_XCNT(j)  (256  + 64 * (j))
#define XB_XSUB(j)  (1280 + 64 * (j))
#define XB_XGEN(j)  (2304 + 64 * (j))
#define XB_TOP      3328
#define XB_TOPGEN   3392
#define XCD_BAR_WORDS 3456
#define XB_SPIN_CAP (1u << 22)
#define LAS __attribute__((address_space(3)))
static_assert(XCD_BAR_WORDS * 4 <= BAR_BYTES, "barrier words");
DI unsigned xb_ld(unsigned* p) { return __hip_atomic_load(p, __ATOMIC_RELAXED, __HIP_MEMORY_SCOPE_AGENT); }
DI unsigned xb_add(unsigned* p, unsigned v) { return __hip_atomic_fetch_add(p, v, __ATOMIC_RELAXED, __HIP_MEMORY_SCOPE_AGENT); }
DI unsigned xb_xcc_id() { return (unsigned)__builtin_amdgcn_s_getreg((3 << 11) | 20) & 0xFu; }
#define XB_SPIN(cond, bar) do { unsigned _sp = 0; while (cond) { __builtin_amdgcn_s_sleep(1); \
    if ((++_sp & 255u) == 0u) { if (xb_ld(&(bar)[XB_TMO])) break; if (_sp > XB_SPIN_CAP) { atomicAdd(&(bar)[XB_TMO], 1u); break; } } } } while (0)
struct XcdBarrier { unsigned* bar; unsigned x; volatile LAS unsigned* st; };
DI XcdBarrier xcd_barrier_post(unsigned* bar, volatile LAS unsigned* st) {
    XcdBarrier b; b.bar = bar; b.x = xb_xcc_id(); b.st = st;
    if (threadIdx.x == 0) (void)xb_add(&bar[XB_XCNT(b.x)], 1u);
    return b;
}
DI void xcd_barrier_complete(unsigned* bar, unsigned x, unsigned& nloc, unsigned& nx) {
    const unsigned G = gridDim.x * gridDim.y * gridDim.z;
    unsigned sum, cnt, mine, sp = 0u;
    for (;;) {
        sum = 0u; cnt = 0u; mine = 0u;
#pragma unroll
        for (unsigned j = 0; j < 16; ++j) { const unsigned c = xb_ld(&bar[XB_XCNT(j)]); sum += c; cnt += (c > 0u) ? 1u : 0u; mine = (j == x) ? c : mine; }
        if (sum == G) break;
        __builtin_amdgcn_s_sleep(1);
        if ((++sp & 255u) == 0u) { if (xb_ld(&bar[XB_TMO])) break; if (sp > XB_SPIN_CAP) { atomicAdd(&bar[XB_TMO], 1u); break; } }
    }
    nloc = mine > 0u ? mine : 1u; nx = cnt > 0u ? cnt : 1u;
}
DI void xcd_barrier(const XcdBarrier& b) {
    asm volatile("s_waitcnt vmcnt(0)" ::: "memory");
    __syncthreads();
    if (threadIdx.x == 0) {
        unsigned* bar = b.bar;
        __builtin_amdgcn_s_waitcnt(0);
        unsigned nloc = b.st[0], nx = b.st[1];
        if (nloc == 0u) { xcd_barrier_complete(bar, b.x, nloc, nx); b.st[0] = nloc; b.st[1] = nx; }
        const unsigned old = xb_add(&bar[XB_XSUB(b.x)], 1u);
        const unsigned gen = old / nloc;
        if (old + 1u == (gen + 1u) * nloc) {
            __builtin_amdgcn_fence(__ATOMIC_RELEASE, "agent");
            asm volatile("s_waitcnt vmcnt(0)" ::: "memory");
            const unsigned og = xb_add(&bar[XB_TOP], 1u);
            const unsigned tg = og / nx;
            if (og + 1u == (tg + 1u) * nx) xb_add(&bar[XB_TOPGEN], 1u);
            else XB_SPIN(xb_ld(&bar[XB_TOPGEN]) == tg, bar);
            __builtin_amdgcn_fence(__ATOMIC_ACQUIRE, "agent");
            xb_add(&bar[XB_XGEN(b.x)], 1u);
            asm volatile("s_waitcnt vmcnt(0)" ::: "memory");
        } else {
            XB_SPIN(xb_ld(&bar[XB_XGEN(b.x)]) == gen, bar);
            __builtin_amdgcn_fence(__ATOMIC_ACQUIRE, "agent");
            asm volatile("s_waitcnt vmcnt(0)" ::: "memory");
        }
    }
    __syncthreads();
}

constexpr int NPHASE = 2 + 9 * DEPTH + 1;
__global__ void __launch_bounds__(256, 2) mk(Params p_unused, int lo, int hi) {
    extern __shared__ __attribute__((aligned(16))) char smem[];
    cg::grid_group grid = cg::this_grid();
    volatile LAS unsigned* xst = (volatile LAS unsigned*)(smem + RS_OFF + 512);
    if (threadIdx.x == 0) { xst[0] = 0u; xst[1] = 0u; xst[2] = 0u; xst[3] = 0u; }
    __syncthreads();
    const XcdBarrier xbar = xcd_barrier_post((unsigned*)(kparams()->ws + OFF_BAR), xst);
    for (int ph = lo; ph < hi; ++ph) {
        KP p = kparams();
        if (ph == 0) phase_setup(p, smem);
        else if (ph == 1) ph_memkv(p, smem);
        else if (ph == NPHASE - 1) ph_final(p);
        else {
            const int l = (ph - 2) / 9, s = (ph - 2) % 9;
            const float* xin = l == 0 ? p->x : p->out;
            const int reps = ((REPMASK >> s) & 1) ? 2 : 1;
            for (int rep = 0; rep < reps; ++rep) {
                const bool dry = rep + 1 < reps;
                switch (s) {
                    case 0: ph_in(p, l, xin, smem); break;
                    case 1: ph_qkv(p, l, smem); break;
                    case 2: ph_mix(p, l, smem); break;
                    case 3: ph_res(p, (const bf16_t*)(p->ws + OFF_OMIX), DM, (const bf16_t*)(p->ws + OFF_WOUT) + (size_t)l * DM * DM, xin, smem, dry); break;
                    case 4: ph_qm(p, l, smem); break;
                    case 5: ph_memattn(p, l, smem); break;
                    case 6: ph_res(p, (const bf16_t*)(p->ws + OFF_OMEM), DM, (const bf16_t*)(p->ws + OFF_WMO) + (size_t)l * DM * DM, p->out, smem, dry); break;
                    case 7: ph_up(p, l, smem); break;
                    case 8: ph_res(p, (const bf16_t*)(p->ws + OFF_ACT), DFF, (const bf16_t*)(p->ws + OFF_WDN) + (size_t)l * DM * DFF, p->out, smem, dry); break;
                }
                if (dry) xcd_barrier(xbar);
            }
        }
        if (ph + 1 < hi) { if (ph == 0) grid.sync(); else if (ph != 1) xcd_barrier(xbar); }
    }
}

extern "C" void kernel_launch(void* const* d_in, const int* in_sizes, int n_in, void* d_out, int out_size, void* d_ws, size_t ws_size, hipStream_t stream) {
    static int grid_blocks = 0;
    if (!grid_blocks) {
        int dev = 0, cus = 0, per_cu = 0;
        hipGetDevice(&dev);
        hipDeviceGetAttribute(&cus, hipDeviceAttributeMultiprocessorCount, dev);
        hipFuncSetAttribute((const void*)mk, hipFuncAttributeMaxDynamicSharedMemorySize, LDS_BYTES);
        hipOccupancyMaxActiveBlocksPerMultiprocessor(&per_cu, (const void*)mk, 256, LDS_BYTES);
        if (per_cu < 1) per_cu = 1;
        if (per_cu > 2) per_cu = 2;
        grid_blocks = cus * per_cu;
        if (ws_size < OFF_END) fprintf(stderr, "kernel_launch: workspace too small: %zu < %zu\n", ws_size, (size_t)OFF_END);
    }
    Params p{};
    const float** fp = (const float**)&p;
    p.x = (const float*)d_in[0]; p.mem = (const float*)d_in[1]; p.pos = (const int*)d_in[2];
    p.norm_mix_g = (const float*)d_in[3]; p.w_in = (const float*)d_in[4]; p.q_norm_g = (const float*)d_in[5]; p.w_uq = (const float*)d_in[6];
    p.kv_norm_g = (const float*)d_in[7]; p.w_ukv = (const float*)d_in[8]; p.sg_ln_g = (const float*)d_in[9]; p.sg_ln_b = (const float*)d_in[10];
    p.sg_w_s = (const float*)d_in[11]; p.sg_b_s = (const float*)d_in[12]; p.out_norm_mla_g = (const float*)d_in[13]; p.out_norm_sg_g = (const float*)d_in[14];
    p.w_out = (const float*)d_in[15]; p.norm_mem_g = (const float*)d_in[16]; p.mem_norm_g = (const float*)d_in[17]; p.w_mq = (const float*)d_in[18];
    p.w_mkv = (const float*)d_in[19]; p.w_mo = (const float*)d_in[20]; p.norm_ffn_g = (const float*)d_in[21]; p.w_up = (const float*)d_in[22];
    p.conv_w = (const float*)d_in[23]; p.conv_b = (const float*)d_in[24]; p.w_down = (const float*)d_in[25]; p.final_norm_g = (const float*)d_in[26];
    p.out = (float*)d_out; p.ws = (char*)d_ws;
    (void)fp;
    (void)hipMemsetAsync((char*)d_ws + OFF_BAR, 0, BAR_BYTES, stream);
#if COOP
    int lo = 0, hi = NPHASE;
    void* args[] = {&p, &lo, &hi};
    hipError_t e = hipLaunchCooperativeKernel((const void*)mk, dim3(grid_blocks), dim3(256), args, LDS_BYTES, stream);
    if (e != hipSuccess) fprintf(stderr, "cooperative launch failed: %s (grid %d)\n", hipGetErrorString(e), grid_blocks);
#else
    for (int ph = 0; ph < NPHASE; ++ph) hipLaunchKernelGGL(mk, dim3(grid_blocks), dim3(256), LDS_BYTES, stream, p, ph, ph + 1);
#endif
}
```
